# Optimizing an MI355X kernel written in HIP

```python
import jax
import jax.numpy as jnp
from jax import lax
import numpy as np

D_MODEL = 1024
BATCH = 8
SEQ = 4096
DEPTH = 1

HEAD_DIM = 64
RWKV_HEADS = 8
RWKV_WIDTH = RWKV_HEADS * HEAD_DIM
MOBA_HEADS = 8
MOBA_WIDTH = MOBA_HEADS * HEAD_DIM
DECAY_LORA = 64
AAA_LORA = 64
GATE_LORA = 160
MOBA_BLOCK = 256
MOBA_TOPK = 3
Q_CHUNK = 64
ROT_DIM = HEAD_DIM // 4
ROPE_THETA = 500000.0
D_FF = 2816
CONV_WIDTH = 3
NORM_EPS = 1e-6
GN_EPS = 64e-5
N_BRANCH = 2
RWKV_IN = 3 * RWKV_WIDTH + DECAY_LORA + AAA_LORA + GATE_LORA
MOBA_IN = 3 * MOBA_WIDTH
GATE_IN = N_BRANCH * D_MODEL
IN_COLS = RWKV_IN + MOBA_IN + GATE_IN

kernel_name = 'hybrid_rwkv7_moba_convffn_block'


def rms_norm(x, g):
    xf = x.astype(jnp.float32)
    y = xf * lax.rsqrt(jnp.mean(xf * xf, axis=-1, keepdims=True) + NORM_EPS)
    return (y * g.astype(jnp.float32)).astype(x.dtype)


def shift_right(z):
    return jnp.pad(z, ((0, 0), (1, 0), (0, 0)))[:, :-1]


def partial_rope(x, positions):
    half = ROT_DIM // 2
    inv_freq = ROPE_THETA ** (-jnp.arange(half, dtype=jnp.float32) / half)
    ang = positions.astype(jnp.float32)[..., None] * inv_freq
    cos = jnp.cos(ang)[:, :, None, :]
    sin = jnp.sin(ang)[:, :, None, :]
    xr = x[..., :ROT_DIM].astype(jnp.float32)
    x1, x2 = xr[..., :half], xr[..., half:]
    rot = jnp.concatenate([x1 * cos - x2 * sin, x2 * cos + x1 * sin], axis=-1)
    return jnp.concatenate([rot.astype(x.dtype), x[..., ROT_DIM:]], axis=-1)


def rwkv7_time_mix(z, w_decay_up, decay_bias, w_aaa_up, aaa_bias, w_gate_up,
                   k_k, k_a, r_k, ln_g, ln_b):
    B, S, _ = z.shape
    H, N, C = RWKV_HEADS, HEAD_DIM, RWKV_WIDTH
    f32 = jnp.float32
    o3 = 3 * C
    o4 = o3 + DECAY_LORA
    o5 = o4 + AAA_LORA
    r, k, v = z[..., :C], z[..., C:2 * C], z[..., 2 * C:o3]
    xw, xa, xg = z[..., o3:o4], z[..., o4:o5], z[..., o5:]
    w_log = -jax.nn.softplus(-(decay_bias + jnp.tanh(xw) @ w_decay_up)) - 0.5
    decay = jnp.exp(-jnp.exp(w_log.astype(f32)))
    a = jax.nn.sigmoid(aaa_bias + xa @ w_aaa_up)
    g = jax.nn.sigmoid(xg) @ w_gate_up
    kk = (k * k_k).astype(f32).reshape(B, S, H, N)
    kk = kk / jnp.maximum(jnp.sqrt(jnp.sum(kk * kk, axis=-1, keepdims=True)), 1e-12)
    k = k * (1.0 + (a - 1.0) * k_a)

    def time_major(t):
        return t.astype(f32).reshape(B, S, H, N).transpose(1, 0, 2, 3)

    kk_t = kk.transpose(1, 0, 2, 3)
    inputs = (time_major(r), time_major(decay), time_major(k), time_major(v),
              -kk_t, kk_t * time_major(a))

    def step(state, inp):
        r_t, w_t, k_t, v_t, a_t, b_t = inp
        sa = jnp.einsum('bhvk,bhk->bhv', state, a_t)
        state = (state * w_t[:, :, None, :] + sa[..., None] * b_t[:, :, None, :]
                 + v_t[..., None] * k_t[:, :, None, :])
        return state, jnp.einsum('bhvk,bhk->bhv', state, r_t)

    state0 = jnp.zeros((B, H, N, N), f32)
    _, y = lax.scan(step, state0, inputs)
    y = y.transpose(1, 0, 2, 3)
    mu = jnp.mean(y, axis=-1, keepdims=True)
    var = jnp.mean(jnp.square(y - mu), axis=-1, keepdims=True)
    y = ((y - mu) * lax.rsqrt(var + GN_EPS)).reshape(B, S, C)
    y = y * ln_g.astype(f32) + ln_b.astype(f32)
    rh = r.astype(f32).reshape(B, S, H, N)
    kh = k.astype(f32).reshape(B, S, H, N)
    vh = v.astype(f32).reshape(B, S, H, N)
    bonus = (jnp.sum(rh * kh * r_k.astype(f32), axis=-1, keepdims=True) * vh).reshape(B, S, C)
    return ((y + bonus) * g.astype(f32)).astype(z.dtype)


def moba_attention(q, k, v):
    B, S, H, Dh = q.shape
    f32 = jnp.float32
    n_blk = -(-S // MOBA_BLOCK)
    S_pad = n_blk * MOBA_BLOCK
    pad = ((0, 0), (0, S_pad - S), (0, 0), (0, 0))
    qt = jnp.pad(q, pad).transpose(0, 2, 1, 3)
    kt = jnp.pad(k, pad).transpose(0, 2, 1, 3)
    vt = jnp.pad(v, pad).transpose(0, 2, 1, 3)
    kb = kt.reshape(B, H, n_blk, MOBA_BLOCK, Dh)
    vb = vt.reshape(B, H, n_blk, MOBA_BLOCK, Dh)
    k_mean = jnp.mean(kb.astype(f32), axis=3)
    gate = jnp.einsum('bhsd,bhnd->bhsn', qt.astype(f32), k_mean)
    q_blk = jnp.arange(S_pad) // MOBA_BLOCK
    past = jnp.arange(n_blk)[None, :] < q_blk[:, None]
    gate = jnp.where(past, gate, -jnp.inf)
    n_sel = min(MOBA_TOPK, n_blk)
    _, sel = lax.top_k(gate, n_sel)
    slot_ok = jnp.arange(n_sel)[None, :] < q_blk[:, None]
    b_idx = jnp.arange(B)[:, None, None, None]
    h_idx = jnp.arange(H)[None, :, None, None]
    scale = Dh ** -0.5
    q_off = jnp.arange(Q_CHUNK)
    k_off = jnp.arange(MOBA_BLOCK)
    n_keys_sel = n_sel * MOBA_BLOCK

    def attend_chunk(c):
        start = c * Q_CHUNK
        blk = start // MOBA_BLOCK
        q_c = lax.dynamic_slice_in_dim(qt, start, Q_CHUNK, axis=2)
        sel_c = lax.dynamic_slice_in_dim(sel, start, Q_CHUNK, axis=2)
        ok_c = lax.dynamic_slice_in_dim(slot_ok, start, Q_CHUNK, axis=0)
        k_sel = kb[b_idx, h_idx, sel_c]
        v_sel = vb[b_idx, h_idx, sel_c]
        k_own = lax.dynamic_index_in_dim(kb, blk, axis=2, keepdims=False)
        v_own = lax.dynamic_index_in_dim(vb, blk, axis=2, keepdims=False)
        s_sel = jnp.einsum('bhqd,bhqnkd->bhqnk', q_c, k_sel, preferred_element_type=f32) * scale
        s_sel = jnp.where(ok_c[None, None, :, :, None], s_sel, -jnp.inf)
        s_own = jnp.einsum('bhqd,bhkd->bhqk', q_c, k_own, preferred_element_type=f32) * scale
        causal = (blk * MOBA_BLOCK + k_off)[None, :] <= (start + q_off)[:, None]
        s_own = jnp.where(causal, s_own, -jnp.inf)
        s_all = jnp.concatenate([s_sel.reshape(B, H, Q_CHUNK, n_keys_sel), s_own], axis=-1)
        p = jax.nn.softmax(s_all, axis=-1).astype(v.dtype)
        p_sel = p[..., :n_keys_sel].reshape(B, H, Q_CHUNK, n_sel, MOBA_BLOCK)
        p_own = p[..., n_keys_sel:]
        o = (jnp.einsum('bhqnk,bhqnkd->bhqd', p_sel, v_sel, preferred_element_type=f32)
             + jnp.einsum('bhqk,bhkd->bhqd', p_own, v_own, preferred_element_type=f32))
        return o.astype(v.dtype)

    out = lax.map(attend_chunk, jnp.arange(S_pad // Q_CHUNK))
    out = out.transpose(1, 0, 3, 2, 4).reshape(B, S_pad, H * Dh)
    return out[:, :S]


def conv_ffn(h, w_up, conv_w, conv_b, w_down):
    u = h @ w_up
    a, b = u[..., :D_FF], u[..., D_FF:]
    a = lax.conv_general_dilated(
        a, conv_w.reshape(CONV_WIDTH, 1, D_FF), window_strides=(1,),
        padding=[(CONV_WIDTH - 1, 0)], dimension_numbers=('NWC', 'WIO', 'NWC'),
        feature_group_count=D_FF) + conv_b
    return (jax.nn.gelu(a, approximate=False) * b) @ w_down


def setup_inputs(seed: int = 0) -> dict:
    key = jax.random.key(seed)
    ks = iter(jax.random.split(key, 32))
    L = DEPTH
    f32 = jnp.float32

    def nrm(shape, scale):
        return jax.random.normal(next(ks), shape, f32) * scale

    def unif(shape, lo, hi):
        return jax.random.uniform(next(ks), shape, f32, lo, hi)

    x = nrm((BATCH, SEQ, D_MODEL), 1.0)
    positions = jnp.broadcast_to(jnp.arange(SEQ, dtype=jnp.int32), (BATCH, SEQ))
    return {
        'x': x,
        'positions': positions,
        'norm1_g': 1.0 + nrm((L, D_MODEL), 0.02),
        'w_in': nrm((L, D_MODEL, IN_COLS), D_MODEL ** -0.5),
        'rwkv_mu': unif((L, RWKV_IN), 0.0, 1.0),
        'w_decay_up': nrm((L, DECAY_LORA, RWKV_WIDTH), 0.5 * DECAY_LORA ** -0.5),
        'decay_bias': unif((L, RWKV_WIDTH), -6.5, -1.5),
        'w_aaa_up': nrm((L, AAA_LORA, RWKV_WIDTH), 0.5 * AAA_LORA ** -0.5),
        'aaa_bias': nrm((L, RWKV_WIDTH), 0.1),
        'w_gate_up': nrm((L, GATE_LORA, RWKV_WIDTH), GATE_LORA ** -0.5),
        'rwkv_k_k': 0.85 + nrm((L, RWKV_WIDTH), 0.05),
        'rwkv_k_a': 1.0 + nrm((L, RWKV_WIDTH), 0.05),
        'rwkv_r_k': nrm((L, RWKV_HEADS, HEAD_DIM), 0.1),
        'rwkv_ln_g': 1.0 + nrm((L, RWKV_WIDTH), 0.02),
        'rwkv_ln_b': nrm((L, RWKV_WIDTH), 0.02),
        'q_norm_g': 1.0 + nrm((L, HEAD_DIM), 0.02),
        'k_norm_g': 1.0 + nrm((L, HEAD_DIM), 0.02),
        'w_branch_a': nrm((L, RWKV_WIDTH, D_MODEL), RWKV_WIDTH ** -0.5),
        'w_branch_b': nrm((L, MOBA_WIDTH, D_MODEL), MOBA_WIDTH ** -0.5),
        'w_out': nrm((L, D_MODEL, D_MODEL), D_MODEL ** -0.5),
        'norm2_g': 1.0 + nrm((L, D_MODEL), 0.02),
        'w_ffn_up': nrm((L, D_MODEL, 2 * D_FF), D_MODEL ** -0.5),
        'ffn_conv_w': nrm((L, CONV_WIDTH, D_FF), CONV_WIDTH ** -0.5),
        'ffn_conv_b': nrm((L, D_FF), 0.02),
        'w_ffn_down': nrm((L, D_FF, D_MODEL), D_FF ** -0.5),
    }


def reference(x, positions, norm1_g, w_in, rwkv_mu, w_decay_up, decay_bias, w_aaa_up,
              aaa_bias, w_gate_up, rwkv_k_k, rwkv_k_a, rwkv_r_k, rwkv_ln_g, rwkv_ln_b,
              q_norm_g, k_norm_g, w_branch_a, w_branch_b, w_out, norm2_g, w_ffn_up,
              ffn_conv_w, ffn_conv_b, w_ffn_down):
    B, S, _ = x.shape
    for l in range(DEPTH):
        h = rms_norm(x, norm1_g[l])
        proj = h @ w_in[l]
        z_rwkv = proj[..., :RWKV_IN]
        z_moba = proj[..., RWKV_IN:RWKV_IN + MOBA_IN]
        gate_pre = proj[..., RWKV_IN + MOBA_IN:]
        z_rwkv = z_rwkv + rwkv_mu[l] * (shift_right(z_rwkv) - z_rwkv)
        y_a = rwkv7_time_mix(z_rwkv, w_decay_up[l], decay_bias[l], w_aaa_up[l], aaa_bias[l],
                             w_gate_up[l], rwkv_k_k[l], rwkv_k_a[l], rwkv_r_k[l],
                             rwkv_ln_g[l], rwkv_ln_b[l])
        q = z_moba[..., :MOBA_WIDTH].reshape(B, S, MOBA_HEADS, HEAD_DIM)
        k = z_moba[..., MOBA_WIDTH:2 * MOBA_WIDTH].reshape(B, S, MOBA_HEADS, HEAD_DIM)
        v = z_moba[..., 2 * MOBA_WIDTH:].reshape(B, S, MOBA_HEADS, HEAD_DIM)
        q = partial_rope(rms_norm(q, q_norm_g[l]), positions)
        k = partial_rope(rms_norm(k, k_norm_g[l]), positions)
        y_b = moba_attention(q, k, v)
        u_a = y_a @ w_branch_a[l]
        u_b = y_b @ w_branch_b[l]
        g_a = jax.nn.sigmoid(gate_pre[..., :D_MODEL])
        g_b = jax.nn.sigmoid(gate_pre[..., D_MODEL:])
        x = x + (g_a * u_a + g_b * u_b) @ w_out[l]
        h2 = rms_norm(x, norm2_g[l])
        x = x + conv_ffn(h2, w_ffn_up[l], ffn_conv_w[l], ffn_conv_b[l], w_ffn_down[l])
    return x
```

```cpp
#include <hip/hip_runtime.h>
#include <hip/hip_cooperative_groups.h>
#include <cstdio>
#include <cstdint>
namespace cg = cooperative_groups;

#ifndef MK_SPLIT
#define MK_SPLIT 0
#endif

namespace pg8 {
#define PG8_LAS __attribute__((address_space(3)))
typedef unsigned short bf16_t;
typedef short bf16x8 __attribute__((ext_vector_type(8)));
typedef float f32x4 __attribute__((ext_vector_type(4)));
typedef unsigned u32x4 __attribute__((ext_vector_type(4)));
typedef unsigned u32x2 __attribute__((ext_vector_type(2)));
constexpr int BM = 256, BK = 64, HALF = 128, HTB = HALF * BK * 2, STAGE_BYTES = 8 * HTB, NXCD = 8, WGM = 2;

__host__ __device__ __forceinline__ int lds_byte(int r, int c) { const int st = (r >> 4) * 2 + (c >> 5), rr = r & 15, cc = c & 31, ob = rr * 64 + cc * 2; return st * 1024 + (ob ^ (((ob >> 9) & 1) << 5)); }
__host__ __device__ __forceinline__ void stage_rc(int b, int& R, int& C) { const int st = b / 1024, sb = b % 1024, swz = sb ^ (((sb >> 9) & 1) << 5); R = (st >> 1) * 16 + swz / 64; C = (st & 1) * 32 + (swz % 64) / 2; }
__host__ __device__ __forceinline__ int perm32(int rho) { const int n = rho >> 4, i = rho & 15; return 8 * (i >> 2) + 4 * n + (i & 3); }

struct Unit { int pm, pn; };
struct Gemm { const bf16_t* A; const bf16_t* Bt; int M, N, K, lda, ldb; };

struct StaticOrder {
    int nM, nN, nwg, G, c;
    __host__ __device__ void init(int M, int N, int G_, int c_) { nM = M / BM; nN = N / BM; nwg = nM * nN; G = G_; c = c_; }
    __host__ __device__ bool next(int i, Unit& u) const {
        const long L = (long)i * G + c; if (L >= nwg) return false;
        int wgid = (int)L; { const int q = nwg / NXCD, r = nwg % NXCD, xcd = wgid % NXCD, off = wgid / NXCD; wgid = (xcd < r ? xcd * (q + 1) : r * (q + 1) + (xcd - r) * q) + off; }
        const int nig = WGM * nN, gid = wgid / nig, fm = gid * WGM, gsz = (nM - fm) < WGM ? (nM - fm) : WGM;
        u.pm = fm + ((wgid % nig) % gsz); u.pn = (wgid % nig) / gsz; return true;
    }
};

__device__ __forceinline__ unsigned cvt_pk_bf16(float lo, float hi) { unsigned r; asm volatile("v_cvt_pk_bf16_f32 %0, %1, %2" : "=v"(r) : "v"(lo), "v"(hi)); return r; }

template <class Epi, bool ALIGN_EPI>
__device__ __forceinline__ void gemm_phase(PG8_LAS unsigned char* lds, const Gemm g, const StaticOrder& S, const Epi& E) {
    const int tid = threadIdx.x, wid = __builtin_amdgcn_readfirstlane(tid >> 6), lane = tid & 63, wr = wid >> 2, wc = wid & 3, fr = lane & 15, fq = lane >> 4;
    const int K = g.K, nt = K / BK;
    unsigned voffA[2], voffB[2];
#pragma unroll
    for (int i = 0; i < 2; ++i) { int R, C; stage_rc(tid * 16 + i * 8192, R, C); const int Rb = Epi::PERM ? ((R & ~31) + perm32(R & 31)) : R;
        voffA[i] = (unsigned)(R * g.lda + C) * 2u; voffB[i] = (unsigned)(Rb * g.ldb + C) * 2u; }
    const size_t kstep = (size_t)(BK * 2);
    const size_t hstepA = (size_t)HALF * g.lda * 2, hstepB = (size_t)HALF * g.ldb * 2;
    const size_t tstepA = 2 * hstepA, tstepB = 2 * hstepB;
    const unsigned ldsw = (unsigned)wid * 1024u;
    const int aoff = lds_byte(wr * 64 + fr, fq * 8), boff = lds_byte(wc * 32 + fr, fq * 8);
#define PG8_SA(b, h) (((b) * 2 + (h)) * HTB)
#define PG8_SB(b, h) ((4 + (b) * 2 + (h)) * HTB)
#define PG8_STAGE(bufoff, gbase, voff) do { _Pragma("unroll") for (int _i = 0; _i < 2; ++_i) \
        __builtin_amdgcn_global_load_lds((const unsigned*)((const char*)(gbase) + (voff)[_i]), (PG8_LAS unsigned*)(lds + (bufoff) + ldsw + _i * 8192), 16, 0, 0); } while (0)
#define PG8_LDA(dst, b, h) do { _Pragma("unroll") for (int m = 0; m < 4; ++m) _Pragma("unroll") for (int k = 0; k < 2; ++k) dst[m][k] = *(const PG8_LAS bf16x8*)(lds + PG8_SA(b, h) + aoff + m * 2048 + k * 1024); } while (0)
#define PG8_LDB(dst, b, h) do { _Pragma("unroll") for (int n = 0; n < 2; ++n) _Pragma("unroll") for (int k = 0; k < 2; ++k) dst[n][k] = *(const PG8_LAS bf16x8*)(lds + PG8_SB(b, h) + boff + n * 2048 + k * 1024); } while (0)
#define PG8_MMA(ai, bj, At, Bt) do { __builtin_amdgcn_s_setprio(1); _Pragma("unroll") for (int m = 0; m < 4; ++m) _Pragma("unroll") for (int n = 0; n < 2; ++n) _Pragma("unroll") for (int k = 0; k < 2; ++k) \
        acc[ai][bj][m][n] = __builtin_amdgcn_mfma_f32_16x16x32_bf16(Bt[n][k], At[m][k], acc[ai][bj][m][n], 0, 0, 0); __builtin_amdgcn_s_setprio(0); } while (0)
#define PG8_WAIT_V(n) asm volatile("s_waitcnt vmcnt(" #n ")" ::: "memory")
#define PG8_WAIT_L(n) asm volatile("s_waitcnt lgkmcnt(" #n ")" ::: "memory")
#define PG8_BAR __builtin_amdgcn_s_barrier()
#define PG8_SCHED __builtin_amdgcn_sched_barrier(0)
    Unit cur, nxt; int ui = 0;
    if (!S.next(0, cur)) return;
    f32x4 acc[2][2][4][2];
#pragma unroll
    for (int a = 0; a < 2; ++a)
#pragma unroll
        for (int b = 0; b < 2; ++b)
#pragma unroll
            for (int m = 0; m < 4; ++m)
#pragma unroll
                for (int n = 0; n < 2; ++n) acc[a][b][m][n] = (f32x4){0.f, 0.f, 0.f, 0.f};
    bf16x8 At[4][2], B0[2][2], B1[2][2];
    const char* cA = (const char*)g.A + (size_t)cur.pm * tstepA; const char* cB = (const char*)g.Bt + (size_t)cur.pn * tstepB;
    PG8_STAGE(PG8_SB(0, 0), cB, voffB); PG8_STAGE(PG8_SB(0, 1), cB + hstepB, voffB); PG8_STAGE(PG8_SA(0, 0), cA, voffA); PG8_STAGE(PG8_SA(0, 1), cA + hstepA, voffA);
    if (wr == 1) PG8_BAR;
    PG8_WAIT_V(2); PG8_BAR;
    PG8_STAGE(PG8_SB(1, 0), cB + kstep, voffB); PG8_STAGE(PG8_SA(1, 0), cA + kstep, voffA); PG8_STAGE(PG8_SB(1, 1), cB + hstepB + kstep, voffB);
    PG8_WAIT_V(6); PG8_BAR;
    for (;;) {
        const bool has_next = S.next(ui + 1, nxt);
        const char* nA = has_next ? (const char*)g.A + (size_t)nxt.pm * tstepA : cA; const char* nB = has_next ? (const char*)g.Bt + (size_t)nxt.pn * tstepB : cB;
        for (int t = 0; t < nt; t += 2) {
            const bool last = (t == nt - 2);
            const char* a1 = cA + (size_t)(t + 1) * kstep;
            const char* a2 = last ? nA : cA + (size_t)(t + 2) * kstep; const char* b2 = last ? nB : cB + (size_t)(t + 2) * kstep;
            const char* a3 = a2 + kstep; const char* b3 = b2 + kstep;
            PG8_LDB(B0, 0, 0); PG8_LDB(B1, 0, 1); PG8_SCHED; PG8_LDA(At, 0, 0); PG8_STAGE(PG8_SA(1, 1), a1 + hstepA, voffA);
            PG8_WAIT_V(8); PG8_WAIT_L(0); PG8_BAR; PG8_MMA(0, 0, At, B0); PG8_MMA(0, 1, At, B1); PG8_BAR; PG8_SCHED;
            PG8_LDA(At, 0, 1); PG8_STAGE(PG8_SB(0, 0), b2, voffB); PG8_STAGE(PG8_SB(0, 1), b2 + hstepB, voffB); PG8_STAGE(PG8_SA(0, 0), a2, voffA);
            PG8_WAIT_V(8); PG8_WAIT_L(0); PG8_BAR; PG8_MMA(1, 0, At, B0); PG8_MMA(1, 1, At, B1); PG8_BAR; PG8_SCHED;
            PG8_LDB(B0, 1, 0); PG8_LDB(B1, 1, 1); PG8_SCHED; PG8_LDA(At, 1, 0); PG8_STAGE(PG8_SA(0, 1), a2 + hstepA, voffA);
            PG8_WAIT_V(8); PG8_WAIT_L(0); PG8_BAR; PG8_MMA(0, 0, At, B0); PG8_MMA(0, 1, At, B1); PG8_BAR; PG8_SCHED;
            PG8_LDA(At, 1, 1); PG8_STAGE(PG8_SB(1, 0), b3, voffB); PG8_STAGE(PG8_SB(1, 1), b3 + hstepB, voffB); PG8_STAGE(PG8_SA(1, 0), a3, voffA);
            PG8_WAIT_V(8); PG8_WAIT_L(0); PG8_BAR; PG8_MMA(1, 0, At, B0); PG8_MMA(1, 1, At, B1); PG8_BAR; PG8_SCHED;
        }
        if constexpr (ALIGN_EPI) { if (wr == 0) PG8_BAR; }
        E(acc, cur, wr, wc, fr, fq);
        if (!has_next) break;
#pragma unroll
        for (int a = 0; a < 2; ++a)
#pragma unroll
            for (int b = 0; b < 2; ++b)
#pragma unroll
                for (int m = 0; m < 4; ++m)
#pragma unroll
                    for (int n = 0; n < 2; ++n) acc[a][b][m][n] = (f32x4){0.f, 0.f, 0.f, 0.f};
        cur = nxt; cA = nA; cB = nB; ++ui;
        if constexpr (ALIGN_EPI) { if (wr == 1) PG8_BAR; }
    }
    PG8_WAIT_V(0);
    if constexpr (!ALIGN_EPI) { if (wr == 0) PG8_BAR; }
    PG8_BAR;
#undef PG8_SA
#undef PG8_SB
#undef PG8_STAGE
#undef PG8_LDA
#undef PG8_LDB
#undef PG8_MMA
#undef PG8_WAIT_V
#undef PG8_WAIT_L
#undef PG8_BAR
#undef PG8_SCHED
}
}

using pg8::bf16_t; using pg8::f32x4; using pg8::u32x4; using pg8::u32x2; using pg8::bf16x8; using pg8::cvt_pk_bf16;
typedef float f32x16 __attribute__((ext_vector_type(16)));

constexpr int NB = 8, SEQ = 4096, DM = 1024, T = NB * SEQ;
constexpr int NPROJ = 5632;
constexpr int IN_COLS = 5408, DFF = 2816;
constexpr size_t MiB = 1u << 20;
constexpr size_t WS_CTL = 0;
constexpr size_t WS_WIN = 1 * MiB, WS_WUP = 12 * MiB, WS_WDN = 23 * MiB, WS_WOUT = 29 * MiB, WS_WBA = 31 * MiB, WS_WBB = 32 * MiB;
constexpr size_t WS_WD = 33 * MiB, WS_WA = 33 * MiB + 256 * 1024, WS_WG = 33 * MiB + 512 * 1024;
constexpr size_t WS_KMEAN = 34 * MiB, WS_SBON = 35 * MiB, WS_SSQ = 36 * MiB;
constexpr size_t WS_GP = 38 * MiB, WS_ZR = 166 * MiB, WS_ZM = 294 * MiB, WS_HB = 390 * MiB, WS_EX = 454 * MiB, WS_END = 486 * MiB;
constexpr size_t WS_E = WS_HB, WS_ALR = WS_HB + 32 * MiB, WS_G = WS_EX;
constexpr size_t WS_R = WS_ZM, WS_K = WS_ZM + 32 * MiB, WS_V = WS_ZM + 64 * MiB;
constexpr size_t WS_YA = WS_ZM + 64 * MiB,         WS_MG = WS_ZM, WS_X1B = WS_HB, WS_U = WS_GP;
constexpr size_t OUT_LA = 0, OUT_KK = 0, OUT_Q = 32 * MiB, OUT_KP = 64 * MiB, OUT_VT = 96 * MiB;
constexpr int LDS_BYTES = 147456, LDS_MISC = 131072;

struct Params {
    const float* in[25]; float* out; unsigned char* ws; int lo, hi; int rep[14];
};
enum { I_X = 0, I_POS, I_N1G, I_WIN, I_MU, I_WDU, I_DB, I_WAU, I_AB, I_WGU, I_KK, I_KA, I_RK, I_LNG, I_LNB, I_QNG, I_KNG, I_WBA, I_WBB, I_WOUT, I_N2G, I_WUP, I_CW, I_CB, I_WDN };

__device__ __forceinline__ float bf_lo(unsigned w) { return __uint_as_float(w << 16); }
__device__ __forceinline__ float bf_hi(unsigned w) { return __uint_as_float(w & 0xffff0000u); }
__device__ __forceinline__ void unpack8(const u32x4 w, float* f) { f[0] = bf_lo(w.x); f[1] = bf_hi(w.x); f[2] = bf_lo(w.y); f[3] = bf_hi(w.y); f[4] = bf_lo(w.z); f[5] = bf_hi(w.z); f[6] = bf_lo(w.w); f[7] = bf_hi(w.w); }
__device__ __forceinline__ u32x4 pack8(const float* f) { u32x4 w; w.x = cvt_pk_bf16(f[0], f[1]); w.y = cvt_pk_bf16(f[2], f[3]); w.z = cvt_pk_bf16(f[4], f[5]); w.w = cvt_pk_bf16(f[6], f[7]); return w; }
__device__ __forceinline__ size_t hm_idx(size_t t, int c) { return ((((t >> 12) * 8 + (size_t)(c >> 6)) * 4096 + (t & 4095)) << 6) + (size_t)(c & 63); }
__device__ __forceinline__ float sigmoidf_(float x) { return 1.f / (1.f + __expf(-x)); }
__device__ __forceinline__ float wave_sum(float v) {
#pragma unroll
    for (int o = 1; o < 64; o <<= 1) v += __shfl_xor(v, o);
    return v;
}

__device__ __forceinline__ float gelu_erf(float v) {
    const float av = fabsf(v), t = __builtin_amdgcn_rcpf(av * 0.2316418882f + 1.0f);
    float q = t * 0.5307027145f + (-0.7265760135f); q = q * t + 0.7107068705f; q = q * t + (-0.142248368f); q = q * t + 0.127414796f; q = q * t;
    const float e = __builtin_amdgcn_exp2f((v * v) * (-0.72134752044f));
    const float m = v * (q * e);
    return v < 0.f ? m : v - m;
}
template <int CTRL> __device__ __forceinline__ float dpp_mov0(float x) { return __int_as_float(__builtin_amdgcn_update_dpp(0, __float_as_int(x), CTRL, 0xF, 0xF, false)); }
struct EpiProj {
    static constexpr bool PERM = true;
    bf16_t* zr; bf16_t* zm; bf16_t* gp; bf16_t* la; const float* mu; bool dry;
    __device__ __forceinline__ void operator()(const f32x4 (&acc)[2][2][4][2], const pg8::Unit& u, int wr, int wc, int fr, int fq) const {
        if (u.pn == 6 || u.pn == 7) {
            const int row0 = u.pm * 256 + wr * 64 + fr;
#pragma unroll
            for (int bj = 0; bj < 2; ++bj) {
                const int c = u.pn * 256 + bj * 128 + wc * 32 + 8 * fq;
                const int mode = c < 1600 ? 1 : (c < 1664 ? 0 : (c < 1824 ? 2 : 3));
                const int kq = c - 1824;
                const int dc = c < 1600 ? c - 1536 : (c < 1664 ? c - 1600 + 128 : (c < 1824 ? c - 1664 + 256 : (kq < 64 ? 64 + kq : (kq < 128 ? 192 + (kq - 64) : 416 + (kq - 128)))));
                const int mc_ = mode == 3 ? 0 : c;
                const f32x4 mu0 = *(const f32x4*)(mu + mc_), mu1 = *(const f32x4*)(mu + mc_ + 4);
#pragma unroll
                for (int ai = 0; ai < 2; ++ai)
#pragma unroll
                    for (int m = 0; m < 4; ++m) { const size_t row = (size_t)(row0 + ai * 128 + m * 16); float o[8], rawv[8];
#pragma unroll
                        for (int i = 0; i < 8; ++i) { const float cur = acc[ai][bj][m][i >> 2][i & 3];
                            const float oldv = m > 0 ? dpp_mov0<0x121>(acc[ai][bj][m > 0 ? m - 1 : 0][i >> 2][i & 3]) : 0.f;
                            const float prev = __int_as_float(__builtin_amdgcn_update_dpp(__float_as_int(oldv), __float_as_int(cur), 0x111, 0xF, 0xF, false));
                            const float mui = i < 4 ? mu0[i & 3] : mu1[i & 3];
                            const float z = cur + mui * (prev - cur), zz = mode == 1 ? 2.f * z : z, sg = 1.f / (1.f + __expf(-zz));
                            o[i] = mode == 1 ? 2.f * sg - 1.f : (mode == 2 ? sg : (mode == 0 ? z : 0.f)); rawv[i] = cur; }
                        if (!(m == 0 && fr == 0)) *(u32x4*)(la + row * 512 + dc) = pack8(o);
                        if ((m == 0 && fr == 0) || (m == 3 && fr == 15)) *(u32x4*)(zr + row * 2048 + c) = pack8(rawv);
                        asm volatile("" ::: "memory"); }
            }
            return;
        }
        bf16_t* base; int ldc, colt;
        if (u.pn < 8) { base = zr; ldc = 2048; colt = u.pn * 256; } else if (u.pn < 14) { base = zm; ldc = 1536; colt = (u.pn - 8) * 256; } else { base = gp; ldc = 2048; colt = (u.pn - 14) * 256; }
        const int row0 = u.pm * 256 + wr * 64 + fr, col0 = colt + wc * 32 + 8 * fq;
#pragma unroll
        for (int ai = 0; ai < 2; ++ai)
#pragma unroll
            for (int m = 0; m < 4; ++m) { bf16_t* rowp = base + (size_t)(row0 + ai * 128 + m * 16) * ldc + col0;
#pragma unroll
                for (int bj = 0; bj < 2; ++bj) { const f32x4 v0 = acc[ai][bj][m][0], v1 = acc[ai][bj][m][1]; u32x4 w;
                    w.x = cvt_pk_bf16(v0[0], v0[1]); w.y = cvt_pk_bf16(v0[2], v0[3]); w.z = cvt_pk_bf16(v1[0], v1[1]); w.w = cvt_pk_bf16(v1[2], v1[3]);
                    if (!dry) *(u32x4*)(rowp + bj * 128) = w; } }
    }
};
struct EpiLora {
    static constexpr bool PERM = true;
    bf16_t* O; const float* bias; int mode;
    __device__ __forceinline__ void operator()(const f32x4 (&acc)[2][2][4][2], const pg8::Unit& u, int wr, int wc, int fr, int fq) const {
        const int row0 = u.pm * 256 + wr * 64 + fr, col0 = u.pn * 256 + wc * 32 + 8 * fq;
        const float sc = mode == 0 ? 0.6065306597126334f : 1.f;
#pragma unroll
        for (int bj = 0; bj < 2; ++bj) {
            f32x4 b0 = {0.f, 0.f, 0.f, 0.f}, b1 = {0.f, 0.f, 0.f, 0.f};
            if (mode != 2) { b0 = *(const f32x4*)(bias + col0 + bj * 128); b1 = *(const f32x4*)(bias + col0 + bj * 128 + 4); }
#pragma unroll
            for (int ai = 0; ai < 2; ++ai)
#pragma unroll
                for (int m = 0; m < 4; ++m) { const size_t row_ = (size_t)(row0 + ai * 128 + m * 16); bf16_t* rowp = O + (mode == 2 ? row_ * 512 + col0 + bj * 128 : hm_idx(row_, col0 + bj * 128));
                    f32x4 v0 = acc[ai][bj][m][0] + b0, v1 = acc[ai][bj][m][1] + b1;
                    if (mode != 2) {
#pragma unroll
                        for (int i = 0; i < 4; ++i) { v0[i] = sigmoidf_(v0[i]) * sc; v1[i] = sigmoidf_(v1[i]) * sc; } }
                    u32x4 w; w.x = cvt_pk_bf16(v0[0], v0[1]); w.y = cvt_pk_bf16(v0[2], v0[3]); w.z = cvt_pk_bf16(v1[0], v1[1]); w.w = cvt_pk_bf16(v1[2], v1[3]);
                    *(u32x4*)rowp = w;
                    asm volatile("" ::: "memory"); }
        }
    }
};
struct EpiBranch {
    static constexpr bool PERM = true;
    bf16_t* MG; const bf16_t* GP; int second;
    __device__ __forceinline__ void operator()(const f32x4 (&acc)[2][2][4][2], const pg8::Unit& u, int wr, int wc, int fr, int fq) const {
        const int row0 = u.pm * 256 + wr * 64 + fr, col0 = u.pn * 256 + wc * 32 + 8 * fq;
        u32x4 cg[2], cm[2], ng[2], nm[2];
#pragma unroll
        for (int bj = 0; bj < 2; ++bj) { cg[bj] = *(const u32x4*)(GP + (size_t)row0 * 2048 + second * 1024 + col0 + bj * 128);
            cm[bj] = second ? *(const u32x4*)(MG + (size_t)row0 * 1024 + col0 + bj * 128) : (u32x4){0u, 0u, 0u, 0u}; ng[bj] = cg[bj]; nm[bj] = cm[bj]; }
#pragma unroll
        for (int g = 0; g < 8; ++g) { const int ai = g >> 2, m = g & 3; const size_t row = (size_t)(row0 + ai * 128 + m * 16);
            if (g + 1 < 8) { const size_t rown = (size_t)(row0 + ((g + 1) >> 2) * 128 + ((g + 1) & 3) * 16);
#pragma unroll
                for (int bj = 0; bj < 2; ++bj) { ng[bj] = *(const u32x4*)(GP + rown * 2048 + second * 1024 + col0 + bj * 128);
                    if (second) nm[bj] = *(const u32x4*)(MG + rown * 1024 + col0 + bj * 128); }
                asm volatile("" ::: "memory"); }
#pragma unroll
            for (int bj = 0; bj < 2; ++bj) { const int col = col0 + bj * 128; float v[8], gt[8], pv[8];
#pragma unroll
                for (int i = 0; i < 4; ++i) { v[i] = acc[ai][bj][m][0][i]; v[4 + i] = acc[ai][bj][m][1][i]; }
                unpack8(cg[bj], gt); unpack8(cm[bj], pv);
#pragma unroll
                for (int i = 0; i < 8; ++i) v[i] = v[i] * sigmoidf_(gt[i]) + pv[i];
                *(u32x4*)(MG + row * 1024 + col) = pack8(v); }
#pragma unroll
            for (int bj = 0; bj < 2; ++bj) { cg[bj] = ng[bj]; cm[bj] = nm[bj]; } }
    }
};
struct EpiOut {
    static constexpr bool PERM = true;
    const float* x; float* x1; bf16_t* x1b; float* ssq;
    __device__ __forceinline__ void operator()(const f32x4 (&acc)[2][2][4][2], const pg8::Unit& u, int wr, int wc, int fr, int fq) const {
        const int row0 = u.pm * 256 + wr * 64 + fr, col0 = u.pn * 256 + wc * 32 + 8 * fq;
        f32x4 cur[2][2], nxt[2][2];
#pragma unroll
        for (int bj = 0; bj < 2; ++bj)
#pragma unroll
            for (int n = 0; n < 2; ++n) { cur[bj][n] = *(const f32x4*)(x + (size_t)row0 * 1024 + col0 + bj * 128 + n * 4); nxt[bj][n] = cur[bj][n]; }
#pragma unroll
        for (int g = 0; g < 8; ++g) { const int ai = g >> 2, m = g & 3; const size_t row = (size_t)(row0 + ai * 128 + m * 16); float s = 0.f;
            if (g + 1 < 8) { const size_t rown = (size_t)(row0 + ((g + 1) >> 2) * 128 + ((g + 1) & 3) * 16);
#pragma unroll
                for (int bj = 0; bj < 2; ++bj)
#pragma unroll
                    for (int n = 0; n < 2; ++n) nxt[bj][n] = *(const f32x4*)(x + rown * 1024 + col0 + bj * 128 + n * 4);
                asm volatile("" ::: "memory"); }
#pragma unroll
            for (int bj = 0; bj < 2; ++bj) { const size_t off = row * 1024 + col0 + bj * 128;
                const f32x4 r0 = cur[bj][0] + acc[ai][bj][m][0], r1 = cur[bj][1] + acc[ai][bj][m][1];
                u32x4 w; w.x = cvt_pk_bf16(r0[0], r0[1]); w.y = cvt_pk_bf16(r0[2], r0[3]); w.z = cvt_pk_bf16(r1[0], r1[1]); w.w = cvt_pk_bf16(r1[2], r1[3]);
                *(u32x4*)(x1b + off) = w;
                s += ((r0[0] * r0[0] + r0[1] * r0[1]) + (r0[2] * r0[2] + r0[3] * r0[3])) + ((r1[0] * r1[0] + r1[1] * r1[1]) + (r1[2] * r1[2] + r1[3] * r1[3])); }
            s += __shfl_xor(s, 16); s += __shfl_xor(s, 32);
            if (fq == 0) ssq[row * 16 + u.pn * 4 + wc] = s;
#pragma unroll
            for (int bj = 0; bj < 2; ++bj)
#pragma unroll
                for (int n = 0; n < 2; ++n) cur[bj][n] = nxt[bj][n]; }
    }
};
template <int CTRL> __device__ __forceinline__ float dpp_mov(float x) { return __int_as_float(__builtin_amdgcn_update_dpp(0, __float_as_int(x), CTRL, 0xF, 0xF, false)); }
struct EpiUp {
    static constexpr bool PERM = true;
    bf16_t* U; const float* ssq; const float* cw; const float* cb;
    __device__ __forceinline__ void operator()(const f32x4 (&acc)[2][2][4][2], const pg8::Unit& u, int wr, int wc, int fr, int fq) const {
        const int row0 = u.pm * 256 + wr * 64 + fr, cl = u.pn * 128 + wc * 32 + 8 * fq;
#pragma unroll
        for (int n = 0; n < 2; ++n) {
            const int c4 = cl + 4 * n;
            const f32x4 w0 = *(const f32x4*)(cw + c4), w1 = *(const f32x4*)(cw + DFF + c4), w2 = *(const f32x4*)(cw + 2 * DFF + c4), bs = *(const f32x4*)(cb + c4);
            f32x4 cs4[4], ns4[4];
            f32x4 avp = {0.f, 0.f, 0.f, 0.f};
#pragma unroll
            for (int q = 0; q < 4; ++q) { cs4[q] = ((const f32x4*)(ssq + (size_t)row0 * 16))[q]; ns4[q] = cs4[q]; }
#pragma unroll
            for (int g = 0; g < 8; ++g) { const int ai = g >> 2, m = g & 3; const size_t row = (size_t)(row0 + ai * 128 + m * 16);
                if (g + 1 < 8) { const size_t rown = (size_t)(row0 + ((g + 1) >> 2) * 128 + ((g + 1) & 3) * 16);
#pragma unroll
                    for (int q = 0; q < 4; ++q) ns4[q] = ((const f32x4*)(ssq + rown * 16))[q];
                    asm volatile("" ::: "memory"); }
                const f32x4 sa_ = cs4[0], sb_ = cs4[1], sc_ = cs4[2], sd_ = cs4[3];
                const float ss = ((sa_[0] + sa_[1]) + (sa_[2] + sa_[3])) + ((sb_[0] + sb_[1]) + (sb_[2] + sb_[3])) + ((sc_[0] + sc_[1]) + (sc_[2] + sc_[3])) + ((sd_[0] + sd_[1]) + (sd_[2] + sd_[3]));
                const float rstd = rsqrtf(ss * (1.f / 1024.f) + 1e-6f);
                const f32x4 av = acc[ai][0][m][n] * rstd, bv = acc[ai][1][m][n] * rstd; f32x4 o;
#pragma unroll
                for (int i = 0; i < 4; ++i) {
                    const float o1 = m > 0 ? dpp_mov<0x121>(avp[i]) : 0.f, o2 = m > 0 ? dpp_mov<0x122>(avp[i]) : 0.f;
                    const float p1 = __int_as_float(__builtin_amdgcn_update_dpp(__float_as_int(o1), __float_as_int(av[i]), 0x111, 0xF, 0xF, false));
                    const float p2 = __int_as_float(__builtin_amdgcn_update_dpp(__float_as_int(o2), __float_as_int(av[i]), 0x112, 0xF, 0xF, false));
                    const float v = w0[i] * p2 + w1[i] * p1 + w2[i] * av[i] + bs[i]; o[i] = gelu_erf(v) * bv[i]; }
                bf16_t* ua = U + row * NPROJ + c4; bf16_t* ub = ua + DFF;
                u32x2 pa, pb, po; pa.x = cvt_pk_bf16(av[0], av[1]); pa.y = cvt_pk_bf16(av[2], av[3]); pb.x = cvt_pk_bf16(bv[0], bv[1]); pb.y = cvt_pk_bf16(bv[2], bv[3]);
                po.x = cvt_pk_bf16(o[0], o[1]); po.y = cvt_pk_bf16(o[2], o[3]);
                if (fr >= 2 || m > 0) { *(u32x2*)ub = po; if (fr >= 14 && m == 3) *(u32x2*)ua = pa; }
                else { *(u32x2*)ua = pa; *(u32x2*)ub = pb; }
                avp = av;
#pragma unroll
                for (int q = 0; q < 4; ++q) cs4[q] = ns4[q]; }
        }
    }
};
struct EpiDown {
    static constexpr bool PERM = true;
    float* out; const bf16_t* x1b; bool dry;
    __device__ __forceinline__ void operator()(const f32x4 (&acc)[2][2][4][2], const pg8::Unit& u, int wr, int wc, int fr, int fq) const {
        const int row0 = u.pm * 256 + wr * 64 + fr, col0 = u.pn * 256 + wc * 32 + 8 * fq;
        u32x4 cur[2], nxt[2];
#pragma unroll
        for (int bj = 0; bj < 2; ++bj) { cur[bj] = *(const u32x4*)(x1b + (size_t)row0 * 1024 + col0 + bj * 128); nxt[bj] = cur[bj]; }
#pragma unroll
        for (int g = 0; g < 8; ++g) { const int ai = g >> 2, m = g & 3; const size_t row = (size_t)(row0 + ai * 128 + m * 16);
            if (g + 1 < 8) { const size_t rown = (size_t)(row0 + ((g + 1) >> 2) * 128 + ((g + 1) & 3) * 16);
#pragma unroll
                for (int bj = 0; bj < 2; ++bj) nxt[bj] = *(const u32x4*)(x1b + rown * 1024 + col0 + bj * 128);
                asm volatile("" ::: "memory"); }
#pragma unroll
            for (int bj = 0; bj < 2; ++bj) { const size_t off = row * 1024 + col0 + bj * 128; const u32x4 xb = cur[bj];
                const f32x4 x0 = {bf_lo(xb.x), bf_hi(xb.x), bf_lo(xb.y), bf_hi(xb.y)}, x1 = {bf_lo(xb.z), bf_hi(xb.z), bf_lo(xb.w), bf_hi(xb.w)};
                const f32x4 r0 = x0 + acc[ai][bj][m][0], r1 = x1 + acc[ai][bj][m][1];
                if (!dry) { *(f32x4*)(out + off) = r0; *(f32x4*)(out + off + 4) = r1; } }
#pragma unroll
            for (int bj = 0; bj < 2; ++bj) cur[bj] = nxt[bj]; }
    }
};

__device__ __forceinline__ void tr_item(const float* W, int Ksrc, int Nsrc, int srccol0, const float* rowscale, bf16_t* WT, int ldk, int n0, int k0, float* scr, int lane) {
    float v[32]; const int nn = lane & 31; const bool colok = srccol0 >= 0; const float* Wc = W + (colok ? srccol0 : 0) + nn;
#pragma unroll
    for (int i = 0; i < 32; ++i) { const int k = k0 + 2 * i + (lane >> 5); const bool ok = colok && k < Ksrc; const int kc = ok ? k : 0;
        float t = Wc[(size_t)kc * Nsrc]; if (rowscale) t *= rowscale[kc]; v[i] = ok ? t : 0.f; }
#pragma unroll
    for (int i = 0; i < 32; ++i) scr[(2 * i + (lane >> 5)) * 33 + nn] = v[i];
    asm volatile("s_waitcnt lgkmcnt(0)" ::: "memory");
    const int c = lane & 7;
#pragma unroll
    for (int j = 0; j < 4; ++j) { const int n = (lane >> 3) + 8 * j; const float* s = scr + (8 * c) * 33 + n;
        u32x4 o; o.x = cvt_pk_bf16(s[0 * 33], s[1 * 33]); o.y = cvt_pk_bf16(s[2 * 33], s[3 * 33]); o.z = cvt_pk_bf16(s[4 * 33], s[5 * 33]); o.w = cvt_pk_bf16(s[6 * 33], s[7 * 33]);
        *(u32x4*)(WT + (size_t)(n0 + n) * ldk + k0 + 8 * c) = o; }
    asm volatile("s_waitcnt lgkmcnt(0)" ::: "memory");
}
__device__ __forceinline__ void phase0(const Params& p, unsigned char* lds) {
    const int tid = threadIdx.x, lane = tid & 63, wave = tid >> 6;
    float* scr = (float*)(lds + wave * 16384);
    const int gw = blockIdx.x * 8 + wave, NGW = gridDim.x * 8;
    unsigned char* ws = p.ws;
    constexpr int I_1 = 16 * 176, I_2 = 16 * 176, I_3 = 44 * 32, I_4 = 16 * 32, I_5 = 8 * 32, I_6 = 8 * 32, I_7 = 2 * 16, I_8 = 2 * 16, I_9 = 4 * 16;
    constexpr int NIT = I_1 + I_2 + I_3 + I_4 + I_5 + I_6 + I_7 + I_8 + I_9;
    for (int it = gw; it < NIT; it += NGW) {
        int r = it;
        if (r < I_1) { const int kb = r / 176, nb = r % 176, n0 = nb * 32; const int sc = n0 < 1824 ? n0 : (n0 < 2048 ? -1 : n0 - 224);
            tr_item(p.in[I_WIN], 1024, IN_COLS, sc, nullptr, (bf16_t*)(ws + WS_WIN), 1024, n0, kb * 64, scr, lane); continue; } r -= I_1;
        if (r < I_2) { const int kb = r / 176, nb = r % 176; const int n0 = nb * 32, pn_ = n0 >> 8, w_ = n0 & 255; const int sc = w_ < 128 ? 128 * pn_ + w_ : DFF + 128 * pn_ + (w_ - 128);
            tr_item(p.in[I_WUP], 1024, 5632, sc, p.in[I_N2G], (bf16_t*)(ws + WS_WUP), 1024, n0, kb * 64, scr, lane); continue; } r -= I_2;
        if (r < I_3) { const int kb = r / 32, nb = r % 32; tr_item(p.in[I_WDN], 2816, 1024, nb * 32, nullptr, (bf16_t*)(ws + WS_WDN), 2816, nb * 32, kb * 64, scr, lane); continue; } r -= I_3;
        if (r < I_4) { const int kb = r / 32, nb = r % 32; tr_item(p.in[I_WOUT], 1024, 1024, nb * 32, nullptr, (bf16_t*)(ws + WS_WOUT), 1024, nb * 32, kb * 64, scr, lane); continue; } r -= I_4;
        if (r < I_5) { const int kb = r / 32, nb = r % 32; tr_item(p.in[I_WBA], 512, 1024, nb * 32, nullptr, (bf16_t*)(ws + WS_WBA), 512, nb * 32, kb * 64, scr, lane); continue; } r -= I_5;
        if (r < I_6) { const int kb = r / 32, nb = r % 32; tr_item(p.in[I_WBB], 512, 1024, nb * 32, nullptr, (bf16_t*)(ws + WS_WBB), 512, nb * 32, kb * 64, scr, lane); continue; } r -= I_6;
        if (r < I_7) { const int kb = r / 16, nb = r % 16; tr_item(p.in[I_WDU], 64, 512, nb * 32, nullptr, (bf16_t*)(ws + WS_WD), 128, nb * 32, kb * 64, scr, lane); continue; } r -= I_7;
        if (r < I_8) { const int kb = r / 16, nb = r % 16; tr_item(p.in[I_WAU], 64, 512, nb * 32, nullptr, (bf16_t*)(ws + WS_WA), 128, nb * 32, kb * 64, scr, lane); continue; } r -= I_8;
        { const int kb = r / 16, nb = r % 16; tr_item(p.in[I_WGU], 160, 512, nb * 32, nullptr, (bf16_t*)(ws + WS_WG), 256, nb * 32, kb * 64, scr, lane); }
    }
    const float* x = p.in[I_X]; const float* g1 = p.in[I_N1G]; bf16_t* hb = (bf16_t*)(ws + WS_HB);
    f32x4 gv[4];
#pragma unroll
    for (int j = 0; j < 4; ++j) gv[j] = *(const f32x4*)(g1 + 4 * lane + 256 * j);
    for (int m0 = gw; m0 < T; m0 += 4 * NGW) {
        f32x4 v[4][4];
#pragma unroll
        for (int j = 0; j < 4; ++j) { const f32x4* xr = (const f32x4*)(x + (size_t)(m0 + j * NGW) * DM) + lane;
#pragma unroll
            for (int q = 0; q < 4; ++q) v[j][q] = xr[64 * q]; }
#pragma unroll
        for (int j = 0; j < 4; ++j) { float s = 0.f;
#pragma unroll
            for (int q = 0; q < 4; ++q) s += (v[j][q][0] * v[j][q][0] + v[j][q][1] * v[j][q][1]) + (v[j][q][2] * v[j][q][2] + v[j][q][3] * v[j][q][3]);
            const float rstd = rsqrtf(wave_sum(s) * (1.f / DM) + 1e-6f);
            u32x2* o8 = (u32x2*)(hb + (size_t)(m0 + j * NGW) * DM) + lane;
#pragma unroll
            for (int q = 0; q < 4; ++q) { const f32x4 y = v[j][q] * rstd * gv[q]; u32x2 w; w.x = cvt_pk_bf16(y[0], y[1]); w.y = cvt_pk_bf16(y[2], y[3]); o8[64 * q] = w; } }
    }
}

__device__ __forceinline__ void phase2(const Params& p, unsigned char* lds, int parts) {
    const int tid = threadIdx.x;
    unsigned char* ws = p.ws;
    const bf16_t* ZM = (const bf16_t*)(ws + WS_ZM); const bf16_t* ZR = (const bf16_t*)(ws + WS_ZR);
    bf16_t* Qp = (bf16_t*)((unsigned char*)p.out + OUT_Q); bf16_t* Kp = (bf16_t*)((unsigned char*)p.out + OUT_KP); bf16_t* VT = (bf16_t*)((unsigned char*)p.out + OUT_VT);
    bf16_t* LA = (bf16_t*)((unsigned char*)p.out + OUT_LA);
    float* KMEAN = (float*)(ws + WS_KMEAN);
    const int* pos = (const int*)p.in[I_POS];
    float* kl = (float*)lds;
    unsigned short* vl = (unsigned short*)(lds + 256 * 65 * 4);
    const int tok = tid >> 1, half = tid & 1;
    const float rvh[8] = {0.15915493667125702f, 0.030863763764500618f, 0.005985185503959656f, 0.0011606636689975858f, 0.0002250790857942775f, 4.3647953134495765e-05f, 8.464330676360987e-06f, 1.6414262518082978e-06f};
    const float rvl[8] = {6.4206382432985265e-09f, -6.060805191054897e-10f, 1.7242327010613678e-10f, -4.8028716420622786e-11f, -6.753226016592562e-12f, 1.6772382094298877e-12f, -1.2670839041623722e-13f, -9.854460929453572e-15f};
    u32x4 nraw[2][4]; int npos = 0;
#define P2_LOAD(it_) do { const int h_ = (it_) & 7, blk_ = ((it_) >> 3) & 15, b_ = (it_) >> 7; const size_t t_ = (size_t)b_ * SEQ + blk_ * 256 + tok; npos = pos[t_]; \
        _Pragma("unroll") for (int w3 = 1; w3 < 2; ++w3) _Pragma("unroll") for (int j = 0; j < 4; ++j) nraw[w3][j] = *(const u32x4*)(ZM + t_ * 1536 + w3 * 512 + h_ * 64 + 32 * half + 8 * j); } while (0)
    if ((parts & 1) && (int)blockIdx.x < 1024) P2_LOAD((int)blockIdx.x);
    if (parts & 1)
    for (int item = blockIdx.x; item < 1024; item += gridDim.x) {
        const int h = item & 7, blk = (item >> 3) & 15, b = item >> 7;
        const size_t t = (size_t)b * SEQ + blk * 256 + tok;
        u32x4 raw[2][4]; const int cpos = npos;
#pragma unroll
        for (int w3 = 1; w3 < 2; ++w3)
#pragma unroll
            for (int j = 0; j < 4; ++j) raw[w3][j] = nraw[w3][j];
        if (item + (int)gridDim.x < 1024) P2_LOAD(item + (int)gridDim.x);
        float cs[8], sn[8];
        { const float ps = (float)cpos;
#pragma unroll
          for (int i = 0; i < 8; ++i) { const float hi_ = ps * rvh[i], lo_ = fmaf(ps, rvh[i], -hi_) + ps * rvl[i];
              const float fx = (hi_ - floorf(hi_)) + lo_; sn[i] = __builtin_amdgcn_sinf(fx); cs[i] = __builtin_amdgcn_cosf(fx); } }
#pragma unroll
        for (int which = 1; which < 2; ++which) {
            const float* gg = p.in[which ? I_KNG : I_QNG] + 32 * half;
            float v[32];
#pragma unroll
            for (int j = 0; j < 4; ++j) unpack8(raw[which][j], v + 8 * j);
            float ss = 0.f;
#pragma unroll
            for (int i = 0; i < 32; ++i) ss += v[i] * v[i];
            ss += __shfl_xor(ss, 1);
            const float rstd = rsqrtf(ss * (1.f / 64.f) + 1e-6f);
#pragma unroll
            for (int i = 0; i < 32; ++i) v[i] = v[i] * rstd * gg[i];
            if (half == 0) {
#pragma unroll
                for (int i = 0; i < 8; ++i) { const float x1 = v[i], x2 = v[8 + i]; v[i] = x1 * cs[i] - x2 * sn[i]; v[8 + i] = x2 * cs[i] + x1 * sn[i]; }
            }
            bf16_t* dst = (which ? Kp : Qp) + t * 512 + h * 64 + 32 * half;
#pragma unroll
            for (int j = 0; j < 4; ++j) *(u32x4*)(dst + 8 * j) = pack8(v + 8 * j);
            if (which == 1) {
#pragma unroll
                for (int i = 0; i < 32; ++i) kl[tok * 65 + 32 * half + i] = v[i];
            }
        }
        __syncthreads();
        { float* kp = (float*)(lds + 256 * 65 * 4); const int d_ = tid & 63, part = tid >> 6; float s0_ = 0.f, s1_ = 0.f;
#pragma unroll 8
          for (int r = 0; r < 32; r += 2) { s0_ += kl[(part * 32 + r) * 65 + d_]; s1_ += kl[(part * 32 + r + 1) * 65 + d_]; }
          kp[part * 64 + d_] = s0_ + s1_; }
        __syncthreads();
        if (tid < 64) { const float* kp = (const float*)(lds + 256 * 65 * 4); float s_ = 0.f;
#pragma unroll
            for (int q8 = 0; q8 < 8; ++q8) s_ += kp[q8 * 64 + tid];
            KMEAN[((size_t)(b * 8 + h) * 16 + blk) * 64 + tid] = s_ * (1.f / 256.f); }
    }
    __syncthreads();
    const float* mu = p.in[I_MU];
    const size_t NG = (parts & 2) ? (size_t)(T / 64) * 64 : 0;
    for (size_t idx = (size_t)blockIdx.x * 512 + tid; idx < NG; idx += (size_t)gridDim.x * 512) {
        const size_t t = (idx >> 6) * 64; const int dc = (int)(idx & 63) * 8; int sc = -1, mode = 0;
        if (dc < 64) { sc = 1536 + dc; mode = 1; } else if (dc >= 128 && dc < 192) { sc = 1600 + dc - 128; mode = 0; } else if (dc >= 256 && dc < 416) { sc = 1664 + dc - 256; mode = 2; }
        float v[8];
#pragma unroll
        for (int i = 0; i < 8; ++i) v[i] = 0.f;
        if (sc >= 0) { float a[8], pr[8]; unpack8(*(const u32x4*)(ZR + t * 2048 + sc), a);
            if ((t & (SEQ - 1)) != 0) unpack8(*(const u32x4*)(ZR + (t - 1) * 2048 + sc), pr); else {
#pragma unroll
                for (int i = 0; i < 8; ++i) pr[i] = 0.f; }
#pragma unroll
            for (int i = 0; i < 8; ++i) { const float z = a[i] + mu[sc + i] * (pr[i] - a[i]); v[i] = mode == 1 ? tanhf(z) : (mode == 2 ? sigmoidf_(z) : z); } }
        *(u32x4*)(LA + t * 512 + dc) = pack8(v);
    }
}

__device__ __forceinline__ void phase4(const Params& p) {
    const int tid = threadIdx.x; unsigned char* ws = p.ws;
    const bf16_t* ZR = (const bf16_t*)(ws + WS_ZR); const bf16_t* ALR = (const bf16_t*)(ws + WS_ALR);
    bf16_t* R = (bf16_t*)(ws + WS_R); bf16_t* K = (bf16_t*)(ws + WS_K); bf16_t* V = (bf16_t*)(ws + WS_V); bf16_t* KK = (bf16_t*)((unsigned char*)p.out + OUT_KK);
    float* SBON = (float*)(ws + WS_SBON);
    const float* mu = p.in[I_MU]; const float* k_k = p.in[I_KK]; const float* k_a = p.in[I_KA]; const float* r_k = p.in[I_RK];
    const size_t NG = (size_t)(T / 2) * 64;
    for (size_t idx = (size_t)blockIdx.x * 512 + tid; idx < NG; idx += (size_t)gridDim.x * 512) {
        const size_t t0 = (idx >> 6) * 2; const int c0 = (int)(idx & 63) * 8;
        const bool first = (t0 & (SEQ - 1)) == 0;
        u32x4 raw[3][3], ral[2];
#pragma unroll
        for (int j = 0; j < 3; ++j)
#pragma unroll
            for (int w3 = 0; w3 < 3; ++w3) { if (j > 0 || !first) raw[j][w3] = *(const u32x4*)(ZR + (t0 + j - 1) * 2048 + w3 * 512 + c0); else raw[j][w3] = (u32x4){0u, 0u, 0u, 0u}; }
        const size_t hm0 = hm_idx(t0, c0);
        ral[0] = *(const u32x4*)(ALR + hm0); ral[1] = *(const u32x4*)(ALR + hm0 + 64);
        float muv[3][8], kkw[8], kaw[8], rkw[8];
#pragma unroll
        for (int i = 0; i < 8; ++i) { muv[0][i] = mu[c0 + i]; muv[1][i] = mu[512 + c0 + i]; muv[2][i] = mu[1024 + c0 + i]; kkw[i] = k_k[c0 + i]; kaw[i] = k_a[c0 + i]; rkw[i] = r_k[c0 + i]; }
#pragma unroll
        for (int j = 0; j < 2; ++j) {
            float z[3][8], pr[8], al[8];
#pragma unroll
            for (int w3 = 0; w3 < 3; ++w3) { unpack8(raw[j + 1][w3], z[w3]); unpack8(raw[j][w3], pr);
#pragma unroll
                for (int i = 0; i < 8; ++i) z[w3][i] = z[w3][i] + muv[w3][i] * (pr[i] - z[w3][i]); }
            unpack8(ral[j], al);
            float kk[8], km[8]; float ss = 0.f, sb = 0.f;
#pragma unroll
            for (int i = 0; i < 8; ++i) { kk[i] = z[1][i] * kkw[i]; ss += kk[i] * kk[i]; km[i] = z[1][i] * (1.f + (al[i] - 1.f) * kaw[i]); sb += z[0][i] * km[i] * rkw[i]; }
            ss += __shfl_xor(ss, 1); ss += __shfl_xor(ss, 2); ss += __shfl_xor(ss, 4);
            sb += __shfl_xor(sb, 1); sb += __shfl_xor(sb, 2); sb += __shfl_xor(sb, 4);
            const float inv = 1.f / fmaxf(sqrtf(ss), 1e-12f);
#pragma unroll
            for (int i = 0; i < 8; ++i) kk[i] *= inv;
            const size_t hm = hm0 + 64 * j;
            *(u32x4*)(R + hm) = pack8(z[0]); *(u32x4*)(K + hm) = pack8(km); *(u32x4*)(V + hm) = pack8(z[2]); *(u32x4*)(KK + hm) = pack8(kk);
            if ((idx & 7) == 0) SBON[(t0 + j) * 8 + (c0 >> 6)] = sb;
        }
    }
}

template <int CTRL> __device__ __forceinline__ float dpp_add(float x) {
    const int y = __builtin_amdgcn_update_dpp(0, __float_as_int(x), CTRL, 0xF, 0xF, false);
    return x + __int_as_float(y);
}
__device__ __forceinline__ float row16_sum(float x) {
    x = dpp_add<0xB1>(x);
    x = dpp_add<0x4E>(x);
    x = dpp_add<0x141>(x);
    x = dpp_add<0x140>(x);
    return x;
}
typedef float f32x2 __attribute__((ext_vector_type(2)));
__device__ __forceinline__ float fmul_(float a, float b) { float d; asm("v_mul_f32_e32 %0, %1, %2" : "=v"(d) : "v"(a), "v"(b)); return d; }
__device__ __forceinline__ float fadd_(float a, float b) { float d; asm("v_add_f32_e32 %0, %1, %2" : "=v"(d) : "v"(a), "v"(b)); return d; }
__device__ __forceinline__ float ffma_(float a, float b, float c) { float d; asm("v_fma_f32 %0, %1, %2, %3" : "=v"(d) : "v"(a), "v"(b), "v"(c)); return d; }
__device__ __forceinline__ float row16_sum_asm(float x) {
    float d;
    asm("s_nop 1\n\tv_add_f32_dpp %0, %1, %1 quad_perm:[1,0,3,2] row_mask:0xf bank_mask:0xf\n\t"
        "s_nop 1\n\tv_add_f32_dpp %0, %0, %0 quad_perm:[2,3,0,1] row_mask:0xf bank_mask:0xf\n\t"
        "s_nop 1\n\tv_add_f32_dpp %0, %0, %0 row_half_mirror row_mask:0xf bank_mask:0xf\n\t"
        "s_nop 1\n\tv_add_f32_dpp %0, %0, %0 row_mirror row_mask:0xf bank_mask:0xf" : "=&v"(d) : "v"(x));
    return d;
}
constexpr int SC_STEPS = 32, SC_ROW = 336;
__device__ __forceinline__ void scan_block(const Params& p, unsigned char* lds, int sb) {
    const int tid = threadIdx.x, lane = tid & 63, wave = __builtin_amdgcn_readfirstlane(tid >> 6);
    unsigned char* ws = p.ws;
    const bf16_t* ALR = (const bf16_t*)(ws + WS_ALR); const bf16_t* E = (const bf16_t*)(ws + WS_E);
    bf16_t* Y = (bf16_t*)((unsigned char*)p.out + OUT_VT);
    const int xi_ = sb >> 3, quarter = xi_ & 3, bh = (sb & 7) + 8 * (xi_ >> 2), b = bh >> 3, h = bh & 7;
    float* buf = (float*)lds;
    float* ybuf = (float*)(lds + 2 * SC_STEPS * SC_ROW * 4);
    const size_t rowbase = (size_t)b * SEQ;
    constexpr int NCH = SEQ / SC_STEPS;
    if (wave >= 4) {
        const int lt = tid - 256, st_tok = lt >> 3, st_c = lt & 7;
        const bf16_t* ZR = (const bf16_t*)(ws + WS_ZR); float* SBON = (float*)(ws + WS_SBON);
        const int hc = h * 64 + st_c * 8;
        float mur[8], muk[8], muv[8], kkw[8], kaw[8], rkw[8];
#pragma unroll
        for (int i = 0; i < 8; ++i) { mur[i] = p.in[I_MU][hc + i]; muk[i] = p.in[I_MU][512 + hc + i]; muv[i] = p.in[I_MU][1024 + hc + i]; kkw[i] = p.in[I_KK][hc + i]; kaw[i] = p.in[I_KA][hc + i]; rkw[i] = p.in[I_RK][hc + i]; }
        u32x4 Pr, Pk, Pv, Ppr, Ppk, Ppv, Pa, Pe, Qr, Qk, Qv, Qpr, Qpk, Qpv, Qa, Qe;
#define SC_LOAD(X, ch) do { const int s_ = (ch) * SC_STEPS + st_tok; const bf16_t* zr_ = ZR + (rowbase + s_) * 2048 + hc; \
        X##r = *(const u32x4*)(zr_); X##k = *(const u32x4*)(zr_ + 512); X##v = *(const u32x4*)(zr_ + 1024); \
        if (s_ > 0) { X##pr = *(const u32x4*)(zr_ - 2048); X##pk = *(const u32x4*)(zr_ - 2048 + 512); X##pv = *(const u32x4*)(zr_ - 2048 + 1024); } \
        else { X##pr = (u32x4){0u, 0u, 0u, 0u}; X##pk = X##pr; X##pv = X##pr; } \
        const size_t o_ = (((size_t)bh * SEQ) + s_) * 64 + st_c * 8; X##a = *(const u32x4*)(ALR + o_); X##e = *(const u32x4*)(E + o_); } while (0)
#define SC_STORE(X, ch) do { float* bq = buf + ((ch) & 1) * SC_STEPS * SC_ROW; \
        float fr_[8], fk_[8], fv_[8], fp_[8], fa_[8], fe_[8], fkk_[8], fkm_[8]; \
        unpack8(X##r, fr_); unpack8(X##pr, fp_); _Pragma("unroll") for (int i_ = 0; i_ < 8; ++i_) fr_[i_] = fr_[i_] + mur[i_] * (fp_[i_] - fr_[i_]); \
        unpack8(X##k, fk_); unpack8(X##pk, fp_); _Pragma("unroll") for (int i_ = 0; i_ < 8; ++i_) fk_[i_] = fk_[i_] + muk[i_] * (fp_[i_] - fk_[i_]); \
        unpack8(X##v, fv_); unpack8(X##pv, fp_); _Pragma("unroll") for (int i_ = 0; i_ < 8; ++i_) fv_[i_] = fv_[i_] + muv[i_] * (fp_[i_] - fv_[i_]); \
        unpack8(X##a, fa_); unpack8(X##e, fe_); \
        float ss_ = 0.f, sb_ = 0.f; \
        _Pragma("unroll") for (int i_ = 0; i_ < 8; ++i_) { fkk_[i_] = fk_[i_] * kkw[i_]; ss_ += fkk_[i_] * fkk_[i_]; fkm_[i_] = fk_[i_] * (1.f + (fa_[i_] - 1.f) * kaw[i_]); sb_ += fr_[i_] * fkm_[i_] * rkw[i_]; } \
        ss_ += __shfl_xor(ss_, 1); ss_ += __shfl_xor(ss_, 2); ss_ += __shfl_xor(ss_, 4); \
        sb_ += __shfl_xor(sb_, 1); sb_ += __shfl_xor(sb_, 2); sb_ += __shfl_xor(sb_, 4); \
        const float inv_ = 1.f / fmaxf(sqrtf(ss_), 1e-12f); \
        _Pragma("unroll") for (int i_ = 0; i_ < 8; ++i_) fkk_[i_] *= inv_; \
        if (quarter == 0 && st_c == 0) SBON[(rowbase + (size_t)(ch) * SC_STEPS + st_tok) * 8 + h] = sb_; \
        { float* q = bq + st_tok * SC_ROW + st_c * 8; f32x4 o0, o1; \
          o0 = (f32x4){fr_[0], fr_[1], fr_[2], fr_[3]}; o1 = (f32x4){fr_[4], fr_[5], fr_[6], fr_[7]}; *(f32x4*)(q) = o0; *(f32x4*)(q + 4) = o1; \
          o0 = (f32x4){__expf(-fe_[0]), __expf(-fe_[1]), __expf(-fe_[2]), __expf(-fe_[3])}; o1 = (f32x4){__expf(-fe_[4]), __expf(-fe_[5]), __expf(-fe_[6]), __expf(-fe_[7])}; *(f32x4*)(q + 64) = o0; *(f32x4*)(q + 68) = o1; \
          o0 = (f32x4){fkm_[0], fkm_[1], fkm_[2], fkm_[3]}; o1 = (f32x4){fkm_[4], fkm_[5], fkm_[6], fkm_[7]}; *(f32x4*)(q + 128) = o0; *(f32x4*)(q + 132) = o1; \
          o0 = (f32x4){-fkk_[0], -fkk_[1], -fkk_[2], -fkk_[3]}; o1 = (f32x4){-fkk_[4], -fkk_[5], -fkk_[6], -fkk_[7]}; *(f32x4*)(q + 192) = o0; *(f32x4*)(q + 196) = o1; \
          o0 = (f32x4){fkk_[0] * fa_[0], fkk_[1] * fa_[1], fkk_[2] * fa_[2], fkk_[3] * fa_[3]}; o1 = (f32x4){fkk_[4] * fa_[4], fkk_[5] * fa_[5], fkk_[6] * fa_[6], fkk_[7] * fa_[7]}; *(f32x4*)(q + 256) = o0; *(f32x4*)(q + 260) = o1; } \
        if ((st_c >> 1) == quarter) { float* q = bq + st_tok * SC_ROW + 320 + (st_c & 1) * 8; \
          *(f32x4*)(q) = (f32x4){fv_[0], fv_[1], fv_[2], fv_[3]}; *(f32x4*)(q + 4) = (f32x4){fv_[4], fv_[5], fv_[6], fv_[7]}; } } while (0)
#define SC_FLUSH(ch) do { const float* yq = ybuf + ((ch) & 1) * 512; const int tk = lt >> 3, r2 = (lt & 7) * 2; \
        f32x2 o; o.x = yq[r2 * 32 + tk]; o.y = yq[(r2 + 1) * 32 + tk]; \
        *(unsigned*)(Y + (rowbase + (size_t)(ch) * SC_STEPS + tk) * 512 + h * 64 + quarter * 16 + r2) = cvt_pk_bf16(o.x, o.y); } while (0)
        SC_LOAD(Q, 0); SC_STORE(Q, 0); SC_LOAD(P, 1); SC_LOAD(Q, 2);
        __syncthreads();
        for (int ch = 0; ch < NCH; ch += 2) {
            SC_STORE(P, ch + 1);
            if (ch + 3 < NCH) SC_LOAD(P, ch + 3);
            if (ch >= 1) SC_FLUSH(ch - 1);
            __syncthreads();
            if (ch + 2 < NCH) SC_STORE(Q, ch + 2);
            if (ch + 4 < NCH) SC_LOAD(Q, ch + 4);
            SC_FLUSH(ch);
            __syncthreads();
        }
        SC_FLUSH(NCH - 1);
#undef SC_LOAD
#undef SC_STORE
#undef SC_FLUSH
    } else {
        __syncthreads();
        const int c = lane & 15, rowq = wave * 4 + (lane >> 4);
#define SC_LDG(X, base) do { _Pragma("unroll") for (int u_ = 0; u_ < 2; ++u_) { const float* q_ = (base) + u_ * SC_ROW; \
            X##r[u_] = *(const f32x4*)(q_ + 4 * c); X##w[u_] = *(const f32x4*)(q_ + 64 + 4 * c); X##k[u_] = *(const f32x4*)(q_ + 128 + 4 * c); \
            X##a[u_] = *(const f32x4*)(q_ + 192 + 4 * c); X##b[u_] = *(const f32x4*)(q_ + 256 + 4 * c); X##v[u_] = q_[320 + rowq]; } } while (0)
#define SC_STEP(Xa, Xb, Xw, Xk, Xv, RP, yprev) do { float dA_, dB_, vk0_, vk1_, vk2_, vk3_; \
        asm volatile("v_mul_f32_e32 %0, %2, %6\n\tv_mul_f32_e32 %1, %2, %10\n\t" \
                     "v_fma_f32 %0, %3, %7, %0\n\tv_fma_f32 %1, %3, %11, %1\n\t" \
                     "v_fma_f32 %0, %4, %8, %0\n\tv_fma_f32 %1, %4, %12, %1\n\t" \
                     "v_fma_f32 %0, %5, %9, %0\n\tv_fma_f32 %1, %5, %13, %1" \
                     : "=&v"(dA_), "=&v"(dB_) \
                     : "v"(s0), "v"(s1), "v"(s2), "v"(s3), "v"(Xa[0]), "v"(Xa[1]), "v"(Xa[2]), "v"(Xa[3]), "v"(RP[0]), "v"(RP[1]), "v"(RP[2]), "v"(RP[3])); \
        asm volatile("v_mul_f32_e32 %2, %6, %10\n\t" \
                     "v_add_f32_dpp %0, %0, %0 quad_perm:[1,0,3,2] row_mask:0xf bank_mask:0xf\n\tv_add_f32_dpp %1, %1, %1 quad_perm:[1,0,3,2] row_mask:0xf bank_mask:0xf\n\t" \
                     "v_mul_f32_e32 %3, %7, %10\n\t" \
                     "v_add_f32_dpp %0, %0, %0 quad_perm:[2,3,0,1] row_mask:0xf bank_mask:0xf\n\tv_add_f32_dpp %1, %1, %1 quad_perm:[2,3,0,1] row_mask:0xf bank_mask:0xf\n\t" \
                     "v_mul_f32_e32 %4, %8, %10\n\t" \
                     "v_add_f32_dpp %0, %0, %0 row_half_mirror row_mask:0xf bank_mask:0xf\n\tv_add_f32_dpp %1, %1, %1 row_half_mirror row_mask:0xf bank_mask:0xf\n\t" \
                     "v_mul_f32_e32 %5, %9, %10\n\t" \
                     "v_add_f32_dpp %0, %0, %0 row_mirror row_mask:0xf bank_mask:0xf\n\tv_add_f32_dpp %1, %1, %1 row_mirror row_mask:0xf bank_mask:0xf" \
                     : "+v"(dA_), "+v"(dB_), "=&v"(vk0_), "=&v"(vk1_), "=&v"(vk2_), "=&v"(vk3_) \
                     : "v"(Xk[0]), "v"(Xk[1]), "v"(Xk[2]), "v"(Xk[3]), "v"(Xv)); \
        asm volatile("v_fma_f32 %4, %8, %9, %4\n\tv_fma_f32 %5, %8, %10, %5\n\tv_fma_f32 %6, %8, %11, %6\n\tv_fma_f32 %7, %8, %12, %7\n\t" \
                     "v_fma_f32 %0, %0, %13, %4\n\tv_fma_f32 %1, %1, %14, %5\n\tv_fma_f32 %2, %2, %15, %6\n\tv_fma_f32 %3, %3, %16, %7" \
                     : "+v"(s0), "+v"(s1), "+v"(s2), "+v"(s3), "+v"(vk0_), "+v"(vk1_), "+v"(vk2_), "+v"(vk3_) \
                     : "v"(dA_), "v"(Xb[0]), "v"(Xb[1]), "v"(Xb[2]), "v"(Xb[3]), "v"(Xw[0]), "v"(Xw[1]), "v"(Xw[2]), "v"(Xw[3])); \
        yprev = dB_; } while (0)
#define SC_CMP(X, j0) do { _Pragma("unroll") for (int u_ = 0; u_ < 2; ++u_) { float yp_; \
            SC_STEP(X##a[u_], X##b[u_], X##w[u_], X##k[u_], X##v[u_], rp, yp_); rp = X##r[u_]; \
            ykeep = ((((j0) + u_ + 31) & 15) == c) ? yp_ : ykeep; if (((j0) + u_) == 16) yb[c] = ykeep; } } while (0)
        float s0 = 0.f, s1 = 0.f, s2 = 0.f, s3 = 0.f;
        f32x4 rp = {0.f, 0.f, 0.f, 0.f}; float ykeep = 0.f;
        f32x4 Ar[2], Aw[2], Ak[2], Aa[2], Ab[2], Br[2], Bw[2], Bk[2], Ba[2], Bb[2]; float Av[2], Bv[2];
        for (int ch = 0; ch < NCH; ++ch) {
            const float* bp = buf + (ch & 1) * SC_STEPS * SC_ROW; float* yb = ybuf + (ch & 1) * 512 + rowq * 32;
            SC_LDG(A, bp);
#pragma unroll 2
            for (int g = 0; g < 16; g += 2) {
                SC_LDG(B, bp + (g + 1) * 2 * SC_ROW);
                __builtin_amdgcn_sched_barrier(0);
                SC_CMP(A, 2 * g);
                __builtin_amdgcn_sched_barrier(0);
                if (g + 2 < 16) SC_LDG(A, bp + (g + 2) * 2 * SC_ROW);
                __builtin_amdgcn_sched_barrier(0);
                SC_CMP(B, 2 * g + 2);
                __builtin_amdgcn_sched_barrier(0);
            }
            { const float y_ = row16_sum_asm(fadd_(ffma_(s1, rp[1], fmul_(s0, rp[0])), ffma_(s3, rp[3], fmul_(s2, rp[2])))); ykeep = (c == 15) ? y_ : ykeep; yb[16 + c] = ykeep; }
            __syncthreads();
        }
#undef SC_LDG
#undef SC_CMP
#undef SC_STEP
    }
    __syncthreads();
}

__device__ __forceinline__ int crow(int r, int hi) { return (r & 3) + 8 * (r >> 2) + 4 * hi; }
constexpr int AT_KROW = 144, AT_VROW = 144, AT_KB = 64 * AT_KROW, AT_VB = 64 * AT_VROW;
constexpr int AT_K0 = 0, AT_V0 = 4 * AT_KB, AT_KM = 4 * AT_KB + 4 * AT_VB;
typedef short tr4_t __attribute__((ext_vector_type(4)));
typedef __attribute__((address_space(3))) tr4_t tr4_lds_t;
typedef __attribute__((address_space(3))) const char* tr_lds_cptr;
__device__ __forceinline__ void attn_unit(const Params& p, unsigned char* lds, int bh, int qb) {
    const int tid = threadIdx.x, lane = tid & 63, wave = __builtin_amdgcn_readfirstlane(tid >> 6), q = lane & 31, hi = lane >> 5;
    const int b = bh >> 3, h = bh & 7;
    const bf16_t* Kp = (const bf16_t*)((const unsigned char*)p.out + OUT_KP);
    const bf16_t* ZMv = (const bf16_t*)(p.ws + WS_ZM); bf16_t* YB = (bf16_t*)p.out;
    const float* KMEAN = (const float*)(p.ws + WS_KMEAN);
    float* km = (float*)(lds + AT_KM);
    for (int i = tid; i < 1024; i += 512) km[i] = KMEAN[(size_t)bh * 1024 + i];
    const size_t qrow = (size_t)b * SEQ + qb * 256 + wave * 32 + q;
    bf16x8 qf[4];
    {
        float qn[32];
#pragma unroll
        for (int kk = 0; kk < 4; ++kk) unpack8(*(const u32x4*)(ZMv + qrow * 1536 + h * 64 + 16 * kk + 8 * hi), qn + 8 * kk);
        float ssq_ = 0.f;
#pragma unroll
        for (int e = 0; e < 32; ++e) ssq_ += qn[e] * qn[e];
        ssq_ += __shfl_xor(ssq_, 32);
        const float rq = rsqrtf(ssq_ * (1.f / 64.f) + 1e-6f);
        const float* qg = p.in[I_QNG];
#pragma unroll
        for (int kk = 0; kk < 4; ++kk)
#pragma unroll
            for (int e = 0; e < 8; ++e) qn[kk * 8 + e] = qn[kk * 8 + e] * rq * qg[16 * kk + 8 * hi + e];
        const float rvh[8] = {0.15915493667125702f, 0.030863763764500618f, 0.005985185503959656f, 0.0011606636689975858f, 0.0002250790857942775f, 4.3647953134495765e-05f, 8.464330676360987e-06f, 1.6414262518082978e-06f};
        const float rvl[8] = {6.4206382432985265e-09f, -6.060805191054897e-10f, 1.7242327010613678e-10f, -4.8028716420622786e-11f, -6.753226016592562e-12f, 1.6772382094298877e-12f, -1.2670839041623722e-13f, -9.854460929453572e-15f};
        const float ps = (float)((const int*)p.in[I_POS])[qrow];
#pragma unroll
        for (int e = 0; e < 8; ++e) { const float hi_ = ps * rvh[e], lo_ = fmaf(ps, rvh[e], -hi_) + ps * rvl[e]; const float fx = (hi_ - floorf(hi_)) + lo_;
            const float sn_ = __builtin_amdgcn_sinf(fx), cs_ = __builtin_amdgcn_cosf(fx); const float other = __shfl_xor(qn[e], 32);
            qn[e] = qn[e] * cs_ + (hi ? other : -other) * sn_; }
#pragma unroll
        for (int kk = 0; kk < 4; ++kk) { const u32x4 w = pack8(qn + 8 * kk); qf[kk] = __builtin_bit_cast(bf16x8, w); }
    }
    const int ld_r = tid >> 3, ld_c = tid & 7;
    const bf16_t* kbase = Kp + ((size_t)b * SEQ + ld_r) * 512 + h * 64 + ld_c * 8;
    const bf16_t* vbase = ZMv + ((size_t)b * SEQ + ld_r) * 1536 + 1024 + h * 64 + ld_c * 8;
    const int NT = 4 * (qb + 1);
    u32x4 kreg = *(const u32x4*)(kbase), vreg = *(const u32x4*)(vbase), kreg2 = *(const u32x4*)(kbase + (size_t)64 * 512), vreg2 = *(const u32x4*)(vbase + (size_t)64 * 1536);
#define AT_PUT(slot, kr, vr) do { *(u32x4*)(lds + AT_K0 + (slot) * AT_KB + ld_r * AT_KROW + ld_c * 16) = (kr); *(u32x4*)(lds + AT_V0 + (slot) * AT_VB + ld_r * AT_VROW + ld_c * 16) = (vr); } while (0)
    AT_PUT(0, kreg, vreg); AT_PUT(1, kreg2, vreg2);
    __syncthreads();
    unsigned mask = 0u; float mc = 0.f;
    {
        float qv[32];
#pragma unroll
        for (int kk = 0; kk < 4; ++kk)
#pragma unroll
            for (int e = 0; e < 8; ++e) qv[kk * 8 + e] = __uint_as_float(((unsigned)(unsigned short)qf[kk][e]) << 16);
        { float qq = 0.f;
#pragma unroll
          for (int e = 0; e < 32; ++e) qq += qv[e] * qv[e];
          qq += __shfl_xor(qq, 32); mc = sqrtf(qq) * (10.f / 8.f) * 1.4426950408889634f; }
        float g[15];
#pragma unroll
        for (int j = 0; j < 15; ++j) { float s = 0.f;
#pragma unroll
            for (int kk = 0; kk < 4; ++kk)
#pragma unroll
                for (int e = 0; e < 8; ++e) s += qv[kk * 8 + e] * km[j * 64 + 16 * kk + 8 * hi + e];
            s += __shfl_xor(s, 32); g[j] = (j < qb) ? s : -INFINITY; }
#pragma unroll
        for (int pass = 0; pass < 3; ++pass) { float m = g[0]; int idx = 0;
#pragma unroll
            for (int j = 1; j < 15; ++j) if (g[j] > m) { m = g[j]; idx = j; }
            if (m > -INFINITY) mask |= 1u << idx;
#pragma unroll
            for (int j = 0; j < 15; ++j) if (j == idx) g[j] = -INFINITY; }
    }
    const float C = 0.125f * 1.4426950408889634f;
    float l = 0.f;
    f32x16 O0 = {}, O1 = {};
    const int qrel = 32 * wave + q;
    for (int i2 = 0; i2 < NT; i2 += 2) {
        if (i2 + 2 < NT) { const size_t adv = (size_t)(i2 + 2) * 64; kreg = *(const u32x4*)(kbase + adv * 512); vreg = *(const u32x4*)(vbase + adv * 1536);
            kreg2 = *(const u32x4*)(kbase + (adv + 64) * 512); vreg2 = *(const u32x4*)(vbase + (adv + 64) * 1536); }
#pragma unroll 1
      for (int sub = 0; sub < 2; ++sub) { const int i = i2 + sub;
        const int j = i >> 2, kt = i & 3;
        const unsigned char* Kb = lds + AT_K0 + (i & 3) * AT_KB; tr_lds_cptr Vb3 = (tr_lds_cptr)lds + AT_V0 + (i & 3) * AT_VB;
        const bool own = (j == qb);
        const bool act = own ? true : ((mask >> j) & 1u);
        const bool wave_on = own ? (64 * kt <= 32 * wave + 31) : (__ballot(act) != 0ull);
        if (wave_on) {
            f32x16 s0 = {}, s1 = {};
#pragma unroll
            for (int kk = 0; kk < 4; ++kk) {
                const bf16x8 k0 = *(const bf16x8*)(Kb + q * AT_KROW + (16 * kk + 8 * hi) * 2);
                const bf16x8 k1 = *(const bf16x8*)(Kb + (q + 32) * AT_KROW + (16 * kk + 8 * hi) * 2);
                s0 = __builtin_amdgcn_mfma_f32_32x32x16_bf16(k0, qf[kk], s0, 0, 0, 0);
                s1 = __builtin_amdgcn_mfma_f32_32x32x16_bf16(k1, qf[kk], s1, 0, 0, 0);
            }
            if (own) {
#pragma unroll
                for (int r = 0; r < 16; ++r) { const int key = 64 * kt + crow(r, hi); if (key > qrel) s0[r] = -1e30f; if (key + 32 > qrel) s1[r] = -1e30f; }
            } else if (!act) {
#pragma unroll
                for (int r = 0; r < 16; ++r) { s0[r] = -1e30f; s1[r] = -1e30f; }
            }
            float ls = 0.f;
#pragma unroll
            for (int r = 0; r < 16; ++r) { s0[r] = __builtin_amdgcn_exp2f(s0[r] * C - mc); s1[r] = __builtin_amdgcn_exp2f(s1[r] * C - mc); ls += s0[r] + s1[r]; }
            l += ls;
            bf16x8 pf[2][2];
#pragma unroll
            for (int s = 0; s < 2; ++s) {
                u32x4 w0, w1;
                w0.x = cvt_pk_bf16(s0[8 * s + 0], s0[8 * s + 1]); w0.y = cvt_pk_bf16(s0[8 * s + 2], s0[8 * s + 3]); w0.z = cvt_pk_bf16(s0[8 * s + 4], s0[8 * s + 5]); w0.w = cvt_pk_bf16(s0[8 * s + 6], s0[8 * s + 7]);
                w1.x = cvt_pk_bf16(s1[8 * s + 0], s1[8 * s + 1]); w1.y = cvt_pk_bf16(s1[8 * s + 2], s1[8 * s + 3]); w1.z = cvt_pk_bf16(s1[8 * s + 4], s1[8 * s + 5]); w1.w = cvt_pk_bf16(s1[8 * s + 6], s1[8 * s + 7]);
                pf[0][s] = __builtin_bit_cast(bf16x8, w0); pf[1][s] = __builtin_bit_cast(bf16x8, w1);
            }
#pragma unroll
            for (int kh = 0; kh < 2; ++kh)
#pragma unroll
                for (int s = 0; s < 2; ++s) {
                    const int keyq = 32 * kh + 16 * s + 4 * hi + ((lane & 15) >> 2), cb = (16 * ((lane >> 4) & 1) + 4 * (lane & 3)) * 2;
                    const tr4_t a0 = __builtin_amdgcn_ds_read_tr16_b64_v4i16((tr4_lds_t*)(Vb3 + keyq * AT_VROW + cb)), a1 = __builtin_amdgcn_ds_read_tr16_b64_v4i16((tr4_lds_t*)(Vb3 + (keyq + 8) * AT_VROW + cb));
                    const tr4_t c0 = __builtin_amdgcn_ds_read_tr16_b64_v4i16((tr4_lds_t*)(Vb3 + keyq * AT_VROW + cb + 64)), c1 = __builtin_amdgcn_ds_read_tr16_b64_v4i16((tr4_lds_t*)(Vb3 + (keyq + 8) * AT_VROW + cb + 64));
                    const bf16x8 va = {a0[0], a0[1], a0[2], a0[3], a1[0], a1[1], a1[2], a1[3]}, vc = {c0[0], c0[1], c0[2], c0[3], c1[0], c1[1], c1[2], c1[3]};
                    O0 = __builtin_amdgcn_mfma_f32_32x32x16_bf16(va, pf[kh][s], O0, 0, 0, 0);
                    O1 = __builtin_amdgcn_mfma_f32_32x32x16_bf16(vc, pf[kh][s], O1, 0, 0, 0);
                }
        }
      }
        if (i2 + 2 < NT) { AT_PUT((i2 + 2) & 3, kreg, vreg); AT_PUT((i2 + 3) & 3, kreg2, vreg2); }
        __syncthreads();
    }
#undef AT_PUT
    l += __shfl_xor(l, 32);
    const float inv = 1.f / l;
    bf16_t* orow = YB + qrow * 512 + h * 64;
#pragma unroll
    for (int g4 = 0; g4 < 4; ++g4) {
        u32x2 w0, w1;
        w0.x = cvt_pk_bf16(O0[4 * g4 + 0] * inv, O0[4 * g4 + 1] * inv); w0.y = cvt_pk_bf16(O0[4 * g4 + 2] * inv, O0[4 * g4 + 3] * inv);
        w1.x = cvt_pk_bf16(O1[4 * g4 + 0] * inv, O1[4 * g4 + 1] * inv); w1.y = cvt_pk_bf16(O1[4 * g4 + 2] * inv, O1[4 * g4 + 3] * inv);
        *(u32x2*)(orow + 8 * g4 + 4 * hi) = w0; *(u32x2*)(orow + 32 + 8 * g4 + 4 * hi) = w1;
    }
}

__device__ __forceinline__ void phase6(const Params& p) {
    const int tid = threadIdx.x; unsigned char* ws = p.ws;
    const bf16_t* Y = (const bf16_t*)((const unsigned char*)p.out + OUT_VT); const bf16_t* ZR = (const bf16_t*)(ws + WS_ZR); const float* mu = p.in[I_MU]; const bf16_t* G = (const bf16_t*)(ws + WS_G); const float* SBON = (const float*)(ws + WS_SBON);
    bf16_t* YA = (bf16_t*)(ws + WS_YA); const float* ln_g = p.in[I_LNG]; const float* ln_b = p.in[I_LNB];
    const size_t NG = (size_t)T * 64, STR = (size_t)gridDim.x * 512;
    for (size_t idx0 = (size_t)blockIdx.x * 512 + tid; idx0 < NG; idx0 += 4 * STR) {
        f32x4 ya[4][2]; u32x4 rv[4], rpv[4], rg[4]; float sbv[4];
#pragma unroll
        for (int j = 0; j < 4; ++j) { const size_t idx = idx0 + j * STR; const size_t t = idx >> 6; const int c0 = (int)(idx & 63) * 8;
            { const u32x4 yw = *(const u32x4*)(Y + t * 512 + c0); ya[j][0] = (f32x4){bf_lo(yw.x), bf_hi(yw.x), bf_lo(yw.y), bf_hi(yw.y)}; ya[j][1] = (f32x4){bf_lo(yw.z), bf_hi(yw.z), bf_lo(yw.w), bf_hi(yw.w)}; }
            rv[j] = *(const u32x4*)(ZR + t * 2048 + 1024 + c0); rpv[j] = (t & (SEQ - 1)) ? *(const u32x4*)(ZR + (t - 1) * 2048 + 1024 + c0) : (u32x4){0u, 0u, 0u, 0u}; rg[j] = *(const u32x4*)(G + t * 512 + c0); sbv[j] = SBON[t * 8 + (c0 >> 6)]; }
#pragma unroll
        for (int j = 0; j < 4; ++j) { const size_t idx = idx0 + j * STR; const size_t t = idx >> 6; const int c0 = (int)(idx & 63) * 8;
            float y[8] = {ya[j][0][0], ya[j][0][1], ya[j][0][2], ya[j][0][3], ya[j][1][0], ya[j][1][1], ya[j][1][2], ya[j][1][3]};
            float s_ = 0.f;
#pragma unroll
            for (int i = 0; i < 8; ++i) s_ += y[i];
            s_ += __shfl_xor(s_, 1); s_ += __shfl_xor(s_, 2); s_ += __shfl_xor(s_, 4);
            const float mean = s_ * (1.f / 64.f); float q = 0.f;
#pragma unroll
            for (int i = 0; i < 8; ++i) { y[i] -= mean; q += y[i] * y[i]; }
            q += __shfl_xor(q, 1); q += __shfl_xor(q, 2); q += __shfl_xor(q, 4);
            const float rstd = rsqrtf(q * (1.f / 64.f) + 64e-5f);
            float v[8], pv_[8], g[8]; unpack8(rv[j], v); unpack8(rpv[j], pv_); unpack8(rg[j], g);
#pragma unroll
            for (int i = 0; i < 8; ++i) v[i] = v[i] + mu[1024 + c0 + i] * (pv_[i] - v[i]);
#pragma unroll
            for (int i = 0; i < 8; ++i) y[i] = (y[i] * rstd * ln_g[c0 + i] + ln_b[c0 + i] + sbv[j] * v[i]) * g[i];
            *(u32x4*)(YA + t * 512 + c0) = pack8(y); }
    }
}

__device__ __forceinline__ void phase10(const Params& p, bool dry) {
    const int tid = threadIdx.x; bf16_t* U = (bf16_t*)(p.ws + WS_U);
    const float* cw = p.in[I_CW]; const float* cb = p.in[I_CB];
    const size_t NG = (size_t)(T / 64) * 352;
    for (size_t idx = (size_t)blockIdx.x * 512 + tid; idx < NG; idx += (size_t)gridDim.x * 512) {
        const size_t tq = idx / 352; const int c0 = (int)(idx - tq * 352) * 8; const size_t t0 = tq * 64; const int s0 = (int)(t0 & (SEQ - 1));
        u32x4 ra[4], rb[2];
#pragma unroll
        for (int j = 0; j < 4; ++j) { if (j >= 2 || s0 > 0) ra[j] = *(const u32x4*)(U + (t0 + j - 2) * NPROJ + c0); else ra[j] = (u32x4){0u, 0u, 0u, 0u}; }
#pragma unroll
        for (int j = 0; j < 2; ++j) rb[j] = *(const u32x4*)(U + (t0 + j) * NPROJ + DFF + c0);
        float w0[8], w1[8], w2[8], bs[8];
#pragma unroll
        for (int i = 0; i < 8; ++i) { w0[i] = cw[c0 + i]; w1[i] = cw[DFF + c0 + i]; w2[i] = cw[2 * DFF + c0 + i]; bs[i] = cb[c0 + i]; }
        float a2[8], a1[8], a0[8];
        unpack8(ra[0], a2); unpack8(ra[1], a1);
#pragma unroll
        for (int j = 0; j < 2; ++j) {
            float bv[8], o[8]; unpack8(ra[j + 2], a0); unpack8(rb[j], bv);
#pragma unroll
            for (int i = 0; i < 8; ++i) { const float v = w0[i] * a2[i] + w1[i] * a1[i] + w2[i] * a0[i] + bs[i]; o[i] = gelu_erf(v) * bv[i]; a2[i] = a1[i]; a1[i] = a0[i]; }
            if (!dry) *(u32x4*)(U + (t0 + j) * NPROJ + DFF + c0) = pack8(o);
        }
    }
}

#define LAS __attribute__((address_space(3)))
#define XB_TMO      128
#define XB_XCNT(j)  (256  + 64 * (j))
#define XB_XSUB(j)  (1280 + 64 * (j))
#define XB_XGEN(j)  (2304 + 64 * (j))
#define XB_TOP      3328
#define XB_TOPGEN   3392
#define XCD_BAR_WORDS 3456
#define XB_SPIN_CAP (1u << 20)
__device__ __forceinline__ unsigned xb_ld(unsigned* p)              { return __hip_atomic_load(p, __ATOMIC_RELAXED, __HIP_MEMORY_SCOPE_AGENT); }
__device__ __forceinline__ unsigned xb_add(unsigned* p, unsigned v) { return __hip_atomic_fetch_add(p, v, __ATOMIC_RELAXED, __HIP_MEMORY_SCOPE_AGENT); }
__device__ __forceinline__ unsigned xb_xcc_id() { return (unsigned)__builtin_amdgcn_s_getreg((3 << 11) | 20) & 0xFu; }
#define XB_SPIN(cond, bar) do { unsigned _sp = 0; while (cond) { __builtin_amdgcn_s_sleep(1); \
    if ((++_sp & 255u) == 0u) { if (xb_ld(&(bar)[XB_TMO])) break; if (_sp > XB_SPIN_CAP) { atomicAdd(&(bar)[XB_TMO], 1u); break; } } } } while (0)
struct XcdBarrier { unsigned* bar; unsigned x; volatile LAS unsigned* st; };
__device__ __forceinline__ XcdBarrier xcd_barrier_post(unsigned* bar, volatile LAS unsigned* st) {
    XcdBarrier b; b.bar = bar; b.x = xb_xcc_id(); b.st = st;
    if (threadIdx.x == 0) (void)xb_add(&bar[XB_XCNT(b.x)], 1u);
    return b;
}
__device__ __forceinline__ void xcd_barrier_complete(unsigned* bar, unsigned x, unsigned& nloc, unsigned& nx) {
    const unsigned G = gridDim.x * gridDim.y * gridDim.z;
    unsigned sum, cnt, mine, sp = 0u;
    for (;;) {
        sum = 0u; cnt = 0u; mine = 0u;
#pragma unroll
        for (unsigned j = 0; j < 16; ++j) { const unsigned c = xb_ld(&bar[XB_XCNT(j)]); sum += c; cnt += (c > 0u) ? 1u : 0u; mine = (j == x) ? c : mine; }
        if (sum == G) break;
        __builtin_amdgcn_s_sleep(1);
        if ((++sp & 255u) == 0u) { if (xb_ld(&bar[XB_TMO])) break; if (sp > XB_SPIN_CAP) { atomicAdd(&bar[XB_TMO], 1u); break; } }
    }
    nloc = mine > 0u ? mine : 1u; nx = cnt > 0u ? cnt : 1u;
}
__device__ __forceinline__ void xcd_barrier(const XcdBarrier& b) {
    asm volatile("s_waitcnt vmcnt(0)" ::: "memory");
    __syncthreads();
    if (threadIdx.x == 0) {
        unsigned* bar = b.bar;
        __builtin_amdgcn_s_waitcnt(0);
        unsigned nloc = b.st[0], nx = b.st[1];
        if (nloc == 0u) { xcd_barrier_complete(bar, b.x, nloc, nx); b.st[0] = nloc; b.st[1] = nx; }
        const unsigned old = xb_add(&bar[XB_XSUB(b.x)], 1u);
        const unsigned gen = old / nloc;
        if (old + 1u == (gen + 1u) * nloc) {
            __builtin_amdgcn_fence(__ATOMIC_RELEASE, "agent");
            asm volatile("s_waitcnt vmcnt(0)" ::: "memory");
            const unsigned og = xb_add(&bar[XB_TOP], 1u);
            const unsigned tg = og / nx;
            if (og + 1u == (tg + 1u) * nx) xb_add(&bar[XB_TOPGEN], 1u);
            else XB_SPIN(xb_ld(&bar[XB_TOPGEN]) == tg, bar);
            __builtin_amdgcn_fence(__ATOMIC_ACQUIRE, "agent");
            xb_add(&bar[XB_XGEN(b.x)], 1u);
            asm volatile("s_waitcnt vmcnt(0)" ::: "memory");
        } else {
            XB_SPIN(xb_ld(&bar[XB_XGEN(b.x)]) == gen, bar);
            __builtin_amdgcn_fence(__ATOMIC_ACQUIRE, "agent");
            asm volatile("s_waitcnt vmcnt(0)" ::: "memory");
        }
    }
    __syncthreads();
}

#ifndef PROBE_DRY1
#define PROBE_DRY1 0
#endif
#ifndef PROBE_P2PARTS
#define PROBE_P2PARTS 3
#endif
constexpr int NPHASE = 12;
__global__ void __launch_bounds__(512, 2) hybrid_fwd(Params p) {
    extern __shared__ __attribute__((aligned(16))) unsigned char lds[];
    cg::grid_group grid = cg::this_grid();
    PG8_LAS unsigned char* lds3 = (PG8_LAS unsigned char*)lds;
    unsigned char* ws = p.ws;
    const int G = gridDim.x, bx = blockIdx.x;
    const int lo = p.lo, hi = p.hi;
#ifndef PH_MASK
#define PH_MASK 0xFFF
#endif
#define IN(k) (((PH_MASK >> (k)) & 1) && lo <= (k) && (k) < hi)
    if (threadIdx.x < 16) ((volatile LAS unsigned*)(lds3 + LDS_MISC))[16 + threadIdx.x] = 0u;
    __syncthreads();
    const XcdBarrier xbar = xcd_barrier_post((unsigned*)(ws + WS_CTL) + 1024, (volatile LAS unsigned*)(lds3 + LDS_MISC) + 16);
#define RLOOP(k) _Pragma("unroll 1") for (int r_ = 0; r_ < p.rep[k]; ++r_)
#define SEAM(k) do { if (IN(k) && IN((k) + 1)) { if ((k) == 0 && lo < 0) grid.sync(); else xcd_barrier(xbar); } } while (0)
#ifndef REP_EW
#define REP_EW 1
#endif
    if (IN(0)) { RLOOP(0) phase0(p, lds); } SEAM(0);
    if (IN(1)) {
        pg8::Gemm g{(const bf16_t*)(ws + WS_HB), (const bf16_t*)(ws + WS_WIN), T, NPROJ, 1024, 1024, 1024}; pg8::StaticOrder S; S.init(T, NPROJ, G, bx);
        RLOOP(1) { EpiProj E{(bf16_t*)(ws + WS_ZR), (bf16_t*)(ws + WS_ZM), (bf16_t*)(ws + WS_GP), (bf16_t*)((unsigned char*)p.out + OUT_LA), p.in[I_MU], PROBE_DRY1 && (r_ + 1 < p.rep[1])}; pg8::gemm_phase<EpiProj, true>(lds3, g, S, E); }
    } SEAM(1);
    if (IN(2)) { RLOOP(2) phase2(p, lds, r_ == 0 ? 3 : PROBE_P2PARTS); } SEAM(2);
    if (IN(3)) {
        const bf16_t* LA = (const bf16_t*)((const unsigned char*)p.out + OUT_LA);
        RLOOP(3)
#pragma unroll 1
        for (int w = 0; w < 3; ++w) {
            const bf16_t* Bt = (const bf16_t*)(ws + (w == 0 ? WS_WD : (w == 1 ? WS_WA : WS_WG)));
            bf16_t* O = (bf16_t*)(ws + (w == 0 ? WS_E : (w == 1 ? WS_ALR : WS_G)));
            const float* bias = w == 0 ? p.in[I_DB] : p.in[I_AB];
            const int Kw = (w == 2) ? 256 : 128;
            pg8::Gemm g{LA + 128 * w, Bt, T, 512, Kw, 512, Kw}; pg8::StaticOrder S; S.init(T, 512, G, bx);
            EpiLora E{O, bias, w};
            pg8::gemm_phase<EpiLora, true>(lds3, g, S, E);
        }
    } do { if (IN(3) && IN(5)) xcd_barrier(xbar); } while (0);
    if (IN(5)) {
#ifndef REP_SCAN
#define REP_SCAN 1
#endif
        RLOOP(5) scan_block(p, lds, bx);
        volatile unsigned* sh = (volatile unsigned*)(lds + LDS_MISC);
#pragma unroll 1
        for (int rep = 0; rep < p.rep[12]; ++rep) {
        unsigned* qctr = (unsigned*)(ws + WS_CTL) + 64 + 64 * rep;
        for (;;) {
            __syncthreads();
            if (threadIdx.x == 0) sh[0] = atomicAdd(qctr, 1u);
            __syncthreads();
            const unsigned u = sh[0];
            if (u >= 1024u) break;
            attn_unit(p, lds, (int)(u & 63u), 15 - (int)(u >> 6));
        }
        }
    } SEAM(5);
    if (IN(6)) { RLOOP(6) phase6(p); } SEAM(6);
#pragma unroll 1
    for (int r_ = 0; r_ < p.rep[13]; ++r_) xcd_barrier(xbar);

    if (IN(7)) {
        const bf16_t* GP = (const bf16_t*)(ws + WS_GP); bf16_t* MG = (bf16_t*)(ws + WS_MG);
#pragma unroll 1
        for (int w = 0; w < 2 * p.rep[7]; ++w) {
            const int second = w & 1;
            pg8::Gemm g{second ? (const bf16_t*)p.out : (const bf16_t*)(ws + WS_YA), (const bf16_t*)(ws + (second ? WS_WBB : WS_WBA)), T, 1024, 512, 512, 512}; pg8::StaticOrder S; S.init(T, 1024, G, bx);
            EpiBranch E{MG, GP, second}; pg8::gemm_phase<EpiBranch, true>(lds3, g, S, E);
        }
    } SEAM(7);
    if (IN(8)) {
        pg8::Gemm g{(const bf16_t*)(ws + WS_MG), (const bf16_t*)(ws + WS_WOUT), T, 1024, 1024, 1024, 1024}; pg8::StaticOrder S; S.init(T, 1024, G, bx);
        EpiOut E{p.in[I_X], p.out, (bf16_t*)(ws + WS_X1B), (float*)(ws + WS_SSQ)};
        RLOOP(8) pg8::gemm_phase<EpiOut, true>(lds3, g, S, E);
    } SEAM(8);
    if (IN(9)) {
        pg8::Gemm g{(const bf16_t*)(ws + WS_X1B), (const bf16_t*)(ws + WS_WUP), T, NPROJ, 1024, 1024, 1024}; pg8::StaticOrder S; S.init(T, NPROJ, G, bx);
        EpiUp E{(bf16_t*)(ws + WS_U), (const float*)(ws + WS_SSQ), p.in[I_CW], p.in[I_CB]};
        RLOOP(9) pg8::gemm_phase<EpiUp, true>(lds3, g, S, E);
    } SEAM(9);
    if (IN(10)) { RLOOP(10) phase10(p, r_ + 1 < p.rep[10]); } SEAM(10);
    if (IN(11)) {
        pg8::Gemm g{(const bf16_t*)(ws + WS_U) + DFF, (const bf16_t*)(ws + WS_WDN), T, 1024, DFF, NPROJ, DFF}; pg8::StaticOrder S; S.init(T, 1024, G, bx);
        RLOOP(11) { EpiDown E{p.out, (const bf16_t*)(ws + WS_X1B), r_ + 1 < p.rep[11]}; pg8::gemm_phase<EpiDown, true>(lds3, g, S, E); }
    }
#undef IN
#undef SEAM
}

extern "C" void kernel_launch(void* const* d_in, const int* in_sizes, int n_in, void* d_out, int out_size, void* d_ws, size_t ws_size, hipStream_t stream) {
    static int grid = 0;
    if (grid == 0) {
        if (n_in != 25 || out_size != T * DM || ws_size < WS_END) { fprintf(stderr, "kernel_launch: unexpected shapes (n_in %d out %d ws %zu)\n", n_in, out_size, ws_size); grid = -1; return; }
        int dev = 0, cus = 0, per_cu = 0;
        hipGetDevice(&dev); hipDeviceGetAttribute(&cus, hipDeviceAttributeMultiprocessorCount, dev);
        if (hipFuncSetAttribute((const void*)hybrid_fwd, hipFuncAttributeMaxDynamicSharedMemorySize, LDS_BYTES) != hipSuccess) { fprintf(stderr, "kernel_launch: hipFuncSetAttribute failed\n"); grid = -1; return; }
        hipOccupancyMaxActiveBlocksPerMultiprocessor(&per_cu, (const void*)hybrid_fwd, 512, LDS_BYTES);
        (void)hipGetLastError();
        if (per_cu < 1) per_cu = 1;
        grid = cus * per_cu; if (grid > 256) grid = 256;
        if (grid != 256) fprintf(stderr, "kernel_launch: grid %d (expected 256)\n", grid);
    }
    if (grid < 0) return;
    (void)hipMemsetAsync((char*)d_ws + WS_CTL, 0, 65536, stream);
    Params p{};
    for (int i = 0; i < 25; ++i) p.in[i] = (const float*)d_in[i];
    p.out = (float*)d_out; p.ws = (unsigned char*)d_ws;
    for (int i = 0; i < 14; ++i) p.rep[i] = 1;
    p.rep[13] = 0;
#ifdef PROBE_SYNCS
    p.rep[13] = PROBE_SYNCS;
#endif
#ifdef PROBE_PHASE
    p.rep[PROBE_PHASE] = 2;
#endif
#ifdef PROBE_PHASE2
    p.rep[PROBE_PHASE2] = 2;
#endif
#if MK_SPLIT
    for (int ph = 0; ph < NPHASE; ++ph) { p.lo = ph; p.hi = ph + 1; void* args[] = {&p};
        hipError_t e = hipLaunchCooperativeKernel((const void*)hybrid_fwd, dim3(grid), dim3(512), args, LDS_BYTES, stream);
        if (e != hipSuccess) { fprintf(stderr, "cooperative launch (phase %d) failed: %s\n", ph, hipGetErrorString(e)); break; } }
#else
    p.lo = 0; p.hi = NPHASE; void* args[] = {&p};
    hipError_t e = hipLaunchCooperativeKernel((const void*)hybrid_fwd, dim3(grid), dim3(512), args, LDS_BYTES, stream);
    if (e != hipSuccess) fprintf(stderr, "cooperative launch failed: %s (grid %d)\n", hipGetErrorString(e), grid);
#endif
}
```

```cpp
#include <hip/hip_runtime.h>
#include <hip/hip_cooperative_groups.h>
#include <cstdio>
#include <cstdint>
namespace cg = cooperative_groups;

#ifndef MK_SPLIT
#define MK_SPLIT 0
#endif

namespace pg8 {
#define PG8_LAS __attribute__((address_space(3)))
typedef unsigned short bf16_t;
typedef short bf16x8 __attribute__((ext_vector_type(8)));
typedef float f32x4 __attribute__((ext_vector_type(4)));
typedef unsigned u32x4 __attribute__((ext_vector_type(4)));
typedef unsigned u32x2 __attribute__((ext_vector_type(2)));
constexpr int BM = 256, BK = 64, HALF = 128, HTB = HALF * BK * 2, STAGE_BYTES = 8 * HTB, NXCD = 8, WGM = 4;

__host__ __device__ __forceinline__ int lds_byte(int r, int c) { const int st = (r >> 4) * 2 + (c >> 5), rr = r & 15, cc = c & 31, ob = rr * 64 + cc * 2; return st * 1024 + (ob ^ (((ob >> 9) & 1) << 5)); }
__host__ __device__ __forceinline__ void stage_rc(int b, int& R, int& C) { const int st = b / 1024, sb = b % 1024, swz = sb ^ (((sb >> 9) & 1) << 5); R = (st >> 1) * 16 + swz / 64; C = (st & 1) * 32 + (swz % 64) / 2; }
__host__ __device__ __forceinline__ int perm32(int rho) { const int n = rho >> 4, i = rho & 15; return 8 * (i >> 2) + 4 * n + (i & 3); }

struct Unit { int pm, pn; };
struct Gemm { const bf16_t* A; const bf16_t* Bt; int M, N, K, lda, ldb; };

struct StaticOrder {
    int nM, nN, nwg, G, c, wgm;
    __host__ __device__ void init(int M, int N, int G_, int c_) { nM = M / BM; nN = N / BM; nwg = nM * nN; G = G_; c = c_; wgm = nN > 8 ? 4 : 8; }
    __host__ __device__ bool next(int i, Unit& u) const {
        const long L = (long)i * G + c; if (L >= nwg) return false;
        int wgid = (int)L; { const int q = nwg / NXCD, r = nwg % NXCD, xcd = wgid % NXCD, off = wgid / NXCD; wgid = (xcd < r ? xcd * (q + 1) : r * (q + 1) + (xcd - r) * q) + off; }
        const int nig = wgm * nN, gid = wgid / nig, fm = gid * wgm, gsz = (nM - fm) < wgm ? (nM - fm) : wgm;
        u.pm = fm + ((wgid % nig) % gsz); u.pn = (wgid % nig) / gsz; return true;
    }
};

__device__ __forceinline__ unsigned cvt_pk_bf16(float lo, float hi) { unsigned r; asm volatile("v_cvt_pk_bf16_f32 %0, %1, %2" : "=v"(r) : "v"(lo), "v"(hi)); return r; }

template <class Epi, bool ALIGN_EPI>
__device__ __forceinline__ void gemm_phase(PG8_LAS unsigned char* lds, const Gemm g, const StaticOrder& S, const Epi& E) {
    const int tid = threadIdx.x, wid = __builtin_amdgcn_readfirstlane(tid >> 6), lane = tid & 63, wr = wid >> 2, wc = wid & 3, fr = lane & 15, fq = lane >> 4;
    const int K = g.K, nt = K / BK;
    unsigned voffA[2], voffB[2];
#pragma unroll
    for (int i = 0; i < 2; ++i) { int R, C; stage_rc(tid * 16 + i * 8192, R, C); const int Rb = Epi::PERM ? ((R & ~31) + perm32(R & 31)) : R;
        voffA[i] = (unsigned)(R * g.lda + C) * 2u; voffB[i] = (unsigned)(Rb * g.ldb + C) * 2u; }
    const size_t kstep = (size_t)(BK * 2);
    const size_t hstepA = (size_t)HALF * g.lda * 2, hstepB = (size_t)HALF * g.ldb * 2;
    const size_t tstepA = 2 * hstepA, tstepB = 2 * hstepB;
    const unsigned ldsw = (unsigned)wid * 1024u;
    const int aoff = lds_byte(wr * 64 + fr, fq * 8), boff = lds_byte(wc * 32 + fr, fq * 8);
#define PG8_SA(b, h) (((b) * 2 + (h)) * HTB)
#define PG8_SB(b, h) ((4 + (b) * 2 + (h)) * HTB)
#define PG8_STAGE(bufoff, gbase, voff) do { _Pragma("unroll") for (int _i = 0; _i < 2; ++_i) \
        __builtin_amdgcn_global_load_lds((const unsigned*)((const char*)(gbase) + (voff)[_i]), (PG8_LAS unsigned*)(lds + (bufoff) + ldsw + _i * 8192), 16, 0, 0); } while (0)
#define PG8_LDA(dst, b, h) do { _Pragma("unroll") for (int m = 0; m < 4; ++m) _Pragma("unroll") for (int k = 0; k < 2; ++k) dst[m][k] = *(const PG8_LAS bf16x8*)(lds + PG8_SA(b, h) + aoff + m * 2048 + k * 1024); } while (0)
#define PG8_LDB(dst, b, h) do { _Pragma("unroll") for (int n = 0; n < 2; ++n) _Pragma("unroll") for (int k = 0; k < 2; ++k) dst[n][k] = *(const PG8_LAS bf16x8*)(lds + PG8_SB(b, h) + boff + n * 2048 + k * 1024); } while (0)
#define PG8_MMA(ai, bj, At, Bt) do { __builtin_amdgcn_s_setprio(1); _Pragma("unroll") for (int m = 0; m < 4; ++m) _Pragma("unroll") for (int n = 0; n < 2; ++n) _Pragma("unroll") for (int k = 0; k < 2; ++k) \
        acc[ai][bj][m][n] = __builtin_amdgcn_mfma_f32_16x16x32_bf16(Bt[n][k], At[m][k], acc[ai][bj][m][n], 0, 0, 0); __builtin_amdgcn_s_setprio(0); } while (0)
#define PG8_WAIT_V(n) asm volatile("s_waitcnt vmcnt(" #n ")" ::: "memory")
#define PG8_WAIT_L(n) asm volatile("s_waitcnt lgkmcnt(" #n ")" ::: "memory")
#define PG8_BAR __builtin_amdgcn_s_barrier()
#define PG8_SCHED __builtin_amdgcn_sched_barrier(0)
    Unit cur, nxt; int ui = 0;
    if (!S.next(0, cur)) return;
    f32x4 acc[2][2][4][2];
#pragma unroll
    for (int a = 0; a < 2; ++a)
#pragma unroll
        for (int b = 0; b < 2; ++b)
#pragma unroll
            for (int m = 0; m < 4; ++m)
#pragma unroll
                for (int n = 0; n < 2; ++n) acc[a][b][m][n] = (f32x4){0.f, 0.f, 0.f, 0.f};
    bf16x8 At[4][2], B0[2][2], B1[2][2];
    const char* cA = (const char*)g.A + (size_t)cur.pm * tstepA; const char* cB = (const char*)g.Bt + (size_t)cur.pn * tstepB;
    PG8_STAGE(PG8_SB(0, 0), cB, voffB); PG8_STAGE(PG8_SB(0, 1), cB + hstepB, voffB); PG8_STAGE(PG8_SA(0, 0), cA, voffA); PG8_STAGE(PG8_SA(0, 1), cA + hstepA, voffA);
    if (wr == 1) PG8_BAR;
    PG8_WAIT_V(2); PG8_BAR;
    PG8_STAGE(PG8_SB(1, 0), cB + kstep, voffB); PG8_STAGE(PG8_SA(1, 0), cA + kstep, voffA); PG8_STAGE(PG8_SB(1, 1), cB + hstepB + kstep, voffB);
    PG8_WAIT_V(6); PG8_BAR;
    for (;;) {
        const bool has_next = S.next(ui + 1, nxt);
        const char* nA = has_next ? (const char*)g.A + (size_t)nxt.pm * tstepA : cA; const char* nB = has_next ? (const char*)g.Bt + (size_t)nxt.pn * tstepB : cB;
        for (int t = 0; t < nt; t += 2) {
            const bool last = (t == nt - 2);
            const char* a1 = cA + (size_t)(t + 1) * kstep;
            const char* a2 = last ? nA : cA + (size_t)(t + 2) * kstep; const char* b2 = last ? nB : cB + (size_t)(t + 2) * kstep;
            const char* a3 = a2 + kstep; const char* b3 = b2 + kstep;
            PG8_LDB(B0, 0, 0); PG8_LDB(B1, 0, 1); PG8_SCHED; PG8_LDA(At, 0, 0); PG8_STAGE(PG8_SA(1, 1), a1 + hstepA, voffA);
            PG8_WAIT_V(8); PG8_WAIT_L(0); PG8_BAR; PG8_MMA(0, 0, At, B0); PG8_MMA(0, 1, At, B1); PG8_BAR; PG8_SCHED;
            PG8_LDA(At, 0, 1); PG8_STAGE(PG8_SB(0, 0), b2, voffB); PG8_STAGE(PG8_SB(0, 1), b2 + hstepB, voffB); PG8_STAGE(PG8_SA(0, 0), a2, voffA);
            PG8_WAIT_V(8); PG8_WAIT_L(0); PG8_BAR; PG8_MMA(1, 0, At, B0); PG8_MMA(1, 1, At, B1); PG8_BAR; PG8_SCHED;
            PG8_LDB(B0, 1, 0); PG8_LDB(B1, 1, 1); PG8_SCHED; PG8_LDA(At, 1, 0); PG8_STAGE(PG8_SA(0, 1), a2 + hstepA, voffA);
            PG8_WAIT_V(8); PG8_WAIT_L(0); PG8_BAR; PG8_MMA(0, 0, At, B0); PG8_MMA(0, 1, At, B1); PG8_BAR; PG8_SCHED;
            PG8_LDA(At, 1, 1); PG8_STAGE(PG8_SB(1, 0), b3, voffB); PG8_STAGE(PG8_SB(1, 1), b3 + hstepB, voffB); PG8_STAGE(PG8_SA(1, 0), a3, voffA);
            PG8_WAIT_V(8); PG8_WAIT_L(0); PG8_BAR; PG8_MMA(1, 0, At, B0); PG8_MMA(1, 1, At, B1); PG8_BAR; PG8_SCHED;
        }
        if constexpr (ALIGN_EPI) { if (wr == 0) PG8_BAR; }
        E(acc, cur, wr, wc, fr, fq);
        if (!has_next) break;
#pragma unroll
        for (int a = 0; a < 2; ++a)
#pragma unroll
            for (int b = 0; b < 2; ++b)
#pragma unroll
                for (int m = 0; m < 4; ++m)
#pragma unroll
                    for (int n = 0; n < 2; ++n) acc[a][b][m][n] = (f32x4){0.f, 0.f, 0.f, 0.f};
        cur = nxt; cA = nA; cB = nB; ++ui;
        if constexpr (ALIGN_EPI) { if (wr == 1) PG8_BAR; }
    }
    PG8_WAIT_V(0);
    if constexpr (!ALIGN_EPI) { if (wr == 0) PG8_BAR; }
    PG8_BAR;
#undef PG8_SA
#undef PG8_SB
#undef PG8_STAGE
#undef PG8_LDA
#undef PG8_LDB
#undef PG8_MMA
#undef PG8_WAIT_V
#undef PG8_WAIT_L
#undef PG8_BAR
#undef PG8_SCHED
}
}

using pg8::bf16_t; using pg8::f32x4; using pg8::u32x4; using pg8::u32x2; using pg8::bf16x8; using pg8::cvt_pk_bf16;
typedef float f32x16 __attribute__((ext_vector_type(16)));

constexpr int NB = 8, SEQ = 4096, DM = 1024, T = NB * SEQ;
constexpr int NPROJ = 5632;
constexpr int IN_COLS = 5408, DFF = 2816;
constexpr size_t MiB = 1u << 20;
constexpr size_t WS_CTL = 0;
constexpr size_t WS_WIN = 1 * MiB, WS_WUP = 12 * MiB, WS_WDN = 23 * MiB, WS_WOUT = 29 * MiB, WS_WBA = 31 * MiB, WS_WBB = 32 * MiB;
constexpr size_t WS_WD = 33 * MiB, WS_WA = 33 * MiB + 256 * 1024, WS_WG = 33 * MiB + 512 * 1024;
constexpr size_t WS_KMEAN = 34 * MiB, WS_SBON = 35 * MiB, WS_SSQ = 36 * MiB;
constexpr size_t WS_GP = 38 * MiB, WS_ZR = 166 * MiB, WS_ZM = 294 * MiB, WS_HB = 390 * MiB, WS_EX = 454 * MiB, WS_END = 486 * MiB;
constexpr size_t WS_E = WS_HB, WS_ALR = WS_HB + 32 * MiB, WS_G = WS_EX;
constexpr size_t WS_R = WS_ZM, WS_K = WS_ZM + 32 * MiB, WS_V = WS_ZM + 64 * MiB;
constexpr size_t WS_YA = WS_ZM + 64 * MiB,         WS_MG = WS_ZM, WS_X1B = WS_HB, WS_U = WS_GP;
constexpr size_t OUT_LA = 0, OUT_KK = 0, OUT_Q = 32 * MiB, OUT_KP = 64 * MiB, OUT_VT = 96 * MiB;
constexpr int LDS_BYTES = 147456, LDS_MISC = 131072;

struct Params {
    const float* in[25]; float* out; unsigned char* ws; int lo, hi; int rep[14];
};
enum { I_X = 0, I_POS, I_N1G, I_WIN, I_MU, I_WDU, I_DB, I_WAU, I_AB, I_WGU, I_KK, I_KA, I_RK, I_LNG, I_LNB, I_QNG, I_KNG, I_WBA, I_WBB, I_WOUT, I_N2G, I_WUP, I_CW, I_CB, I_WDN };

__device__ __forceinline__ float bf_lo(unsigned w) { return __uint_as_float(w << 16); }
__device__ __forceinline__ float bf_hi(unsigned w) { return __uint_as_float(w & 0xffff0000u); }
__device__ __forceinline__ void unpack8(const u32x4 w, float* f) { f[0] = bf_lo(w.x); f[1] = bf_hi(w.x); f[2] = bf_lo(w.y); f[3] = bf_hi(w.y); f[4] = bf_lo(w.z); f[5] = bf_hi(w.z); f[6] = bf_lo(w.w); f[7] = bf_hi(w.w); }
__device__ __forceinline__ u32x4 pack8(const float* f) { u32x4 w; w.x = cvt_pk_bf16(f[0], f[1]); w.y = cvt_pk_bf16(f[2], f[3]); w.z = cvt_pk_bf16(f[4], f[5]); w.w = cvt_pk_bf16(f[6], f[7]); return w; }
__device__ __forceinline__ size_t hm_idx(size_t t, int c) { return ((((t >> 12) * 8 + (size_t)(c >> 6)) * 4096 + (t & 4095)) << 6) + (size_t)(c & 63); }
__device__ __forceinline__ float sigmoidf_(float x) { return 1.f / (1.f + __expf(-x)); }
__device__ __forceinline__ float wave_sum(float v) {
#pragma unroll
    for (int o = 1; o < 64; o <<= 1) v += __shfl_xor(v, o);
    return v;
}

__device__ __forceinline__ float gelu_erf(float v) {
    const float av = fabsf(v), t = __builtin_amdgcn_rcpf(av * 0.2316418882f + 1.0f);
    float q = t * 0.5307027145f + (-0.7265760135f); q = q * t + 0.7107068705f; q = q * t + (-0.142248368f); q = q * t + 0.127414796f; q = q * t;
    const float e = __builtin_amdgcn_exp2f((v * v) * (-0.72134752044f));
    const float m = v * (q * e);
    return v < 0.f ? m : v - m;
}
template <int CTRL> __device__ __forceinline__ float dpp_mov0(float x) { return __int_as_float(__builtin_amdgcn_update_dpp(0, __float_as_int(x), CTRL, 0xF, 0xF, false)); }
struct EpiProj {
    static constexpr bool PERM = true;
    bf16_t* zr; bf16_t* zm; bf16_t* gp; bf16_t* la; const float* mu; bool dry;
    __device__ __forceinline__ void operator()(const f32x4 (&acc)[2][2][4][2], const pg8::Unit& u, int wr, int wc, int fr, int fq) const {
        if (u.pn == 6 || u.pn == 7) {
            const int row0 = u.pm * 256 + wr * 64 + fr;
#pragma unroll
            for (int bj = 0; bj < 2; ++bj) {
                const int c = u.pn * 256 + bj * 128 + wc * 32 + 8 * fq;
                const int mode = c < 1600 ? 1 : (c < 1664 ? 0 : (c < 1824 ? 2 : 3));
                const int kq = c - 1824;
                const int dc = c < 1600 ? c - 1536 : (c < 1664 ? c - 1600 + 128 : (c < 1824 ? c - 1664 + 256 : (kq < 64 ? 64 + kq : (kq < 128 ? 192 + (kq - 64) : 416 + (kq - 128)))));
                const int mc_ = mode == 3 ? 0 : c;
                const f32x4 mu0 = *(const f32x4*)(mu + mc_), mu1 = *(const f32x4*)(mu + mc_ + 4);
#pragma unroll
                for (int ai = 0; ai < 2; ++ai)
#pragma unroll
                    for (int m = 0; m < 4; ++m) { const size_t row = (size_t)(row0 + ai * 128 + m * 16); float o[8], rawv[8];
#pragma unroll
                        for (int i = 0; i < 8; ++i) { const float cur = acc[ai][bj][m][i >> 2][i & 3];
                            const float oldv = m > 0 ? dpp_mov0<0x121>(acc[ai][bj][m > 0 ? m - 1 : 0][i >> 2][i & 3]) : 0.f;
                            const float prev = __int_as_float(__builtin_amdgcn_update_dpp(__float_as_int(oldv), __float_as_int(cur), 0x111, 0xF, 0xF, false));
                            const float mui = i < 4 ? mu0[i & 3] : mu1[i & 3];
                            const float z = cur + mui * (prev - cur), zz = mode == 1 ? 2.f * z : z, sg = 1.f / (1.f + __expf(-zz));
                            o[i] = mode == 1 ? 2.f * sg - 1.f : (mode == 2 ? sg : (mode == 0 ? z : 0.f)); rawv[i] = cur; }
                        if (!(m == 0 && fr == 0)) *(u32x4*)(la + row * 512 + dc) = pack8(o);
                        if ((m == 0 && fr == 0) || (m == 3 && fr == 15)) *(u32x4*)(zr + row * 2048 + c) = pack8(rawv);
                        asm volatile("" ::: "memory"); }
            }
            return;
        }
        bf16_t* base; int ldc, colt;
        if (u.pn < 8) { base = zr; ldc = 2048; colt = u.pn * 256; } else if (u.pn < 14) { base = zm; ldc = 1536; colt = (u.pn - 8) * 256; } else { base = gp; ldc = 2048; colt = (u.pn - 14) * 256; }
        const int row0 = u.pm * 256 + wr * 64 + fr, col0 = colt + wc * 32 + 8 * fq;
#pragma unroll
        for (int ai = 0; ai < 2; ++ai)
#pragma unroll
            for (int m = 0; m < 4; ++m) { bf16_t* rowp = base + (size_t)(row0 + ai * 128 + m * 16) * ldc + col0;
#pragma unroll
                for (int bj = 0; bj < 2; ++bj) { const f32x4 v0 = acc[ai][bj][m][0], v1 = acc[ai][bj][m][1]; u32x4 w;
                    w.x = cvt_pk_bf16(v0[0], v0[1]); w.y = cvt_pk_bf16(v0[2], v0[3]); w.z = cvt_pk_bf16(v1[0], v1[1]); w.w = cvt_pk_bf16(v1[2], v1[3]);
                    if (!dry) *(u32x4*)(rowp + bj * 128) = w; } }
    }
};
struct EpiLora {
    static constexpr bool PERM = true;
    bf16_t* O; const float* bias; int mode;
    __device__ __forceinline__ void operator()(const f32x4 (&acc)[2][2][4][2], const pg8::Unit& u, int wr, int wc, int fr, int fq) const {
        const int row0 = u.pm * 256 + wr * 64 + fr, col0 = u.pn * 256 + wc * 32 + 8 * fq;
        const float sc = mode == 0 ? 0.6065306597126334f : 1.f;
#pragma unroll
        for (int bj = 0; bj < 2; ++bj) {
            f32x4 b0 = {0.f, 0.f, 0.f, 0.f}, b1 = {0.f, 0.f, 0.f, 0.f};
            if (mode != 2) { b0 = *(const f32x4*)(bias + col0 + bj * 128); b1 = *(const f32x4*)(bias + col0 + bj * 128 + 4); }
#pragma unroll
            for (int ai = 0; ai < 2; ++ai)
#pragma unroll
                for (int m = 0; m < 4; ++m) { const size_t row_ = (size_t)(row0 + ai * 128 + m * 16); bf16_t* rowp = O + (mode == 2 ? row_ * 512 + col0 + bj * 128 : hm_idx(row_, col0 + bj * 128));
                    f32x4 v0 = acc[ai][bj][m][0] + b0, v1 = acc[ai][bj][m][1] + b1;
                    if (mode != 2) {
#pragma unroll
                        for (int i = 0; i < 4; ++i) { v0[i] = sigmoidf_(v0[i]) * sc; v1[i] = sigmoidf_(v1[i]) * sc; } }
                    u32x4 w; w.x = cvt_pk_bf16(v0[0], v0[1]); w.y = cvt_pk_bf16(v0[2], v0[3]); w.z = cvt_pk_bf16(v1[0], v1[1]); w.w = cvt_pk_bf16(v1[2], v1[3]);
                    *(u32x4*)rowp = w;
                    asm volatile("" ::: "memory"); }
        }
    }
};
struct EpiBranch {
    static constexpr bool PERM = true;
    bf16_t* MG; const bf16_t* GP; int second;
    __device__ __forceinline__ void operator()(const f32x4 (&acc)[2][2][4][2], const pg8::Unit& u, int wr, int wc, int fr, int fq) const {
        const int row0 = u.pm * 256 + wr * 64 + fr, col0 = u.pn * 256 + wc * 32 + 8 * fq;
        u32x4 cg[2], cm[2], ng[2], nm[2];
#pragma unroll
        for (int bj = 0; bj < 2; ++bj) { cg[bj] = *(const u32x4*)(GP + (size_t)row0 * 2048 + second * 1024 + col0 + bj * 128);
            cm[bj] = second ? *(const u32x4*)(MG + (size_t)row0 * 1024 + col0 + bj * 128) : (u32x4){0u, 0u, 0u, 0u}; ng[bj] = cg[bj]; nm[bj] = cm[bj]; }
#pragma unroll
        for (int g = 0; g < 8; ++g) { const int ai = g >> 2, m = g & 3; const size_t row = (size_t)(row0 + ai * 128 + m * 16);
            if (g + 1 < 8) { const size_t rown = (size_t)(row0 + ((g + 1) >> 2) * 128 + ((g + 1) & 3) * 16);
#pragma unroll
                for (int bj = 0; bj < 2; ++bj) { ng[bj] = *(const u32x4*)(GP + rown * 2048 + second * 1024 + col0 + bj * 128);
                    if (second) nm[bj] = *(const u32x4*)(MG + rown * 1024 + col0 + bj * 128); }
                asm volatile("" ::: "memory"); }
#pragma unroll
            for (int bj = 0; bj < 2; ++bj) { const int col = col0 + bj * 128; float v[8], gt[8], pv[8];
#pragma unroll
                for (int i = 0; i < 4; ++i) { v[i] = acc[ai][bj][m][0][i]; v[4 + i] = acc[ai][bj][m][1][i]; }
                unpack8(cg[bj], gt); unpack8(cm[bj], pv);
#pragma unroll
                for (int i = 0; i < 8; ++i) v[i] = v[i] * sigmoidf_(gt[i]) + pv[i];
                *(u32x4*)(MG + row * 1024 + col) = pack8(v); }
#pragma unroll
            for (int bj = 0; bj < 2; ++bj) { cg[bj] = ng[bj]; cm[bj] = nm[bj]; } }
    }
};
struct EpiOut {
    static constexpr bool PERM = true;
    const float* x; float* x1; bf16_t* x1b; float* ssq;
    __device__ __forceinline__ void operator()(const f32x4 (&acc)[2][2][4][2], const pg8::Unit& u, int wr, int wc, int fr, int fq) const {
        const int row0 = u.pm * 256 + wr * 64 + fr, col0 = u.pn * 256 + wc * 32 + 8 * fq;
        f32x4 cur[2][2], nxt[2][2];
#pragma unroll
        for (int bj = 0; bj < 2; ++bj)
#pragma unroll
            for (int n = 0; n < 2; ++n) { cur[bj][n] = *(const f32x4*)(x + (size_t)row0 * 1024 + col0 + bj * 128 + n * 4); nxt[bj][n] = cur[bj][n]; }
#pragma unroll
        for (int g = 0; g < 8; ++g) { const int ai = g >> 2, m = g & 3; const size_t row = (size_t)(row0 + ai * 128 + m * 16); float s = 0.f;
            if (g + 1 < 8) { const size_t rown = (size_t)(row0 + ((g + 1) >> 2) * 128 + ((g + 1) & 3) * 16);
#pragma unroll
                for (int bj = 0; bj < 2; ++bj)
#pragma unroll
                    for (int n = 0; n < 2; ++n) nxt[bj][n] = *(const f32x4*)(x + rown * 1024 + col0 + bj * 128 + n * 4);
                asm volatile("" ::: "memory"); }
#pragma unroll
            for (int bj = 0; bj < 2; ++bj) { const size_t off = row * 1024 + col0 + bj * 128;
                const f32x4 r0 = cur[bj][0] + acc[ai][bj][m][0], r1 = cur[bj][1] + acc[ai][bj][m][1];
                u32x4 w; w.x = cvt_pk_bf16(r0[0], r0[1]); w.y = cvt_pk_bf16(r0[2], r0[3]); w.z = cvt_pk_bf16(r1[0], r1[1]); w.w = cvt_pk_bf16(r1[2], r1[3]);
                *(u32x4*)(x1b + off) = w;
                s += ((r0[0] * r0[0] + r0[1] * r0[1]) + (r0[2] * r0[2] + r0[3] * r0[3])) + ((r1[0] * r1[0] + r1[1] * r1[1]) + (r1[2] * r1[2] + r1[3] * r1[3])); }
            s += __shfl_xor(s, 16); s += __shfl_xor(s, 32);
            if (fq == 0) ssq[row * 16 + u.pn * 4 + wc] = s;
#pragma unroll
            for (int bj = 0; bj < 2; ++bj)
#pragma unroll
                for (int n = 0; n < 2; ++n) cur[bj][n] = nxt[bj][n]; }
    }
};
template <int CTRL> __device__ __forceinline__ float dpp_mov(float x) { return __int_as_float(__builtin_amdgcn_update_dpp(0, __float_as_int(x), CTRL, 0xF, 0xF, false)); }
struct EpiUp {
    static constexpr bool PERM = true;
    bf16_t* U; const float* ssq; const float* cw; const float* cb;
    __device__ __forceinline__ void operator()(const f32x4 (&acc)[2][2][4][2], const pg8::Unit& u, int wr, int wc, int fr, int fq) const {
        const int row0 = u.pm * 256 + wr * 64 + fr, cl = u.pn * 128 + wc * 32 + 8 * fq;
#pragma unroll
        for (int n = 0; n < 2; ++n) {
            const int c4 = cl + 4 * n;
            const f32x4 w0 = *(const f32x4*)(cw + c4), w1 = *(const f32x4*)(cw + DFF + c4), w2 = *(const f32x4*)(cw + 2 * DFF + c4), bs = *(const f32x4*)(cb + c4);
            f32x4 cs4[4], ns4[4];
            f32x4 avp = {0.f, 0.f, 0.f, 0.f};
#pragma unroll
            for (int q = 0; q < 4; ++q) { cs4[q] = ((const f32x4*)(ssq + (size_t)row0 * 16))[q]; ns4[q] = cs4[q]; }
#pragma unroll
            for (int g = 0; g < 8; ++g) { const int ai = g >> 2, m = g & 3; const size_t row = (size_t)(row0 + ai * 128 + m * 16);
                if (g + 1 < 8) { const size_t rown = (size_t)(row0 + ((g + 1) >> 2) * 128 + ((g + 1) & 3) * 16);
#pragma unroll
                    for (int q = 0; q < 4; ++q) ns4[q] = ((const f32x4*)(ssq + rown * 16))[q];
                    asm volatile("" ::: "memory"); }
                const f32x4 sa_ = cs4[0], sb_ = cs4[1], sc_ = cs4[2], sd_ = cs4[3];
                const float ss = ((sa_[0] + sa_[1]) + (sa_[2] + sa_[3])) + ((sb_[0] + sb_[1]) + (sb_[2] + sb_[3])) + ((sc_[0] + sc_[1]) + (sc_[2] + sc_[3])) + ((sd_[0] + sd_[1]) + (sd_[2] + sd_[3]));
                const float rstd = rsqrtf(ss * (1.f / 1024.f) + 1e-6f);
                const f32x4 av = acc[ai][0][m][n] * rstd, bv = acc[ai][1][m][n] * rstd; f32x4 o;
#pragma unroll
                for (int i = 0; i < 4; ++i) {
                    const float o1 = m > 0 ? dpp_mov<0x121>(avp[i]) : 0.f, o2 = m > 0 ? dpp_mov<0x122>(avp[i]) : 0.f;
                    const float p1 = __int_as_float(__builtin_amdgcn_update_dpp(__float_as_int(o1), __float_as_int(av[i]), 0x111, 0xF, 0xF, false));
                    const float p2 = __int_as_float(__builtin_amdgcn_update_dpp(__float_as_int(o2), __float_as_int(av[i]), 0x112, 0xF, 0xF, false));
                    const float v = w0[i] * p2 + w1[i] * p1 + w2[i] * av[i] + bs[i]; o[i] = gelu_erf(v) * bv[i]; }
                bf16_t* ua = U + row * NPROJ + c4; bf16_t* ub = ua + DFF;
                u32x2 pa, pb, po; pa.x = cvt_pk_bf16(av[0], av[1]); pa.y = cvt_pk_bf16(av[2], av[3]); pb.x = cvt_pk_bf16(bv[0], bv[1]); pb.y = cvt_pk_bf16(bv[2], bv[3]);
                po.x = cvt_pk_bf16(o[0], o[1]); po.y = cvt_pk_bf16(o[2], o[3]);
                if (fr >= 2 || m > 0) { *(u32x2*)ub = po; if (fr >= 14 && m == 3) *(u32x2*)ua = pa; }
                else { *(u32x2*)ua = pa; *(u32x2*)ub = pb; }
                avp = av;
#pragma unroll
                for (int q = 0; q < 4; ++q) cs4[q] = ns4[q]; }
        }
    }
};
struct EpiDown {
    static constexpr bool PERM = true;
    float* out; const bf16_t* x1b; bool dry;
    __device__ __forceinline__ void operator()(const f32x4 (&acc)[2][2][4][2], const pg8::Unit& u, int wr, int wc, int fr, int fq) const {
        const int row0 = u.pm * 256 + wr * 64 + fr, col0 = u.pn * 256 + wc * 32 + 8 * fq;
        u32x4 cur[2], nxt[2];
#pragma unroll
        for (int bj = 0; bj < 2; ++bj) { cur[bj] = *(const u32x4*)(x1b + (size_t)row0 * 1024 + col0 + bj * 128); nxt[bj] = cur[bj]; }
#pragma unroll
        for (int g = 0; g < 8; ++g) { const int ai = g >> 2, m = g & 3; const size_t row = (size_t)(row0 + ai * 128 + m * 16);
            if (g + 1 < 8) { const size_t rown = (size_t)(row0 + ((g + 1) >> 2) * 128 + ((g + 1) & 3) * 16);
#pragma unroll
                for (int bj = 0; bj < 2; ++bj) nxt[bj] = *(const u32x4*)(x1b + rown * 1024 + col0 + bj * 128);
                asm volatile("" ::: "memory"); }
#pragma unroll
            for (int bj = 0; bj < 2; ++bj) { const size_t off = row * 1024 + col0 + bj * 128; const u32x4 xb = cur[bj];
                const f32x4 x0 = {bf_lo(xb.x), bf_hi(xb.x), bf_lo(xb.y), bf_hi(xb.y)}, x1 = {bf_lo(xb.z), bf_hi(xb.z), bf_lo(xb.w), bf_hi(xb.w)};
                const f32x4 r0 = x0 + acc[ai][bj][m][0], r1 = x1 + acc[ai][bj][m][1];
                if (!dry) { *(f32x4*)(out + off) = r0; *(f32x4*)(out + off + 4) = r1; } }
#pragma unroll
            for (int bj = 0; bj < 2; ++bj) cur[bj] = nxt[bj]; }
    }
};

__device__ __forceinline__ void tr_item(const float* W, int Ksrc, int Nsrc, int srccol0, const float* rowscale, bf16_t* WT, int ldk, int n0, int k0, float* scr, int lane) {
    float v[32]; const int nn = lane & 31; const bool colok = srccol0 >= 0; const float* Wc = W + (colok ? srccol0 : 0) + nn;
#pragma unroll
    for (int i = 0; i < 32; ++i) { const int k = k0 + 2 * i + (lane >> 5); const bool ok = colok && k < Ksrc; const int kc = ok ? k : 0;
        float t = Wc[(size_t)kc * Nsrc]; if (rowscale) t *= rowscale[kc]; v[i] = ok ? t : 0.f; }
#pragma unroll
    for (int i = 0; i < 32; ++i) scr[(2 * i + (lane >> 5)) * 33 + nn] = v[i];
    asm volatile("s_waitcnt lgkmcnt(0)" ::: "memory");
    const int c = lane & 7;
#pragma unroll
    for (int j = 0; j < 4; ++j) { const int n = (lane >> 3) + 8 * j; const float* s = scr + (8 * c) * 33 + n;
        u32x4 o; o.x = cvt_pk_bf16(s[0 * 33], s[1 * 33]); o.y = cvt_pk_bf16(s[2 * 33], s[3 * 33]); o.z = cvt_pk_bf16(s[4 * 33], s[5 * 33]); o.w = cvt_pk_bf16(s[6 * 33], s[7 * 33]);
        *(u32x4*)(WT + (size_t)(n0 + n) * ldk + k0 + 8 * c) = o; }
    asm volatile("s_waitcnt lgkmcnt(0)" ::: "memory");
}
__device__ __forceinline__ void phase0(const Params& p, unsigned char* lds) {
    const int tid = threadIdx.x, lane = tid & 63, wave = tid >> 6;
    float* scr = (float*)(lds + wave * 16384);
    const int gw = blockIdx.x * 8 + wave, NGW = gridDim.x * 8;
    unsigned char* ws = p.ws;
    constexpr int I_1 = 16 * 176, I_2 = 16 * 176, I_3 = 44 * 32, I_4 = 16 * 32, I_5 = 8 * 32, I_6 = 8 * 32, I_7 = 2 * 16, I_8 = 2 * 16, I_9 = 4 * 16;
    constexpr int NIT = I_1 + I_2 + I_3 + I_4 + I_5 + I_6 + I_7 + I_8 + I_9;
    for (int it = gw; it < NIT; it += NGW) {
        int r = it;
        if (r < I_1) { const int kb = r / 176, nb = r % 176, n0 = nb * 32; const int sc = n0 < 1824 ? n0 : (n0 < 2048 ? -1 : n0 - 224);
            tr_item(p.in[I_WIN], 1024, IN_COLS, sc, nullptr, (bf16_t*)(ws + WS_WIN), 1024, n0, kb * 64, scr, lane); continue; } r -= I_1;
        if (r < I_2) { const int kb = r / 176, nb = r % 176; const int n0 = nb * 32, pn_ = n0 >> 8, w_ = n0 & 255; const int sc = w_ < 128 ? 128 * pn_ + w_ : DFF + 128 * pn_ + (w_ - 128);
            tr_item(p.in[I_WUP], 1024, 5632, sc, p.in[I_N2G], (bf16_t*)(ws + WS_WUP), 1024, n0, kb * 64, scr, lane); continue; } r -= I_2;
        if (r < I_3) { const int kb = r / 32, nb = r % 32; tr_item(p.in[I_WDN], 2816, 1024, nb * 32, nullptr, (bf16_t*)(ws + WS_WDN), 2816, nb * 32, kb * 64, scr, lane); continue; } r -= I_3;
        if (r < I_4) { const int kb = r / 32, nb = r % 32; tr_item(p.in[I_WOUT], 1024, 1024, nb * 32, nullptr, (bf16_t*)(ws + WS_WOUT), 1024, nb * 32, kb * 64, scr, lane); continue; } r -= I_4;
        if (r < I_5) { const int kb = r / 32, nb = r % 32; tr_item(p.in[I_WBA], 512, 1024, nb * 32, nullptr, (bf16_t*)(ws + WS_WBA), 512, nb * 32, kb * 64, scr, lane); continue; } r -= I_5;
        if (r < I_6) { const int kb = r / 32, nb = r % 32; tr_item(p.in[I_WBB], 512, 1024, nb * 32, nullptr, (bf16_t*)(ws + WS_WBB), 512, nb * 32, kb * 64, scr, lane); continue; } r -= I_6;
        if (r < I_7) { const int kb = r / 16, nb = r % 16; tr_item(p.in[I_WDU], 64, 512, nb * 32, nullptr, (bf16_t*)(ws + WS_WD), 128, nb * 32, kb * 64, scr, lane); continue; } r -= I_7;
        if (r < I_8) { const int kb = r / 16, nb = r % 16; tr_item(p.in[I_WAU], 64, 512, nb * 32, nullptr, (bf16_t*)(ws + WS_WA), 128, nb * 32, kb * 64, scr, lane); continue; } r -= I_8;
        { const int kb = r / 16, nb = r % 16; tr_item(p.in[I_WGU], 160, 512, nb * 32, nullptr, (bf16_t*)(ws + WS_WG), 256, nb * 32, kb * 64, scr, lane); }
    }
    const float* x = p.in[I_X]; const float* g1 = p.in[I_N1G]; bf16_t* hb = (bf16_t*)(ws + WS_HB);
    f32x4 gv[4];
#pragma unroll
    for (int j = 0; j < 4; ++j) gv[j] = *(const f32x4*)(g1 + 4 * lane + 256 * j);
    for (int m0 = gw; m0 < T; m0 += 4 * NGW) {
        f32x4 v[4][4];
#pragma unroll
        for (int j = 0; j < 4; ++j) { const f32x4* xr = (const f32x4*)(x + (size_t)(m0 + j * NGW) * DM) + lane;
#pragma unroll
            for (int q = 0; q < 4; ++q) v[j][q] = xr[64 * q]; }
#pragma unroll
        for (int j = 0; j < 4; ++j) { float s = 0.f;
#pragma unroll
            for (int q = 0; q < 4; ++q) s += (v[j][q][0] * v[j][q][0] + v[j][q][1] * v[j][q][1]) + (v[j][q][2] * v[j][q][2] + v[j][q][3] * v[j][q][3]);
            const float rstd = rsqrtf(wave_sum(s) * (1.f / DM) + 1e-6f);
            u32x2* o8 = (u32x2*)(hb + (size_t)(m0 + j * NGW) * DM) + lane;
#pragma unroll
            for (int q = 0; q < 4; ++q) { const f32x4 y = v[j][q] * rstd * gv[q]; u32x2 w; w.x = cvt_pk_bf16(y[0], y[1]); w.y = cvt_pk_bf16(y[2], y[3]); o8[64 * q] = w; } }
    }
}

__device__ __forceinline__ void phase2(const Params& p, unsigned char* lds, int parts) {
    const int tid = threadIdx.x;
    unsigned char* ws = p.ws;
    const bf16_t* ZM = (const bf16_t*)(ws + WS_ZM); const bf16_t* ZR = (const bf16_t*)(ws + WS_ZR);
    bf16_t* Qp = (bf16_t*)((unsigned char*)p.out + OUT_Q); bf16_t* Kp = (bf16_t*)((unsigned char*)p.out + OUT_KP); bf16_t* VT = (bf16_t*)((unsigned char*)p.out + OUT_VT);
    bf16_t* LA = (bf16_t*)((unsigned char*)p.out + OUT_LA);
    float* KMEAN = (float*)(ws + WS_KMEAN);
    const int* pos = (const int*)p.in[I_POS];
    float* kl = (float*)lds;
    unsigned short* vl = (unsigned short*)(lds + 256 * 65 * 4);
    const int tok = tid >> 1, half = tid & 1;
    const float rvh[8] = {0.15915493667125702f, 0.030863763764500618f, 0.005985185503959656f, 0.0011606636689975858f, 0.0002250790857942775f, 4.3647953134495765e-05f, 8.464330676360987e-06f, 1.6414262518082978e-06f};
    const float rvl[8] = {6.4206382432985265e-09f, -6.060805191054897e-10f, 1.7242327010613678e-10f, -4.8028716420622786e-11f, -6.753226016592562e-12f, 1.6772382094298877e-12f, -1.2670839041623722e-13f, -9.854460929453572e-15f};
    u32x4 nraw[2][4]; int npos = 0;
#define P2_LOAD(it_) do { const int h_ = (it_) & 7, blk_ = ((it_) >> 3) & 15, b_ = (it_) >> 7; const size_t t_ = (size_t)b_ * SEQ + blk_ * 256 + tok; npos = pos[t_]; \
        _Pragma("unroll") for (int w3 = 1; w3 < 2; ++w3) _Pragma("unroll") for (int j = 0; j < 4; ++j) nraw[w3][j] = *(const u32x4*)(ZM + t_ * 1536 + w3 * 512 + h_ * 64 + 32 * half + 8 * j); } while (0)
    if ((parts & 1) && (int)blockIdx.x < 1024) P2_LOAD((int)blockIdx.x);
    if (parts & 1)
    for (int item = blockIdx.x; item < 1024; item += gridDim.x) {
        const int h = item & 7, blk = (item >> 3) & 15, b = item >> 7;
        const size_t t = (size_t)b * SEQ + blk * 256 + tok;
        u32x4 raw[2][4]; const int cpos = npos;
#pragma unroll
        for (int w3 = 1; w3 < 2; ++w3)
#pragma unroll
            for (int j = 0; j < 4; ++j) raw[w3][j] = nraw[w3][j];
        if (item + (int)gridDim.x < 1024) P2_LOAD(item + (int)gridDim.x);
        float cs[8], sn[8];
        { const float ps = (float)cpos;
#pragma unroll
          for (int i = 0; i < 8; ++i) { const float hi_ = ps * rvh[i], lo_ = fmaf(ps, rvh[i], -hi_) + ps * rvl[i];
              const float fx = (hi_ - floorf(hi_)) + lo_; sn[i] = __builtin_amdgcn_sinf(fx); cs[i] = __builtin_amdgcn_cosf(fx); } }
#pragma unroll
        for (int which = 1; which < 2; ++which) {
            const float* gg = p.in[which ? I_KNG : I_QNG] + 32 * half;
            float v[32];
#pragma unroll
            for (int j = 0; j < 4; ++j) unpack8(raw[which][j], v + 8 * j);
            float ss = 0.f;
#pragma unroll
            for (int i = 0; i < 32; ++i) ss += v[i] * v[i];
            ss += __shfl_xor(ss, 1);
            const float rstd = rsqrtf(ss * (1.f / 64.f) + 1e-6f);
#pragma unroll
            for (int i = 0; i < 32; ++i) v[i] = v[i] * rstd * gg[i];
            if (half == 0) {
#pragma unroll
                for (int i = 0; i < 8; ++i) { const float x1 = v[i], x2 = v[8 + i]; v[i] = x1 * cs[i] - x2 * sn[i]; v[8 + i] = x2 * cs[i] + x1 * sn[i]; }
            }
            bf16_t* dst = (which ? Kp : Qp) + t * 512 + h * 64 + 32 * half;
#pragma unroll
            for (int j = 0; j < 4; ++j) *(u32x4*)(dst + 8 * j) = pack8(v + 8 * j);
            if (which == 1) {
#pragma unroll
                for (int i = 0; i < 32; ++i) kl[tok * 65 + 32 * half + i] = v[i];
            }
        }
        __syncthreads();
        { float* kp = (float*)(lds + 256 * 65 * 4); const int d_ = tid & 63, part = tid >> 6; float s0_ = 0.f, s1_ = 0.f;
#pragma unroll 8
          for (int r = 0; r < 32; r += 2) { s0_ += kl[(part * 32 + r) * 65 + d_]; s1_ += kl[(part * 32 + r + 1) * 65 + d_]; }
          kp[part * 64 + d_] = s0_ + s1_; }
        __syncthreads();
        if (tid < 64) { const float* kp = (const float*)(lds + 256 * 65 * 4); float s_ = 0.f;
#pragma unroll
            for (int q8 = 0; q8 < 8; ++q8) s_ += kp[q8 * 64 + tid];
            KMEAN[((size_t)(b * 8 + h) * 16 + blk) * 64 + tid] = s_ * (1.f / 256.f); }
    }
    __syncthreads();
    const float* mu = p.in[I_MU];
    const size_t NG = (parts & 2) ? (size_t)(T / 64) * 64 : 0;
    for (size_t idx = (size_t)blockIdx.x * 512 + tid; idx < NG; idx += (size_t)gridDim.x * 512) {
        const size_t t = (idx >> 6) * 64; const int dc = (int)(idx & 63) * 8; int sc = -1, mode = 0;
        if (dc < 64) { sc = 1536 + dc; mode = 1; } else if (dc >= 128 && dc < 192) { sc = 1600 + dc - 128; mode = 0; } else if (dc >= 256 && dc < 416) { sc = 1664 + dc - 256; mode = 2; }
        float v[8];
#pragma unroll
        for (int i = 0; i < 8; ++i) v[i] = 0.f;
        if (sc >= 0) { float a[8], pr[8]; unpack8(*(const u32x4*)(ZR + t * 2048 + sc), a);
            if ((t & (SEQ - 1)) != 0) unpack8(*(const u32x4*)(ZR + (t - 1) * 2048 + sc), pr); else {
#pragma unroll
                for (int i = 0; i < 8; ++i) pr[i] = 0.f; }
#pragma unroll
            for (int i = 0; i < 8; ++i) { const float z = a[i] + mu[sc + i] * (pr[i] - a[i]); v[i] = mode == 1 ? tanhf(z) : (mode == 2 ? sigmoidf_(z) : z); } }
        *(u32x4*)(LA + t * 512 + dc) = pack8(v);
    }
}

__device__ __forceinline__ void phase4(const Params& p) {
    const int tid = threadIdx.x; unsigned char* ws = p.ws;
    const bf16_t* ZR = (const bf16_t*)(ws + WS_ZR); const bf16_t* ALR = (const bf16_t*)(ws + WS_ALR);
    bf16_t* R = (bf16_t*)(ws + WS_R); bf16_t* K = (bf16_t*)(ws + WS_K); bf16_t* V = (bf16_t*)(ws + WS_V); bf16_t* KK = (bf16_t*)((unsigned char*)p.out + OUT_KK);
    float* SBON = (float*)(ws + WS_SBON);
    const float* mu = p.in[I_MU]; const float* k_k = p.in[I_KK]; const float* k_a = p.in[I_KA]; const float* r_k = p.in[I_RK];
    const size_t NG = (size_t)(T / 2) * 64;
    for (size_t idx = (size_t)blockIdx.x * 512 + tid; idx < NG; idx += (size_t)gridDim.x * 512) {
        const size_t t0 = (idx >> 6) * 2; const int c0 = (int)(idx & 63) * 8;
        const bool first = (t0 & (SEQ - 1)) == 0;
        u32x4 raw[3][3], ral[2];
#pragma unroll
        for (int j = 0; j < 3; ++j)
#pragma unroll
            for (int w3 = 0; w3 < 3; ++w3) { if (j > 0 || !first) raw[j][w3] = *(const u32x4*)(ZR + (t0 + j - 1) * 2048 + w3 * 512 + c0); else raw[j][w3] = (u32x4){0u, 0u, 0u, 0u}; }
        const size_t hm0 = hm_idx(t0, c0);
        ral[0] = *(const u32x4*)(ALR + hm0); ral[1] = *(const u32x4*)(ALR + hm0 + 64);
        float muv[3][8], kkw[8], kaw[8], rkw[8];
#pragma unroll
        for (int i = 0; i < 8; ++i) { muv[0][i] = mu[c0 + i]; muv[1][i] = mu[512 + c0 + i]; muv[2][i] = mu[1024 + c0 + i]; kkw[i] = k_k[c0 + i]; kaw[i] = k_a[c0 + i]; rkw[i] = r_k[c0 + i]; }
#pragma unroll
        for (int j = 0; j < 2; ++j) {
            float z[3][8], pr[8], al[8];
#pragma unroll
            for (int w3 = 0; w3 < 3; ++w3) { unpack8(raw[j + 1][w3], z[w3]); unpack8(raw[j][w3], pr);
#pragma unroll
                for (int i = 0; i < 8; ++i) z[w3][i] = z[w3][i] + muv[w3][i] * (pr[i] - z[w3][i]); }
            unpack8(ral[j], al);
            float kk[8], km[8]; float ss = 0.f, sb = 0.f;
#pragma unroll
            for (int i = 0; i < 8; ++i) { kk[i] = z[1][i] * kkw[i]; ss += kk[i] * kk[i]; km[i] = z[1][i] * (1.f + (al[i] - 1.f) * kaw[i]); sb += z[0][i] * km[i] * rkw[i]; }
            ss += __shfl_xor(ss, 1); ss += __shfl_xor(ss, 2); ss += __shfl_xor(ss, 4);
            sb += __shfl_xor(sb, 1); sb += __shfl_xor(sb, 2); sb += __shfl_xor(sb, 4);
            const float inv = 1.f / fmaxf(sqrtf(ss), 1e-12f);
#pragma unroll
            for (int i = 0; i < 8; ++i) kk[i] *= inv;
            const size_t hm = hm0 + 64 * j;
            *(u32x4*)(R + hm) = pack8(z[0]); *(u32x4*)(K + hm) = pack8(km); *(u32x4*)(V + hm) = pack8(z[2]); *(u32x4*)(KK + hm) = pack8(kk);
            if ((idx & 7) == 0) SBON[(t0 + j) * 8 + (c0 >> 6)] = sb;
        }
    }
}

template <int CTRL> __device__ __forceinline__ float dpp_add(float x) {
    const int y = __builtin_amdgcn_update_dpp(0, __float_as_int(x), CTRL, 0xF, 0xF, false);
    return x + __int_as_float(y);
}
__device__ __forceinline__ float row16_sum(float x) {
    x = dpp_add<0xB1>(x);
    x = dpp_add<0x4E>(x);
    x = dpp_add<0x141>(x);
    x = dpp_add<0x140>(x);
    return x;
}
typedef float f32x2 __attribute__((ext_vector_type(2)));
__device__ __forceinline__ float fmul_(float a, float b) { float d; asm("v_mul_f32_e32 %0, %1, %2" : "=v"(d) : "v"(a), "v"(b)); return d; }
__device__ __forceinline__ float fadd_(float a, float b) { float d; asm("v_add_f32_e32 %0, %1, %2" : "=v"(d) : "v"(a), "v"(b)); return d; }
__device__ __forceinline__ float ffma_(float a, float b, float c) { float d; asm("v_fma_f32 %0, %1, %2, %3" : "=v"(d) : "v"(a), "v"(b), "v"(c)); return d; }
__device__ __forceinline__ float row16_sum_asm(float x) {
    float d;
    asm("s_nop 1\n\tv_add_f32_dpp %0, %1, %1 quad_perm:[1,0,3,2] row_mask:0xf bank_mask:0xf\n\t"
        "s_nop 1\n\tv_add_f32_dpp %0, %0, %0 quad_perm:[2,3,0,1] row_mask:0xf bank_mask:0xf\n\t"
        "s_nop 1\n\tv_add_f32_dpp %0, %0, %0 row_half_mirror row_mask:0xf bank_mask:0xf\n\t"
        "s_nop 1\n\tv_add_f32_dpp %0, %0, %0 row_mirror row_mask:0xf bank_mask:0xf" : "=&v"(d) : "v"(x));
    return d;
}
constexpr int SC_STEPS = 32, SC_ROW = 336;
__device__ __forceinline__ void scan_block(const Params& p, unsigned char* lds, int sb) {
    const int tid = threadIdx.x, lane = tid & 63, wave = __builtin_amdgcn_readfirstlane(tid >> 6);
    unsigned char* ws = p.ws;
    const bf16_t* ALR = (const bf16_t*)(ws + WS_ALR); const bf16_t* E = (const bf16_t*)(ws + WS_E);
    bf16_t* Y = (bf16_t*)((unsigned char*)p.out + OUT_VT);
    const int xi_ = sb >> 3, quarter = xi_ & 3, bh = (sb & 7) + 8 * (xi_ >> 2), b = bh >> 3, h = bh & 7;
    float* buf = (float*)lds;
    float* ybuf = (float*)(lds + 2 * SC_STEPS * SC_ROW * 4);
    const size_t rowbase = (size_t)b * SEQ;
    constexpr int NCH = SEQ / SC_STEPS;
    if (wave >= 4) {
        const int lt = tid - 256, st_tok = lt >> 3, st_c = lt & 7;
        const bf16_t* ZR = (const bf16_t*)(ws + WS_ZR); float* SBON = (float*)(ws + WS_SBON);
        const int hc = h * 64 + st_c * 8;
        float mur[8], muk[8], muv[8], kkw[8], kaw[8], rkw[8];
#pragma unroll
        for (int i = 0; i < 8; ++i) { mur[i] = p.in[I_MU][hc + i]; muk[i] = p.in[I_MU][512 + hc + i]; muv[i] = p.in[I_MU][1024 + hc + i]; kkw[i] = p.in[I_KK][hc + i]; kaw[i] = p.in[I_KA][hc + i]; rkw[i] = p.in[I_RK][hc + i]; }
        u32x4 Pr, Pk, Pv, Ppr, Ppk, Ppv, Pa, Pe, Qr, Qk, Qv, Qpr, Qpk, Qpv, Qa, Qe;
#define SC_LOAD(X, ch) do { const int s_ = (ch) * SC_STEPS + st_tok; const bf16_t* zr_ = ZR + (rowbase + s_) * 2048 + hc; \
        X##r = *(const u32x4*)(zr_); X##k = *(const u32x4*)(zr_ + 512); X##v = *(const u32x4*)(zr_ + 1024); \
        if (s_ > 0) { X##pr = *(const u32x4*)(zr_ - 2048); X##pk = *(const u32x4*)(zr_ - 2048 + 512); X##pv = *(const u32x4*)(zr_ - 2048 + 1024); } \
        else { X##pr = (u32x4){0u, 0u, 0u, 0u}; X##pk = X##pr; X##pv = X##pr; } \
        const size_t o_ = (((size_t)bh * SEQ) + s_) * 64 + st_c * 8; X##a = *(const u32x4*)(ALR + o_); X##e = *(const u32x4*)(E + o_); } while (0)
#define SC_STORE(X, ch) do { float* bq = buf + ((ch) & 1) * SC_STEPS * SC_ROW; \
        float fr_[8], fk_[8], fv_[8], fp_[8], fa_[8], fe_[8], fkk_[8], fkm_[8]; \
        unpack8(X##r, fr_); unpack8(X##pr, fp_); _Pragma("unroll") for (int i_ = 0; i_ < 8; ++i_) fr_[i_] = fr_[i_] + mur[i_] * (fp_[i_] - fr_[i_]); \
        unpack8(X##k, fk_); unpack8(X##pk, fp_); _Pragma("unroll") for (int i_ = 0; i_ < 8; ++i_) fk_[i_] = fk_[i_] + muk[i_] * (fp_[i_] - fk_[i_]); \
        unpack8(X##v, fv_); unpack8(X##pv, fp_); _Pragma("unroll") for (int i_ = 0; i_ < 8; ++i_) fv_[i_] = fv_[i_] + muv[i_] * (fp_[i_] - fv_[i_]); \
        unpack8(X##a, fa_); unpack8(X##e, fe_); \
        float ss_ = 0.f, sb_ = 0.f; \
        _Pragma("unroll") for (int i_ = 0; i_ < 8; ++i_) { fkk_[i_] = fk_[i_] * kkw[i_]; ss_ += fkk_[i_] * fkk_[i_]; fkm_[i_] = fk_[i_] * (1.f + (fa_[i_] - 1.f) * kaw[i_]); sb_ += fr_[i_] * fkm_[i_] * rkw[i_]; } \
        ss_ += __shfl_xor(ss_, 1); ss_ += __shfl_xor(ss_, 2); ss_ += __shfl_xor(ss_, 4); \
        sb_ += __shfl_xor(sb_, 1); sb_ += __shfl_xor(sb_, 2); sb_ += __shfl_xor(sb_, 4); \
        const float inv_ = 1.f / fmaxf(sqrtf(ss_), 1e-12f); \
        _Pragma("unroll") for (int i_ = 0; i_ < 8; ++i_) fkk_[i_] *= inv_; \
        if (quarter == 0 && st_c == 0) SBON[(rowbase + (size_t)(ch) * SC_STEPS + st_tok) * 8 + h] = sb_; \
        { float* q = bq + st_tok * SC_ROW + st_c * 8; f32x4 o0, o1; \
          o0 = (f32x4){fr_[0], fr_[1], fr_[2], fr_[3]}; o1 = (f32x4){fr_[4], fr_[5], fr_[6], fr_[7]}; *(f32x4*)(q) = o0; *(f32x4*)(q + 4) = o1; \
          o0 = (f32x4){__expf(-fe_[0]), __expf(-fe_[1]), __expf(-fe_[2]), __expf(-fe_[3])}; o1 = (f32x4){__expf(-fe_[4]), __expf(-fe_[5]), __expf(-fe_[6]), __expf(-fe_[7])}; *(f32x4*)(q + 64) = o0; *(f32x4*)(q + 68) = o1; \
          o0 = (f32x4){fkm_[0], fkm_[1], fkm_[2], fkm_[3]}; o1 = (f32x4){fkm_[4], fkm_[5], fkm_[6], fkm_[7]}; *(f32x4*)(q + 128) = o0; *(f32x4*)(q + 132) = o1; \
          o0 = (f32x4){-fkk_[0], -fkk_[1], -fkk_[2], -fkk_[3]}; o1 = (f32x4){-fkk_[4], -fkk_[5], -fkk_[6], -fkk_[7]}; *(f32x4*)(q + 192) = o0; *(f32x4*)(q + 196) = o1; \
          o0 = (f32x4){fkk_[0] * fa_[0], fkk_[1] * fa_[1], fkk_[2] * fa_[2], fkk_[3] * fa_[3]}; o1 = (f32x4){fkk_[4] * fa_[4], fkk_[5] * fa_[5], fkk_[6] * fa_[6], fkk_[7] * fa_[7]}; *(f32x4*)(q + 256) = o0; *(f32x4*)(q + 260) = o1; } \
        if ((st_c >> 1) == quarter) { float* q = bq + st_tok * SC_ROW + 320 + (st_c & 1) * 8; \
          *(f32x4*)(q) = (f32x4){fv_[0], fv_[1], fv_[2], fv_[3]}; *(f32x4*)(q + 4) = (f32x4){fv_[4], fv_[5], fv_[6], fv_[7]}; } } while (0)
#define SC_FLUSH(ch) do { const float* yq = ybuf + ((ch) & 1) * 512; const int tk = lt >> 3, r2 = (lt & 7) * 2; \
        f32x2 o; o.x = yq[r2 * 32 + tk]; o.y = yq[(r2 + 1) * 32 + tk]; \
        *(unsigned*)(Y + (rowbase + (size_t)(ch) * SC_STEPS + tk) * 512 + h * 64 + quarter * 16 + r2) = cvt_pk_bf16(o.x, o.y); } while (0)
        SC_LOAD(Q, 0); SC_STORE(Q, 0); SC_LOAD(P, 1); SC_LOAD(Q, 2);
        __syncthreads();
        for (int ch = 0; ch < NCH; ch += 2) {
            SC_STORE(P, ch + 1);
            if (ch + 3 < NCH) SC_LOAD(P, ch + 3);
            if (ch >= 1) SC_FLUSH(ch - 1);
            __syncthreads();
            if (ch + 2 < NCH) SC_STORE(Q, ch + 2);
            if (ch + 4 < NCH) SC_LOAD(Q, ch + 4);
            SC_FLUSH(ch);
            __syncthreads();
        }
        SC_FLUSH(NCH - 1);
#undef SC_LOAD
#undef SC_STORE
#undef SC_FLUSH
    } else {
        __syncthreads();
        const int c = lane & 15, rowq = wave * 4 + (lane >> 4);
#define SC_LDG(X, base) do { _Pragma("unroll") for (int u_ = 0; u_ < 2; ++u_) { const float* q_ = (base) + u_ * SC_ROW; \
            X##r[u_] = *(const f32x4*)(q_ + 4 * c); X##w[u_] = *(const f32x4*)(q_ + 64 + 4 * c); X##k[u_] = *(const f32x4*)(q_ + 128 + 4 * c); \
            X##a[u_] = *(const f32x4*)(q_ + 192 + 4 * c); X##b[u_] = *(const f32x4*)(q_ + 256 + 4 * c); X##v[u_] = q_[320 + rowq]; } } while (0)
#define SC_STEP(Xa, Xb, Xw, Xk, Xv, RP, yprev) do { float dA_, dB_, vk0_, vk1_, vk2_, vk3_; \
        asm volatile("v_mul_f32_e32 %0, %2, %6\n\tv_mul_f32_e32 %1, %2, %10\n\t" \
                     "v_fma_f32 %0, %3, %7, %0\n\tv_fma_f32 %1, %3, %11, %1\n\t" \
                     "v_fma_f32 %0, %4, %8, %0\n\tv_fma_f32 %1, %4, %12, %1\n\t" \
                     "v_fma_f32 %0, %5, %9, %0\n\tv_fma_f32 %1, %5, %13, %1" \
                     : "=&v"(dA_), "=&v"(dB_) \
                     : "v"(s0), "v"(s1), "v"(s2), "v"(s3), "v"(Xa[0]), "v"(Xa[1]), "v"(Xa[2]), "v"(Xa[3]), "v"(RP[0]), "v"(RP[1]), "v"(RP[2]), "v"(RP[3])); \
        asm volatile("v_mul_f32_e32 %2, %6, %10\n\t" \
                     "v_add_f32_dpp %0, %0, %0 quad_perm:[1,0,3,2] row_mask:0xf bank_mask:0xf\n\tv_add_f32_dpp %1, %1, %1 quad_perm:[1,0,3,2] row_mask:0xf bank_mask:0xf\n\t" \
                     "v_mul_f32_e32 %3, %7, %10\n\t" \
                     "v_add_f32_dpp %0, %0, %0 quad_perm:[2,3,0,1] row_mask:0xf bank_mask:0xf\n\tv_add_f32_dpp %1, %1, %1 quad_perm:[2,3,0,1] row_mask:0xf bank_mask:0xf\n\t" \
                     "v_mul_f32_e32 %4, %8, %10\n\t" \
                     "v_add_f32_dpp %0, %0, %0 row_half_mirror row_mask:0xf bank_mask:0xf\n\tv_add_f32_dpp %1, %1, %1 row_half_mirror row_mask:0xf bank_mask:0xf\n\t" \
                     "v_mul_f32_e32 %5, %9, %10\n\t" \
                     "v_add_f32_dpp %0, %0, %0 row_mirror row_mask:0xf bank_mask:0xf\n\tv_add_f32_dpp %1, %1, %1 row_mirror row_mask:0xf bank_mask:0xf" \
                     : "+v"(dA_), "+v"(dB_), "=&v"(vk0_), "=&v"(vk1_), "=&v"(vk2_), "=&v"(vk3_) \
                     : "v"(Xk[0]), "v"(Xk[1]), "v"(Xk[2]), "v"(Xk[3]), "v"(Xv)); \
        asm volatile("v_fma_f32 %4, %8, %9, %4\n\tv_fma_f32 %5, %8, %10, %5\n\tv_fma_f32 %6, %8, %11, %6\n\tv_fma_f32 %7, %8, %12, %7\n\t" \
                     "v_fma_f32 %0, %0, %13, %4\n\tv_fma_f32 %1, %1, %14, %5\n\tv_fma_f32 %2, %2, %15, %6\n\tv_fma_f32 %3, %3, %16, %7" \
                     : "+v"(s0), "+v"(s1), "+v"(s2), "+v"(s3), "+v"(vk0_), "+v"(vk1_), "+v"(vk2_), "+v"(vk3_) \
                     : "v"(dA_), "v"(Xb[0]), "v"(Xb[1]), "v"(Xb[2]), "v"(Xb[3]), "v"(Xw[0]), "v"(Xw[1]), "v"(Xw[2]), "v"(Xw[3])); \
        yprev = dB_; } while (0)
#define SC_CMP(X, j0) do { _Pragma("unroll") for (int u_ = 0; u_ < 2; ++u_) { float yp_; \
            SC_STEP(X##a[u_], X##b[u_], X##w[u_], X##k[u_], X##v[u_], rp, yp_); rp = X##r[u_]; \
            ykeep = ((((j0) + u_ + 31) & 15) == c) ? yp_ : ykeep; if (((j0) + u_) == 16) yb[c] = ykeep; } } while (0)
        float s0 = 0.f, s1 = 0.f, s2 = 0.f, s3 = 0.f;
        f32x4 rp = {0.f, 0.f, 0.f, 0.f}; float ykeep = 0.f;
        f32x4 Ar[2], Aw[2], Ak[2], Aa[2], Ab[2], Br[2], Bw[2], Bk[2], Ba[2], Bb[2]; float Av[2], Bv[2];
        for (int ch = 0; ch < NCH; ++ch) {
            const float* bp = buf + (ch & 1) * SC_STEPS * SC_ROW; float* yb = ybuf + (ch & 1) * 512 + rowq * 32;
            SC_LDG(A, bp);
#pragma unroll 2
            for (int g = 0; g < 16; g += 2) {
                SC_LDG(B, bp + (g + 1) * 2 * SC_ROW);
                __builtin_amdgcn_sched_barrier(0);
                SC_CMP(A, 2 * g);
                __builtin_amdgcn_sched_barrier(0);
                if (g + 2 < 16) SC_LDG(A, bp + (g + 2) * 2 * SC_ROW);
                __builtin_amdgcn_sched_barrier(0);
                SC_CMP(B, 2 * g + 2);
                __builtin_amdgcn_sched_barrier(0);
            }
            { const float y_ = row16_sum_asm(fadd_(ffma_(s1, rp[1], fmul_(s0, rp[0])), ffma_(s3, rp[3], fmul_(s2, rp[2])))); ykeep = (c == 15) ? y_ : ykeep; yb[16 + c] = ykeep; }
            __syncthreads();
        }
#undef SC_LDG
#undef SC_CMP
#undef SC_STEP
    }
    __syncthreads();
}

__device__ __forceinline__ int crow(int r, int hi) { return (r & 3) + 8 * (r >> 2) + 4 * hi; }
constexpr int AT_KROW = 144, AT_VROW = 144, AT_KB = 64 * AT_KROW, AT_VB = 64 * AT_VROW;
constexpr int AT_K0 = 0, AT_V0 = 4 * AT_KB, AT_KM = 4 * AT_KB + 4 * AT_VB;
typedef short tr4_t __attribute__((ext_vector_type(4)));
typedef __attribute__((address_space(3))) tr4_t tr4_lds_t;
typedef __attribute__((address_space(3))) const char* tr_lds_cptr;
__device__ __forceinline__ void attn_unit(const Params& p, unsigned char* lds, int bh, int qb) {
    const int tid = threadIdx.x, lane = tid & 63, wave = __builtin_amdgcn_readfirstlane(tid >> 6), q = lane & 31, hi = lane >> 5;
    const int b = bh >> 3, h = bh & 7;
    const bf16_t* Kp = (const bf16_t*)((const unsigned char*)p.out + OUT_KP);
    const bf16_t* ZMv = (const bf16_t*)(p.ws + WS_ZM); bf16_t* YB = (bf16_t*)p.out;
    const float* KMEAN = (const float*)(p.ws + WS_KMEAN);
    float* km = (float*)(lds + AT_KM);
    for (int i = tid; i < 1024; i += 512) km[i] = KMEAN[(size_t)bh * 1024 + i];
    const size_t qrow = (size_t)b * SEQ + qb * 256 + wave * 32 + q;
    bf16x8 qf[4];
    {
        float qn[32];
#pragma unroll
        for (int kk = 0; kk < 4; ++kk) unpack8(*(const u32x4*)(ZMv + qrow * 1536 + h * 64 + 16 * kk + 8 * hi), qn + 8 * kk);
        float ssq_ = 0.f;
#pragma unroll
        for (int e = 0; e < 32; ++e) ssq_ += qn[e] * qn[e];
        ssq_ += __shfl_xor(ssq_, 32);
        const float rq = rsqrtf(ssq_ * (1.f / 64.f) + 1e-6f);
        const float* qg = p.in[I_QNG];
#pragma unroll
        for (int kk = 0; kk < 4; ++kk)
#pragma unroll
            for (int e = 0; e < 8; ++e) qn[kk * 8 + e] = qn[kk * 8 + e] * rq * qg[16 * kk + 8 * hi + e];
        const float rvh[8] = {0.15915493667125702f, 0.030863763764500618f, 0.005985185503959656f, 0.0011606636689975858f, 0.0002250790857942775f, 4.3647953134495765e-05f, 8.464330676360987e-06f, 1.6414262518082978e-06f};
        const float rvl[8] = {6.4206382432985265e-09f, -6.060805191054897e-10f, 1.7242327010613678e-10f, -4.8028716420622786e-11f, -6.753226016592562e-12f, 1.6772382094298877e-12f, -1.2670839041623722e-13f, -9.854460929453572e-15f};
        const float ps = (float)((const int*)p.in[I_POS])[qrow];
#pragma unroll
        for (int e = 0; e < 8; ++e) { const float hi_ = ps * rvh[e], lo_ = fmaf(ps, rvh[e], -hi_) + ps * rvl[e]; const float fx = (hi_ - floorf(hi_)) + lo_;
            const float sn_ = __builtin_amdgcn_sinf(fx), cs_ = __builtin_amdgcn_cosf(fx); const float other = __shfl_xor(qn[e], 32);
            qn[e] = qn[e] * cs_ + (hi ? other : -other) * sn_; }
#pragma unroll
        for (int kk = 0; kk < 4; ++kk) { const u32x4 w = pack8(qn + 8 * kk); qf[kk] = __builtin_bit_cast(bf16x8, w); }
    }
    const int ld_r = tid >> 3, ld_c = tid & 7;
    const bf16_t* kbase = Kp + ((size_t)b * SEQ + ld_r) * 512 + h * 64 + ld_c * 8;
    const bf16_t* vbase = ZMv + ((size_t)b * SEQ + ld_r) * 1536 + 1024 + h * 64 + ld_c * 8;
    const int NT = 4 * (qb + 1);
    u32x4 kreg = *(const u32x4*)(kbase), vreg = *(const u32x4*)(vbase), kreg2 = *(const u32x4*)(kbase + (size_t)64 * 512), vreg2 = *(const u32x4*)(vbase + (size_t)64 * 1536);
#define AT_PUT(slot, kr, vr) do { *(u32x4*)(lds + AT_K0 + (slot) * AT_KB + ld_r * AT_KROW + ld_c * 16) = (kr); *(u32x4*)(lds + AT_V0 + (slot) * AT_VB + ld_r * AT_VROW + ld_c * 16) = (vr); } while (0)
    AT_PUT(0, kreg, vreg); AT_PUT(1, kreg2, vreg2);
    __syncthreads();
    unsigned mask = 0u; float mc = 0.f;
    {
        float qv[32];
#pragma unroll
        for (int kk = 0; kk < 4; ++kk)
#pragma unroll
            for (int e = 0; e < 8; ++e) qv[kk * 8 + e] = __uint_as_float(((unsigned)(unsigned short)qf[kk][e]) << 16);
        { float qq = 0.f;
#pragma unroll
          for (int e = 0; e < 32; ++e) qq += qv[e] * qv[e];
          qq += __shfl_xor(qq, 32); mc = sqrtf(qq) * (10.f / 8.f) * 1.4426950408889634f; }
        float g[15];
#pragma unroll
        for (int j = 0; j < 15; ++j) { float s = 0.f;
#pragma unroll
            for (int kk = 0; kk < 4; ++kk)
#pragma unroll
                for (int e = 0; e < 8; ++e) s += qv[kk * 8 + e] * km[j * 64 + 16 * kk + 8 * hi + e];
            s += __shfl_xor(s, 32); g[j] = (j < qb) ? s : -INFINITY; }
#pragma unroll
        for (int pass = 0; pass < 3; ++pass) { float m = g[0]; int idx = 0;
#pragma unroll
            for (int j = 1; j < 15; ++j) if (g[j] > m) { m = g[j]; idx = j; }
            if (m > -INFINITY) mask |= 1u << idx;
#pragma unroll
            for (int j = 0; j < 15; ++j) if (j == idx) g[j] = -INFINITY; }
    }
    const float C = 0.125f * 1.4426950408889634f;
    float l = 0.f;
    f32x16 O0 = {}, O1 = {};
    const int qrel = 32 * wave + q;
    for (int i2 = 0; i2 < NT; i2 += 2) {
        if (i2 + 2 < NT) { const size_t adv = (size_t)(i2 + 2) * 64; kreg = *(const u32x4*)(kbase + adv * 512); vreg = *(const u32x4*)(vbase + adv * 1536);
            kreg2 = *(const u32x4*)(kbase + (adv + 64) * 512); vreg2 = *(const u32x4*)(vbase + (adv + 64) * 1536); }
#pragma unroll 1
      for (int sub = 0; sub < 2; ++sub) { const int i = i2 + sub;
        const int j = i >> 2, kt = i & 3;
        const unsigned char* Kb = lds + AT_K0 + (i & 3) * AT_KB; tr_lds_cptr Vb3 = (tr_lds_cptr)lds + AT_V0 + (i & 3) * AT_VB;
        const bool own = (j == qb);
        const bool act = own ? true : ((mask >> j) & 1u);
        const bool wave_on = own ? (64 * kt <= 32 * wave + 31) : (__ballot(act) != 0ull);
        if (wave_on) {
            f32x16 s0 = {}, s1 = {};
#pragma unroll
            for (int kk = 0; kk < 4; ++kk) {
                const bf16x8 k0 = *(const bf16x8*)(Kb + q * AT_KROW + (16 * kk + 8 * hi) * 2);
                const bf16x8 k1 = *(const bf16x8*)(Kb + (q + 32) * AT_KROW + (16 * kk + 8 * hi) * 2);
                s0 = __builtin_amdgcn_mfma_f32_32x32x16_bf16(k0, qf[kk], s0, 0, 0, 0);
                s1 = __builtin_amdgcn_mfma_f32_32x32x16_bf16(k1, qf[kk], s1, 0, 0, 0);
            }
            if (own) {
#pragma unroll
                for (int r = 0; r < 16; ++r) { const int key = 64 * kt + crow(r, hi); if (key > qrel) s0[r] = -1e30f; if (key + 32 > qrel) s1[r] = -1e30f; }
            } else if (!act) {
#pragma unroll
                for (int r = 0; r < 16; ++r) { s0[r] = -1e30f; s1[r] = -1e30f; }
            }
            float ls = 0.f;
#pragma unroll
            for (int r = 0; r < 16; ++r) { s0[r] = __builtin_amdgcn_exp2f(s0[r] * C - mc); s1[r] = __builtin_amdgcn_exp2f(s1[r] * C - mc); ls += s0[r] + s1[r]; }
            l += ls;
            bf16x8 pf[2][2];
#pragma unroll
            for (int s = 0; s < 2; ++s) {
                u32x4 w0, w1;
                w0.x = cvt_pk_bf16(s0[8 * s + 0], s0[8 * s + 1]); w0.y = cvt_pk_bf16(s0[8 * s + 2], s0[8 * s + 3]); w0.z = cvt_pk_bf16(s0[8 * s + 4], s0[8 * s + 5]); w0.w = cvt_pk_bf16(s0[8 * s + 6], s0[8 * s + 7]);
                w1.x = cvt_pk_bf16(s1[8 * s + 0], s1[8 * s + 1]); w1.y = cvt_pk_bf16(s1[8 * s + 2], s1[8 * s + 3]); w1.z = cvt_pk_bf16(s1[8 * s + 4], s1[8 * s + 5]); w1.w = cvt_pk_bf16(s1[8 * s + 6], s1[8 * s + 7]);
                pf[0][s] = __builtin_bit_cast(bf16x8, w0); pf[1][s] = __builtin_bit_cast(bf16x8, w1);
            }
#pragma unroll
            for (int kh = 0; kh < 2; ++kh)
#pragma unroll
                for (int s = 0; s < 2; ++s) {
                    const int keyq = 32 * kh + 16 * s + 4 * hi + ((lane & 15) >> 2), cb = (16 * ((lane >> 4) & 1) + 4 * (lane & 3)) * 2;
                    const tr4_t a0 = __builtin_amdgcn_ds_read_tr16_b64_v4i16((tr4_lds_t*)(Vb3 + keyq * AT_VROW + cb)), a1 = __builtin_amdgcn_ds_read_tr16_b64_v4i16((tr4_lds_t*)(Vb3 + (keyq + 8) * AT_VROW + cb));
                    const tr4_t c0 = __builtin_amdgcn_ds_read_tr16_b64_v4i16((tr4_lds_t*)(Vb3 + keyq * AT_VROW + cb + 64)), c1 = __builtin_amdgcn_ds_read_tr16_b64_v4i16((tr4_lds_t*)(Vb3 + (keyq + 8) * AT_VROW + cb + 64));
                    const bf16x8 va = {a0[0], a0[1], a0[2], a0[3], a1[0], a1[1], a1[2], a1[3]}, vc = {c0[0], c0[1], c0[2], c0[3], c1[0], c1[1], c1[2], c1[3]};
                    O0 = __builtin_amdgcn_mfma_f32_32x32x16_bf16(va, pf[kh][s], O0, 0, 0, 0);
                    O1 = __builtin_amdgcn_mfma_f32_32x32x16_bf16(vc, pf[kh][s], O1, 0, 0, 0);
                }
        }
      }
        if (i2 + 2 < NT) { AT_PUT((i2 + 2) & 3, kreg, vreg); AT_PUT((i2 + 3) & 3, kreg2, vreg2); }
        __syncthreads();
    }
#undef AT_PUT
    l += __shfl_xor(l, 32);
    const float inv = 1.f / l;
    bf16_t* orow = YB + qrow * 512 + h * 64;
#pragma unroll
    for (int g4 = 0; g4 < 4; ++g4) {
        u32x2 w0, w1;
        w0.x = cvt_pk_bf16(O0[4 * g4 + 0] * inv, O0[4 * g4 + 1] * inv); w0.y = cvt_pk_bf16(O0[4 * g4 + 2] * inv, O0[4 * g4 + 3] * inv);
        w1.x = cvt_pk_bf16(O1[4 * g4 + 0] * inv, O1[4 * g4 + 1] * inv); w1.y = cvt_pk_bf16(O1[4 * g4 + 2] * inv, O1[4 * g4 + 3] * inv);
        *(u32x2*)(orow + 8 * g4 + 4 * hi) = w0; *(u32x2*)(orow + 32 + 8 * g4 + 4 * hi) = w1;
    }
}

__device__ __forceinline__ void phase6(const Params& p) {
    const int tid = threadIdx.x; unsigned char* ws = p.ws;
    const bf16_t* Y = (const bf16_t*)((const unsigned char*)p.out + OUT_VT); const bf16_t* ZR = (const bf16_t*)(ws + WS_ZR); const float* mu = p.in[I_MU]; const bf16_t* G = (const bf16_t*)(ws + WS_G); const float* SBON = (const float*)(ws + WS_SBON);
    bf16_t* YA = (bf16_t*)(ws + WS_YA); const float* ln_g = p.in[I_LNG]; const float* ln_b = p.in[I_LNB];
    const size_t NG = (size_t)T * 64, STR = (size_t)gridDim.x * 512;
    for (size_t idx0 = (size_t)blockIdx.x * 512 + tid; idx0 < NG; idx0 += 4 * STR) {
        f32x4 ya[4][2]; u32x4 rv[4], rpv[4], rg[4]; float sbv[4];
#pragma unroll
        for (int j = 0; j < 4; ++j) { const size_t idx = idx0 + j * STR; const size_t t = idx >> 6; const int c0 = (int)(idx & 63) * 8;
            { const u32x4 yw = *(const u32x4*)(Y + t * 512 + c0); ya[j][0] = (f32x4){bf_lo(yw.x), bf_hi(yw.x), bf_lo(yw.y), bf_hi(yw.y)}; ya[j][1] = (f32x4){bf_lo(yw.z), bf_hi(yw.z), bf_lo(yw.w), bf_hi(yw.w)}; }
            rv[j] = *(const u32x4*)(ZR + t * 2048 + 1024 + c0); rpv[j] = (t & (SEQ - 1)) ? *(const u32x4*)(ZR + (t - 1) * 2048 + 1024 + c0) : (u32x4){0u, 0u, 0u, 0u}; rg[j] = *(const u32x4*)(G + t * 512 + c0); sbv[j] = SBON[t * 8 + (c0 >> 6)]; }
#pragma unroll
        for (int j = 0; j < 4; ++j) { const size_t idx = idx0 + j * STR; const size_t t = idx >> 6; const int c0 = (int)(idx & 63) * 8;
            float y[8] = {ya[j][0][0], ya[j][0][1], ya[j][0][2], ya[j][0][3], ya[j][1][0], ya[j][1][1], ya[j][1][2], ya[j][1][3]};
            float s_ = 0.f;
#pragma unroll
            for (int i = 0; i < 8; ++i) s_ += y[i];
            s_ += __shfl_xor(s_, 1); s_ += __shfl_xor(s_, 2); s_ += __shfl_xor(s_, 4);
            const float mean = s_ * (1.f / 64.f); float q = 0.f;
#pragma unroll
            for (int i = 0; i < 8; ++i) { y[i] -= mean; q += y[i] * y[i]; }
            q += __shfl_xor(q, 1); q += __shfl_xor(q, 2); q += __shfl_xor(q, 4);
            const float rstd = rsqrtf(q * (1.f / 64.f) + 64e-5f);
            float v[8], pv_[8], g[8]; unpack8(rv[j], v); unpack8(rpv[j], pv_); unpack8(rg[j], g);
#pragma unroll
            for (int i = 0; i < 8; ++i) v[i] = v[i] + mu[1024 + c0 + i] * (pv_[i] - v[i]);
#pragma unroll
            for (int i = 0; i < 8; ++i) y[i] = (y[i] * rstd * ln_g[c0 + i] + ln_b[c0 + i] + sbv[j] * v[i]) * g[i];
            *(u32x4*)(YA + t * 512 + c0) = pack8(y); }
    }
}

__device__ __forceinline__ void phase10(const Params& p, bool dry) {
    const int tid = threadIdx.x; bf16_t* U = (bf16_t*)(p.ws + WS_U);
    const float* cw = p.in[I_CW]; const float* cb = p.in[I_CB];
    const size_t NG = (size_t)(T / 64) * 352;
    for (size_t idx = (size_t)blockIdx.x * 512 + tid; idx < NG; idx += (size_t)gridDim.x * 512) {
        const size_t tq = idx / 352; const int c0 = (int)(idx - tq * 352) * 8; const size_t t0 = tq * 64; const int s0 = (int)(t0 & (SEQ - 1));
        u32x4 ra[4], rb[2];
#pragma unroll
        for (int j = 0; j < 4; ++j) { if (j >= 2 || s0 > 0) ra[j] = *(const u32x4*)(U + (t0 + j - 2) * NPROJ + c0); else ra[j] = (u32x4){0u, 0u, 0u, 0u}; }
#pragma unroll
        for (int j = 0; j < 2; ++j) rb[j] = *(const u32x4*)(U + (t0 + j) * NPROJ + DFF + c0);
        float w0[8], w1[8], w2[8], bs[8];
#pragma unroll
        for (int i = 0; i < 8; ++i) { w0[i] = cw[c0 + i]; w1[i] = cw[DFF + c0 + i]; w2[i] = cw[2 * DFF + c0 + i]; bs[i] = cb[c0 + i]; }
        float a2[8], a1[8], a0[8];
        unpack8(ra[0], a2); unpack8(ra[1], a1);
#pragma unroll
        for (int j = 0; j < 2; ++j) {
            float bv[8], o[8]; unpack8(ra[j + 2], a0); unpack8(rb[j], bv);
#pragma unroll
            for (int i = 0; i < 8; ++i) { const float v = w0[i] * a2[i] + w1[i] * a1[i] + w2[i] * a0[i] + bs[i]; o[i] = gelu_erf(v) * bv[i]; a2[i] = a1[i]; a1[i] = a0[i]; }
            if (!dry) *(u32x4*)(U + (t0 + j) * NPROJ + DFF + c0) = pack8(o);
        }
    }
}

#define LAS __attribute__((address_space(3)))
#define XB_TMO      128
#define XB_XCNT(j)  (256  + 64 * (j))
#define XB_XSUB(j)  (1280 + 64 * (j))
#define XB_XGEN(j)  (2304 + 64 * (j))
#define XB_TOP      3328
#define XB_TOPGEN   3392
#define XCD_BAR_WORDS 3456
#define XB_SPIN_CAP (1u << 20)
__device__ __forceinline__ unsigned xb_ld(unsigned* p)              { return __hip_atomic_load(p, __ATOMIC_RELAXED, __HIP_MEMORY_SCOPE_AGENT); }
__device__ __forceinline__ unsigned xb_add(unsigned* p, unsigned v) { return __hip_atomic_fetch_add(p, v, __ATOMIC_RELAXED, __HIP_MEMORY_SCOPE_AGENT); }
__device__ __forceinline__ unsigned xb_xcc_id() { return (unsigned)__builtin_amdgcn_s_getreg((3 << 11) | 20) & 0xFu; }
#define XB_SPIN(cond, bar) do { unsigned _sp = 0; while (cond) { __builtin_amdgcn_s_sleep(1); \
    if ((++_sp & 255u) == 0u) { if (xb_ld(&(bar)[XB_TMO])) break; if (_sp > XB_SPIN_CAP) { atomicAdd(&(bar)[XB_TMO], 1u); break; } } } } while (0)
struct XcdBarrier { unsigned* bar; unsigned x; volatile LAS unsigned* st; };
__device__ __forceinline__ XcdBarrier xcd_barrier_post(unsigned* bar, volatile LAS unsigned* st) {
    XcdBarrier b; b.bar = bar; b.x = xb_xcc_id(); b.st = st;
    if (threadIdx.x == 0) (void)xb_add(&bar[XB_XCNT(b.x)], 1u);
    return b;
}
__device__ __forceinline__ void xcd_barrier_complete(unsigned* bar, unsigned x, unsigned& nloc, unsigned& nx) {
    const unsigned G = gridDim.x * gridDim.y * gridDim.z;
    unsigned sum, cnt, mine, sp = 0u;
    for (;;) {
        sum = 0u; cnt = 0u; mine = 0u;
#pragma unroll
        for (unsigned j = 0; j < 16; ++j) { const unsigned c = xb_ld(&bar[XB_XCNT(j)]); sum += c; cnt += (c > 0u) ? 1u : 0u; mine = (j == x) ? c : mine; }
        if (sum == G) break;
        __builtin_amdgcn_s_sleep(1);
        if ((++sp & 255u) == 0u) { if (xb_ld(&bar[XB_TMO])) break; if (sp > XB_SPIN_CAP) { atomicAdd(&bar[XB_TMO], 1u); break; } }
    }
    nloc = mine > 0u ? mine : 1u; nx = cnt > 0u ? cnt : 1u;
}
__device__ __forceinline__ void xcd_barrier(const XcdBarrier& b) {
    asm volatile("s_waitcnt vmcnt(0)" ::: "memory");
    __syncthreads();
    if (threadIdx.x == 0) {
        unsigned* bar = b.bar;
        __builtin_amdgcn_s_waitcnt(0);
        unsigned nloc = b.st[0], nx = b.st[1];
        if (nloc == 0u) { xcd_barrier_complete(bar, b.x, nloc, nx); b.st[0] = nloc; b.st[1] = nx; }
        const unsigned old = xb_add(&bar[XB_XSUB(b.x)], 1u);
        const unsigned gen = old / nloc;
        if (old + 1u == (gen + 1u) * nloc) {
            __builtin_amdgcn_fence(__ATOMIC_RELEASE, "agent");
            asm volatile("s_waitcnt vmcnt(0)" ::: "memory");
            const unsigned og = xb_add(&bar[XB_TOP], 1u);
            const unsigned tg = og / nx;
            if (og + 1u == (tg + 1u) * nx) xb_add(&bar[XB_TOPGEN], 1u);
            else XB_SPIN(xb_ld(&bar[XB_TOPGEN]) == tg, bar);
            __builtin_amdgcn_fence(__ATOMIC_ACQUIRE, "agent");
            xb_add(&bar[XB_XGEN(b.x)], 1u);
            asm volatile("s_waitcnt vmcnt(0)" ::: "memory");
        } else {
            XB_SPIN(xb_ld(&bar[XB_XGEN(b.x)]) == gen, bar);
            __builtin_amdgcn_fence(__ATOMIC_ACQUIRE, "agent");
            asm volatile("s_waitcnt vmcnt(0)" ::: "memory");
        }
    }
    __syncthreads();
}

#ifndef PROBE_DRY1
#define PROBE_DRY1 0
#endif
#ifndef PROBE_P2PARTS
#define PROBE_P2PARTS 3
#endif
constexpr int NPHASE = 12;
__global__ void __launch_bounds__(512, 2) hybrid_fwd(Params p) {
    extern __shared__ __attribute__((aligned(16))) unsigned char lds[];
    cg::grid_group grid = cg::this_grid();
    PG8_LAS unsigned char* lds3 = (PG8_LAS unsigned char*)lds;
    unsigned char* ws = p.ws;
    const int G = gridDim.x, bx = blockIdx.x;
    const int lo = p.lo, hi = p.hi;
#ifndef PH_MASK
#define PH_MASK 0xFFF
#endif
#define IN(k) (((PH_MASK >> (k)) & 1) && lo <= (k) && (k) < hi)
    if (threadIdx.x < 16) ((volatile LAS unsigned*)(lds3 + LDS_MISC))[16 + threadIdx.x] = 0u;
    __syncthreads();
    const XcdBarrier xbar = xcd_barrier_post((unsigned*)(ws + WS_CTL) + 1024, (volatile LAS unsigned*)(lds3 + LDS_MISC) + 16);
#define RLOOP(k) _Pragma("unroll 1") for (int r_ = 0; r_ < p.rep[k]; ++r_)
#define SEAM(k) do { if (IN(k) && IN((k) + 1)) { if ((k) == 0 && lo < 0) grid.sync(); else xcd_barrier(xbar); } } while (0)
#ifndef REP_EW
#define REP_EW 1
#endif
    if (IN(0)) { RLOOP(0) phase0(p, lds); } SEAM(0);
    if (IN(1)) {
        pg8::Gemm g{(const bf16_t*)(ws + WS_HB), (const bf16_t*)(ws + WS_WIN), T, NPROJ, 1024, 1024, 1024}; pg8::StaticOrder S; S.init(T, NPROJ, G, bx);
        RLOOP(1) { EpiProj E{(bf16_t*)(ws + WS_ZR), (bf16_t*)(ws + WS_ZM), (bf16_t*)(ws + WS_GP), (bf16_t*)((unsigned char*)p.out + OUT_LA), p.in[I_MU], PROBE_DRY1 && (r_ + 1 < p.rep[1])}; pg8::gemm_phase<EpiProj, true>(lds3, g, S, E); }
    } SEAM(1);
    if (IN(2)) { RLOOP(2) phase2(p, lds, r_ == 0 ? 3 : PROBE_P2PARTS); } SEAM(2);
    if (IN(3)) {
        const bf16_t* LA = (const bf16_t*)((const unsigned char*)p.out + OUT_LA);
        RLOOP(3)
#pragma unroll 1
        for (int w = 0; w < 3; ++w) {
            const bf16_t* Bt = (const bf16_t*)(ws + (w == 0 ? WS_WD : (w == 1 ? WS_WA : WS_WG)));
            bf16_t* O = (bf16_t*)(ws + (w == 0 ? WS_E : (w == 1 ? WS_ALR : WS_G)));
            const float* bias = w == 0 ? p.in[I_DB] : p.in[I_AB];
            const int Kw = (w == 2) ? 256 : 128;
            pg8::Gemm g{LA + 128 * w, Bt, T, 512, Kw, 512, Kw}; pg8::StaticOrder S; S.init(T, 512, G, bx);
            EpiLora E{O, bias, w};
            pg8::gemm_phase<EpiLora, true>(lds3, g, S, E);
        }
    } do { if (IN(3) && IN(5)) xcd_barrier(xbar); } while (0);
    if (IN(5)) {
#ifndef REP_SCAN
#define REP_SCAN 1
#endif
        RLOOP(5) scan_block(p, lds, bx);
        volatile unsigned* sh = (volatile unsigned*)(lds + LDS_MISC);
#pragma unroll 1
        for (int rep = 0; rep < p.rep[12]; ++rep) {
        unsigned* qctr = (unsigned*)(ws + WS_CTL) + 64 + 64 * rep;
        for (;;) {
            __syncthreads();
            if (threadIdx.x == 0) sh[0] = atomicAdd(qctr, 1u);
            __syncthreads();
            const unsigned u = sh[0];
            if (u >= 1024u) break;
            attn_unit(p, lds, (int)(u & 63u), 15 - (int)(u >> 6));
        }
        }
    } SEAM(5);
    if (IN(6)) { RLOOP(6) phase6(p); } SEAM(6);
#pragma unroll 1
    for (int r_ = 0; r_ < p.rep[13]; ++r_) xcd_barrier(xbar);

    if (IN(7)) {
        const bf16_t* GP = (const bf16_t*)(ws + WS_GP); bf16_t* MG = (bf16_t*)(ws + WS_MG);
#pragma unroll 1
        for (int w = 0; w < 2 * p.rep[7]; ++w) {
            const int second = w & 1;
            pg8::Gemm g{second ? (const bf16_t*)p.out : (const bf16_t*)(ws + WS_YA), (const bf16_t*)(ws + (second ? WS_WBB : WS_WBA)), T, 1024, 512, 512, 512}; pg8::StaticOrder S; S.init(T, 1024, G, bx);
            EpiBranch E{MG, GP, second}; pg8::gemm_phase<EpiBranch, true>(lds3, g, S, E);
        }
    } SEAM(7);
    if (IN(8)) {
        pg8::Gemm g{(const bf16_t*)(ws + WS_MG), (const bf16_t*)(ws + WS_WOUT), T, 1024, 1024, 1024, 1024}; pg8::StaticOrder S; S.init(T, 1024, G, bx);
        EpiOut E{p.in[I_X], p.out, (bf16_t*)(ws + WS_X1B), (float*)(ws + WS_SSQ)};
        RLOOP(8) pg8::gemm_phase<EpiOut, true>(lds3, g, S, E);
    } SEAM(8);
    if (IN(9)) {
        pg8::Gemm g{(const bf16_t*)(ws + WS_X1B), (const bf16_t*)(ws + WS_WUP), T, NPROJ, 1024, 1024, 1024}; pg8::StaticOrder S; S.init(T, NPROJ, G, bx);
        EpiUp E{(bf16_t*)(ws + WS_U), (const float*)(ws + WS_SSQ), p.in[I_CW], p.in[I_CB]};
        RLOOP(9) pg8::gemm_phase<EpiUp, true>(lds3, g, S, E);
    } SEAM(9);
    if (IN(10)) { RLOOP(10) phase10(p, r_ + 1 < p.rep[10]); } SEAM(10);
    if (IN(11)) {
        pg8::Gemm g{(const bf16_t*)(ws + WS_U) + DFF, (const bf16_t*)(ws + WS_WDN), T, 1024, DFF, NPROJ, DFF}; pg8::StaticOrder S; S.init(T, 1024, G, bx);
        RLOOP(11) { EpiDown E{p.out, (const bf16_t*)(ws + WS_X1B), r_ + 1 < p.rep[11]}; pg8::gemm_phase<EpiDown, true>(lds3, g, S, E); }
    }
#undef IN
#undef SEAM
}

extern "C" void kernel_launch(void* const* d_in, const int* in_sizes, int n_in, void* d_out, int out_size, void* d_ws, size_t ws_size, hipStream_t stream) {
    static int grid = 0;
    if (grid == 0) {
        if (n_in != 25 || out_size != T * DM || ws_size < WS_END) { fprintf(stderr, "kernel_launch: unexpected shapes (n_in %d out %d ws %zu)\n", n_in, out_size, ws_size); grid = -1; return; }
        int dev = 0, cus = 0, per_cu = 0;
        hipGetDevice(&dev); hipDeviceGetAttribute(&cus, hipDeviceAttributeMultiprocessorCount, dev);
        if (hipFuncSetAttribute((const void*)hybrid_fwd, hipFuncAttributeMaxDynamicSharedMemorySize, LDS_BYTES) != hipSuccess) { fprintf(stderr, "kernel_launch: hipFuncSetAttribute failed\n"); grid = -1; return; }
        hipOccupancyMaxActiveBlocksPerMultiprocessor(&per_cu, (const void*)hybrid_fwd, 512, LDS_BYTES);
        (void)hipGetLastError();
        if (per_cu < 1) per_cu = 1;
        grid = cus * per_cu; if (grid > 256) grid = 256;
        if (grid != 256) fprintf(stderr, "kernel_launch: grid %d (expected 256)\n", grid);
    }
    if (grid < 0) return;
    (void)hipMemsetAsync((char*)d_ws + WS_CTL, 0, 65536, stream);
    Params p{};
    for (int i = 0; i < 25; ++i) p.in[i] = (const float*)d_in[i];
    p.out = (float*)d_out; p.ws = (unsigned char*)d_ws;
    for (int i = 0; i < 14; ++i) p.rep[i] = 1;
    p.rep[13] = 0;
#ifdef PROBE_SYNCS
    p.rep[13] = PROBE_SYNCS;
#endif
#ifdef PROBE_PHASE
    p.rep[PROBE_PHASE] = 2;
#endif
#ifdef PROBE_PHASE2
    p.rep[PROBE_PHASE2] = 2;
#endif
#if MK_SPLIT
    for (int ph = 0; ph < NPHASE; ++ph) { p.lo = ph; p.hi = ph + 1; void* args[] = {&p};
        hipError_t e = hipLaunchCooperativeKernel((const void*)hybrid_fwd, dim3(grid), dim3(512), args, LDS_BYTES, stream);
        if (e != hipSuccess) { fprintf(stderr, "cooperative launch (phase %d) failed: %s\n", ph, hipGetErrorString(e)); break; } }
#else
    p.lo = 0; p.hi = NPHASE; void* args[] = {&p};
    hipError_t e = hipLaunchCooperativeKernel((const void*)hybrid_fwd, dim3(grid), dim3(512), args, LDS_BYTES, stream);
    if (e != hipSuccess) fprintf(stderr, "cooperative launch failed: %s (grid %d)\n", hipGetErrorString(e), grid);
#endif
}
```

```cpp
#include <hip/hip_runtime.h>
#include <hip/hip_cooperative_groups.h>
#include <cstdio>
#include <cstdint>
namespace cg = cooperative_groups;

#ifndef MK_SPLIT
#define MK_SPLIT 0
#endif

namespace pg8 {
#define PG8_LAS __attribute__((address_space(3)))
typedef unsigned short bf16_t;
typedef short bf16x8 __attribute__((ext_vector_type(8)));
typedef float f32x4 __attribute__((ext_vector_type(4)));
typedef unsigned u32x4 __attribute__((ext_vector_type(4)));
typedef unsigned u32x2 __attribute__((ext_vector_type(2)));
constexpr int BM = 256, BK = 64, HALF = 128, HTB = HALF * BK * 2, STAGE_BYTES = 8 * HTB, NXCD = 8, WGM = 4;

__host__ __device__ __forceinline__ int lds_byte(int r, int c) { const int st = (r >> 4) * 2 + (c >> 5), rr = r & 15, cc = c & 31, ob = rr * 64 + cc * 2; return st * 1024 + (ob ^ (((ob >> 9) & 1) << 5)); }
__host__ __device__ __forceinline__ void stage_rc(int b, int& R, int& C) { const int st = b / 1024, sb = b % 1024, swz = sb ^ (((sb >> 9) & 1) << 5); R = (st >> 1) * 16 + swz / 64; C = (st & 1) * 32 + (swz % 64) / 2; }
__host__ __device__ __forceinline__ int perm32(int rho) { const int n = rho >> 4, i = rho & 15; return 8 * (i >> 2) + 4 * n + (i & 3); }

struct Unit { int pm, pn; };
struct Gemm { const bf16_t* A; const bf16_t* Bt; int M, N, K, lda, ldb; };

struct StaticOrder {
    int nM, nN, nwg, G, c;
    __host__ __device__ void init(int M, int N, int G_, int c_) { nM = M / BM; nN = N / BM; nwg = nM * nN; G = G_; c = c_; }
    __host__ __device__ bool next(int i, Unit& u) const {
        const long L = (long)i * G + c; if (L >= nwg) return false;
        int wgid = (int)L; { const int q = nwg / NXCD, r = nwg % NXCD, xcd = wgid % NXCD, off = wgid / NXCD; wgid = (xcd < r ? xcd * (q + 1) : r * (q + 1) + (xcd - r) * q) + off; }
        const int nig = WGM * nN, gid = wgid / nig, fm = gid * WGM, gsz = (nM - fm) < WGM ? (nM - fm) : WGM;
        u.pm = fm + ((wgid % nig) % gsz); u.pn = (wgid % nig) / gsz; return true;
    }
};

__device__ __forceinline__ unsigned cvt_pk_bf16(float lo, float hi) { unsigned r; asm volatile("v_cvt_pk_bf16_f32 %0, %1, %2" : "=v"(r) : "v"(lo), "v"(hi)); return r; }

template <class Epi, bool ALIGN_EPI>
__device__ __forceinline__ void gemm_phase(PG8_LAS unsigned char* lds, const Gemm g, const StaticOrder& S, const Epi& E) {
    const int tid = threadIdx.x, wid = __builtin_amdgcn_readfirstlane(tid >> 6), lane = tid & 63, wr = wid >> 2, wc = wid & 3, fr = lane & 15, fq = lane >> 4;
    const int K = g.K, nt = K / BK;
    unsigned voffA[2], voffB[2];
#pragma unroll
    for (int i = 0; i < 2; ++i) { int R, C; stage_rc(tid * 16 + i * 8192, R, C); const int Rb = Epi::PERM ? ((R & ~31) + perm32(R & 31)) : R;
        voffA[i] = (unsigned)(R * g.lda + C) * 2u; voffB[i] = (unsigned)(Rb * g.ldb + C) * 2u; }
    const size_t kstep = (size_t)(BK * 2);
    const size_t hstepA = (size_t)HALF * g.lda * 2, hstepB = (size_t)HALF * g.ldb * 2;
    const size_t tstepA = 2 * hstepA, tstepB = 2 * hstepB;
    const unsigned ldsw = (unsigned)wid * 1024u;
    const int aoff = lds_byte(wr * 64 + fr, fq * 8), boff = lds_byte(wc * 32 + fr, fq * 8);
#define PG8_SA(b, h) (((b) * 2 + (h)) * HTB)
#define PG8_SB(b, h) ((4 + (b) * 2 + (h)) * HTB)
#define PG8_STAGE(bufoff, gbase, voff) do { _Pragma("unroll") for (int _i = 0; _i < 2; ++_i) \
        __builtin_amdgcn_global_load_lds((const unsigned*)((const char*)(gbase) + (voff)[_i]), (PG8_LAS unsigned*)(lds + (bufoff) + ldsw + _i * 8192), 16, 0, 0); } while (0)
#define PG8_LDA(dst, b, h) do { _Pragma("unroll") for (int m = 0; m < 4; ++m) _Pragma("unroll") for (int k = 0; k < 2; ++k) dst[m][k] = *(const PG8_LAS bf16x8*)(lds + PG8_SA(b, h) + aoff + m * 2048 + k * 1024); } while (0)
#define PG8_LDB(dst, b, h) do { _Pragma("unroll") for (int n = 0; n < 2; ++n) _Pragma("unroll") for (int k = 0; k < 2; ++k) dst[n][k] = *(const PG8_LAS bf16x8*)(lds + PG8_SB(b, h) + boff + n * 2048 + k * 1024); } while (0)
#define PG8_MMA(ai, bj, At, Bt) do { __builtin_amdgcn_s_setprio(1); _Pragma("unroll") for (int m = 0; m < 4; ++m) _Pragma("unroll") for (int n = 0; n < 2; ++n) _Pragma("unroll") for (int k = 0; k < 2; ++k) \
        acc[ai][bj][m][n] = __builtin_amdgcn_mfma_f32_16x16x32_bf16(Bt[n][k], At[m][k], acc[ai][bj][m][n], 0, 0, 0); __builtin_amdgcn_s_setprio(0); } while (0)
#define PG8_WAIT_V(n) asm volatile("s_waitcnt vmcnt(" #n ")" ::: "memory")
#define PG8_WAIT_L(n) asm volatile("s_waitcnt lgkmcnt(" #n ")" ::: "memory")
#define PG8_BAR __builtin_amdgcn_s_barrier()
#define PG8_SCHED __builtin_amdgcn_sched_barrier(0)
    Unit cur, nxt; int ui = 0;
    if (!S.next(0, cur)) return;
    f32x4 acc[2][2][4][2];
#pragma unroll
    for (int a = 0; a < 2; ++a)
#pragma unroll
        for (int b = 0; b < 2; ++b)
#pragma unroll
            for (int m = 0; m < 4; ++m)
#pragma unroll
                for (int n = 0; n < 2; ++n) acc[a][b][m][n] = (f32x4){0.f, 0.f, 0.f, 0.f};
    bf16x8 At[4][2], B0[2][2], B1[2][2];
    const char* cA = (const char*)g.A + (size_t)cur.pm * tstepA; const char* cB = (const char*)g.Bt + (size_t)cur.pn * tstepB;
    PG8_STAGE(PG8_SB(0, 0), cB, voffB); PG8_STAGE(PG8_SB(0, 1), cB + hstepB, voffB); PG8_STAGE(PG8_SA(0, 0), cA, voffA); PG8_STAGE(PG8_SA(0, 1), cA + hstepA, voffA);
    if (wr == 1) PG8_BAR;
    PG8_WAIT_V(2); PG8_BAR;
    PG8_STAGE(PG8_SB(1, 0), cB + kstep, voffB); PG8_STAGE(PG8_SA(1, 0), cA + kstep, voffA); PG8_STAGE(PG8_SB(1, 1), cB + hstepB + kstep, voffB);
    PG8_WAIT_V(6); PG8_BAR;
    for (;;) {
        const bool has_next = S.next(ui + 1, nxt);
        const char* nA = has_next ? (const char*)g.A + (size_t)nxt.pm * tstepA : cA; const char* nB = has_next ? (const char*)g.Bt + (size_t)nxt.pn * tstepB : cB;
        for (int t = 0; t < nt; t += 2) {
            const bool last = (t == nt - 2);
            const char* a1 = cA + (size_t)(t + 1) * kstep;
            const char* a2 = last ? nA : cA + (size_t)(t + 2) * kstep; const char* b2 = last ? nB : cB + (size_t)(t + 2) * kstep;
            const char* a3 = a2 + kstep; const char* b3 = b2 + kstep;
            PG8_LDB(B0, 0, 0); PG8_LDB(B1, 0, 1); PG8_SCHED; PG8_LDA(At, 0, 0); PG8_STAGE(PG8_SA(1, 1), a1 + hstepA, voffA);
            PG8_WAIT_V(8); PG8_WAIT_L(0); PG8_BAR; PG8_MMA(0, 0, At, B0); PG8_MMA(0, 1, At, B1); PG8_BAR; PG8_SCHED;
            PG8_LDA(At, 0, 1); PG8_STAGE(PG8_SB(0, 0), b2, voffB); PG8_STAGE(PG8_SB(0, 1), b2 + hstepB, voffB); PG8_STAGE(PG8_SA(0, 0), a2, voffA);
            PG8_WAIT_V(8); PG8_WAIT_L(0); PG8_BAR; PG8_MMA(1, 0, At, B0); PG8_MMA(1, 1, At, B1); PG8_BAR; PG8_SCHED;
            PG8_LDB(B0, 1, 0); PG8_LDB(B1, 1, 1); PG8_SCHED; PG8_LDA(At, 1, 0); PG8_STAGE(PG8_SA(0, 1), a2 + hstepA, voffA);
            PG8_WAIT_V(8); PG8_WAIT_L(0); PG8_BAR; PG8_MMA(0, 0, At, B0); PG8_MMA(0, 1, At, B1); PG8_BAR; PG8_SCHED;
            PG8_LDA(At, 1, 1); PG8_STAGE(PG8_SB(1, 0), b3, voffB); PG8_STAGE(PG8_SB(1, 1), b3 + hstepB, voffB); PG8_STAGE(PG8_SA(1, 0), a3, voffA);
            PG8_WAIT_V(8); PG8_WAIT_L(0); PG8_BAR; PG8_MMA(1, 0, At, B0); PG8_MMA(1, 1, At, B1); PG8_BAR; PG8_SCHED;
        }
        if constexpr (ALIGN_EPI) { if (wr == 0) PG8_BAR; }
        E(acc, cur, wr, wc, fr, fq);
        if (!has_next) break;
#pragma unroll
        for (int a = 0; a < 2; ++a)
#pragma unroll
            for (int b = 0; b < 2; ++b)
#pragma unroll
                for (int m = 0; m < 4; ++m)
#pragma unroll
                    for (int n = 0; n < 2; ++n) acc[a][b][m][n] = (f32x4){0.f, 0.f, 0.f, 0.f};
        cur = nxt; cA = nA; cB = nB; ++ui;
        if constexpr (ALIGN_EPI) { if (wr == 1) PG8_BAR; }
    }
    PG8_WAIT_V(0);
    if constexpr (!ALIGN_EPI) { if (wr == 0) PG8_BAR; }
    PG8_BAR;
#undef PG8_SA
#undef PG8_SB
#undef PG8_STAGE
#undef PG8_LDA
#undef PG8_LDB
#undef PG8_MMA
#undef PG8_WAIT_V
#undef PG8_WAIT_L
#undef PG8_BAR
#undef PG8_SCHED
}
}

using pg8::bf16_t; using pg8::f32x4; using pg8::u32x4; using pg8::u32x2; using pg8::bf16x8; using pg8::cvt_pk_bf16;
typedef float f32x16 __attribute__((ext_vector_type(16)));

constexpr int NB = 8, SEQ = 4096, DM = 1024, T = NB * SEQ;
constexpr int NPROJ = 5632;
constexpr int IN_COLS = 5408, DFF = 2816;
constexpr size_t MiB = 1u << 20;
constexpr size_t WS_CTL = 0;
constexpr size_t WS_WIN = 1 * MiB, WS_WUP = 12 * MiB, WS_WDN = 23 * MiB, WS_WOUT = 29 * MiB, WS_WBA = 31 * MiB, WS_WBB = 32 * MiB;
constexpr size_t WS_WD = 33 * MiB, WS_WA = 33 * MiB + 256 * 1024, WS_WG = 33 * MiB + 512 * 1024;
constexpr size_t WS_KMEAN = 34 * MiB, WS_SBON = 35 * MiB, WS_SSQ = 36 * MiB;
constexpr size_t WS_GP = 38 * MiB, WS_ZR = 166 * MiB, WS_ZM = 294 * MiB, WS_HB = 390 * MiB, WS_EX = 454 * MiB, WS_END = 486 * MiB;
constexpr size_t WS_E = WS_HB, WS_ALR = WS_HB + 32 * MiB, WS_G = WS_EX;
constexpr size_t WS_R = WS_ZM, WS_K = WS_ZM + 32 * MiB, WS_V = WS_ZM + 64 * MiB;
constexpr size_t WS_YA = WS_ZM + 64 * MiB,         WS_MG = WS_ZM, WS_X1B = WS_HB, WS_U = WS_GP;
constexpr size_t OUT_LA = 0, OUT_KK = 0, OUT_Q = 32 * MiB, OUT_KP = 64 * MiB, OUT_VT = 96 * MiB;
constexpr int LDS_BYTES = 147456, LDS_MISC = 131072;

struct Params {
    const float* in[25]; float* out; unsigned char* ws; int lo, hi; int rep[14];
};
enum { I_X = 0, I_POS, I_N1G, I_WIN, I_MU, I_WDU, I_DB, I_WAU, I_AB, I_WGU, I_KK, I_KA, I_RK, I_LNG, I_LNB, I_QNG, I_KNG, I_WBA, I_WBB, I_WOUT, I_N2G, I_WUP, I_CW, I_CB, I_WDN };

__device__ __forceinline__ float bf_lo(unsigned w) { return __uint_as_float(w << 16); }
__device__ __forceinline__ float bf_hi(unsigned w) { return __uint_as_float(w & 0xffff0000u); }
__device__ __forceinline__ void unpack8(const u32x4 w, float* f) { f[0] = bf_lo(w.x); f[1] = bf_hi(w.x); f[2] = bf_lo(w.y); f[3] = bf_hi(w.y); f[4] = bf_lo(w.z); f[5] = bf_hi(w.z); f[6] = bf_lo(w.w); f[7] = bf_hi(w.w); }
__device__ __forceinline__ u32x4 pack8(const float* f) { u32x4 w; w.x = cvt_pk_bf16(f[0], f[1]); w.y = cvt_pk_bf16(f[2], f[3]); w.z = cvt_pk_bf16(f[4], f[5]); w.w = cvt_pk_bf16(f[6], f[7]); return w; }
__device__ __forceinline__ size_t hm_idx(size_t t, int c) { return ((((t >> 12) * 8 + (size_t)(c >> 6)) * 4096 + (t & 4095)) << 6) + (size_t)(c & 63); }
__device__ __forceinline__ float sigmoidf_(float x) { return 1.f / (1.f + __expf(-x)); }
__device__ __forceinline__ float wave_sum(float v) {
#pragma unroll
    for (int o = 1; o < 64; o <<= 1) v += __shfl_xor(v, o);
    return v;
}

__device__ __forceinline__ float gelu_erf(float v) {
    const float av = fabsf(v), t = __builtin_amdgcn_rcpf(av * 0.2316418882f + 1.0f);
    float q = t * 0.5307027145f + (-0.7265760135f); q = q * t + 0.7107068705f; q = q * t + (-0.142248368f); q = q * t + 0.127414796f; q = q * t;
    const float e = __builtin_amdgcn_exp2f((v * v) * (-0.72134752044f));
    const float m = v * (q * e);
    return v < 0.f ? m : v - m;
}
template <int CTRL> __device__ __forceinline__ float dpp_mov0(float x) { return __int_as_float(__builtin_amdgcn_update_dpp(0, __float_as_int(x), CTRL, 0xF, 0xF, false)); }
struct EpiProj {
    static constexpr bool PERM = true;
    bf16_t* zr; bf16_t* zm; bf16_t* gp; bf16_t* la; const float* mu; bool dry;
    __device__ __forceinline__ void operator()(const f32x4 (&acc)[2][2][4][2], const pg8::Unit& u, int wr, int wc, int fr, int fq) const {
        if (u.pn == 6 || u.pn == 7) {
            const int row0 = u.pm * 256 + wr * 64 + fr;
#pragma unroll
            for (int bj = 0; bj < 2; ++bj) {
                const int c = u.pn * 256 + bj * 128 + wc * 32 + 8 * fq;
                const int mode = c < 1600 ? 1 : (c < 1664 ? 0 : (c < 1824 ? 2 : 3));
                const int kq = c - 1824;
                const int dc = c < 1600 ? c - 1536 : (c < 1664 ? c - 1600 + 128 : (c < 1824 ? c - 1664 + 256 : (kq < 64 ? 64 + kq : (kq < 128 ? 192 + (kq - 64) : 416 + (kq - 128)))));
                const int mc_ = mode == 3 ? 0 : c;
                const f32x4 mu0 = *(const f32x4*)(mu + mc_), mu1 = *(const f32x4*)(mu + mc_ + 4);
#pragma unroll
                for (int ai = 0; ai < 2; ++ai)
#pragma unroll
                    for (int m = 0; m < 4; ++m) { const size_t row = (size_t)(row0 + ai * 128 + m * 16); float o[8], rawv[8];
#pragma unroll
                        for (int i = 0; i < 8; ++i) { const float cur = acc[ai][bj][m][i >> 2][i & 3];
                            const float oldv = m > 0 ? dpp_mov0<0x121>(acc[ai][bj][m > 0 ? m - 1 : 0][i >> 2][i & 3]) : 0.f;
                            const float prev = __int_as_float(__builtin_amdgcn_update_dpp(__float_as_int(oldv), __float_as_int(cur), 0x111, 0xF, 0xF, false));
                            const float mui = i < 4 ? mu0[i & 3] : mu1[i & 3];
                            const float z = cur + mui * (prev - cur), zz = mode == 1 ? 2.f * z : z, sg = 1.f / (1.f + __expf(-zz));
                            o[i] = mode == 1 ? 2.f * sg - 1.f : (mode == 2 ? sg : (mode == 0 ? z : 0.f)); rawv[i] = cur; }
                        if (!(m == 0 && fr == 0)) *(u32x4*)(la + row * 512 + dc) = pack8(o);
                        if ((m == 0 && fr == 0) || (m == 3 && fr == 15)) *(u32x4*)(zr + row * 2048 + c) = pack8(rawv);
                        asm volatile("" ::: "memory"); }
            }
            return;
        }
        bf16_t* base; int ldc, colt;
        if (u.pn < 8) { base = zr; ldc = 2048; colt = u.pn * 256; } else if (u.pn < 14) { base = zm; ldc = 1536; colt = (u.pn - 8) * 256; } else { base = gp; ldc = 2048; colt = (u.pn - 14) * 256; }
        const int row0 = u.pm * 256 + wr * 64 + fr, col0 = colt + wc * 32 + 8 * fq;
#pragma unroll
        for (int ai = 0; ai < 2; ++ai)
#pragma unroll
            for (int m = 0; m < 4; ++m) { bf16_t* rowp = base + (size_t)(row0 + ai * 128 + m * 16) * ldc + col0;
#pragma unroll
                for (int bj = 0; bj < 2; ++bj) { const f32x4 v0 = acc[ai][bj][m][0], v1 = acc[ai][bj][m][1]; u32x4 w;
                    w.x = cvt_pk_bf16(v0[0], v0[1]); w.y = cvt_pk_bf16(v0[2], v0[3]); w.z = cvt_pk_bf16(v1[0], v1[1]); w.w = cvt_pk_bf16(v1[2], v1[3]);
                    if (!dry) *(u32x4*)(rowp + bj * 128) = w; } }
    }
};
struct EpiLora {
    static constexpr bool PERM = true;
    bf16_t* O; const float* bias; int mode;
    __device__ __forceinline__ void operator()(const f32x4 (&acc)[2][2][4][2], const pg8::Unit& u, int wr, int wc, int fr, int fq) const {
        const int row0 = u.pm * 256 + wr * 64 + fr, col0 = u.pn * 256 + wc * 32 + 8 * fq;
        const float sc = mode == 0 ? 0.6065306597126334f : 1.f;
#pragma unroll
        for (int bj = 0; bj < 2; ++bj) {
            f32x4 b0 = {0.f, 0.f, 0.f, 0.f}, b1 = {0.f, 0.f, 0.f, 0.f};
            if (mode != 2) { b0 = *(const f32x4*)(bias + col0 + bj * 128); b1 = *(const f32x4*)(bias + col0 + bj * 128 + 4); }
#pragma unroll
            for (int ai = 0; ai < 2; ++ai)
#pragma unroll
                for (int m = 0; m < 4; ++m) { const size_t row_ = (size_t)(row0 + ai * 128 + m * 16); bf16_t* rowp = O + (mode == 2 ? row_ * 512 + col0 + bj * 128 : hm_idx(row_, col0 + bj * 128));
                    f32x4 v0 = acc[ai][bj][m][0] + b0, v1 = acc[ai][bj][m][1] + b1;
                    if (mode != 2) {
#pragma unroll
                        for (int i = 0; i < 4; ++i) { v0[i] = sigmoidf_(v0[i]) * sc; v1[i] = sigmoidf_(v1[i]) * sc; } }
                    u32x4 w; w.x = cvt_pk_bf16(v0[0], v0[1]); w.y = cvt_pk_bf16(v0[2], v0[3]); w.z = cvt_pk_bf16(v1[0], v1[1]); w.w = cvt_pk_bf16(v1[2], v1[3]);
                    *(u32x4*)rowp = w;
                    asm volatile("" ::: "memory"); }
        }
    }
};
struct EpiBranch {
    static constexpr bool PERM = true;
    bf16_t* MG; const bf16_t* GP; int second;
    __device__ __forceinline__ void operator()(const f32x4 (&acc)[2][2][4][2], const pg8::Unit& u, int wr, int wc, int fr, int fq) const {
        const int row0 = u.pm * 256 + wr * 64 + fr, col0 = u.pn * 256 + wc * 32 + 8 * fq;
        u32x4 cg[2], cm[2], ng[2], nm[2];
#pragma unroll
        for (int bj = 0; bj < 2; ++bj) { cg[bj] = *(const u32x4*)(GP + (size_t)row0 * 2048 + second * 1024 + col0 + bj * 128);
            cm[bj] = second ? *(const u32x4*)(MG + (size_t)row0 * 1024 + col0 + bj * 128) : (u32x4){0u, 0u, 0u, 0u}; ng[bj] = cg[bj]; nm[bj] = cm[bj]; }
#pragma unroll
        for (int g = 0; g < 8; ++g) { const int ai = g >> 2, m = g & 3; const size_t row = (size_t)(row0 + ai * 128 + m * 16);
            if (g + 1 < 8) { const size_t rown = (size_t)(row0 + ((g + 1) >> 2) * 128 + ((g + 1) & 3) * 16);
#pragma unroll
                for (int bj = 0; bj < 2; ++bj) { ng[bj] = *(const u32x4*)(GP + rown * 2048 + second * 1024 + col0 + bj * 128);
                    if (second) nm[bj] = *(const u32x4*)(MG + rown * 1024 + col0 + bj * 128); }
                asm volatile("" ::: "memory"); }
#pragma unroll
            for (int bj = 0; bj < 2; ++bj) { const int col = col0 + bj * 128; float v[8], gt[8], pv[8];
#pragma unroll
                for (int i = 0; i < 4; ++i) { v[i] = acc[ai][bj][m][0][i]; v[4 + i] = acc[ai][bj][m][1][i]; }
                unpack8(cg[bj], gt); unpack8(cm[bj], pv);
#pragma unroll
                for (int i = 0; i < 8; ++i) v[i] = v[i] * sigmoidf_(gt[i]) + pv[i];
                *(u32x4*)(MG + row * 1024 + col) = pack8(v); }
#pragma unroll
            for (int bj = 0; bj < 2; ++bj) { cg[bj] = ng[bj]; cm[bj] = nm[bj]; } }
    }
};
struct EpiOut {
    static constexpr bool PERM = true;
    const float* x; float* x1; bf16_t* x1b; float* ssq;
    __device__ __forceinline__ void operator()(const f32x4 (&acc)[2][2][4][2], const pg8::Unit& u, int wr, int wc, int fr, int fq) const {
        const int row0 = u.pm * 256 + wr * 64 + fr, col0 = u.pn * 256 + wc * 32 + 8 * fq;
        f32x4 cur[2][2], nxt[2][2];
#pragma unroll
        for (int bj = 0; bj < 2; ++bj)
#pragma unroll
            for (int n = 0; n < 2; ++n) { cur[bj][n] = *(const f32x4*)(x + (size_t)row0 * 1024 + col0 + bj * 128 + n * 4); nxt[bj][n] = cur[bj][n]; }
#pragma unroll
        for (int g = 0; g < 8; ++g) { const int ai = g >> 2, m = g & 3; const size_t row = (size_t)(row0 + ai * 128 + m * 16); float s = 0.f;
            if (g + 1 < 8) { const size_t rown = (size_t)(row0 + ((g + 1) >> 2) * 128 + ((g + 1) & 3) * 16);
#pragma unroll
                for (int bj = 0; bj < 2; ++bj)
#pragma unroll
                    for (int n = 0; n < 2; ++n) nxt[bj][n] = *(const f32x4*)(x + rown * 1024 + col0 + bj * 128 + n * 4);
                asm volatile("" ::: "memory"); }
#pragma unroll
            for (int bj = 0; bj < 2; ++bj) { const size_t off = row * 1024 + col0 + bj * 128;
                const f32x4 r0 = cur[bj][0] + acc[ai][bj][m][0], r1 = cur[bj][1] + acc[ai][bj][m][1];
                u32x4 w; w.x = cvt_pk_bf16(r0[0], r0[1]); w.y = cvt_pk_bf16(r0[2], r0[3]); w.z = cvt_pk_bf16(r1[0], r1[1]); w.w = cvt_pk_bf16(r1[2], r1[3]);
                *(u32x4*)(x1b + off) = w;
                s += ((r0[0] * r0[0] + r0[1] * r0[1]) + (r0[2] * r0[2] + r0[3] * r0[3])) + ((r1[0] * r1[0] + r1[1] * r1[1]) + (r1[2] * r1[2] + r1[3] * r1[3])); }
            s += __shfl_xor(s, 16); s += __shfl_xor(s, 32);
            if (fq == 0) ssq[row * 16 + u.pn * 4 + wc] = s;
#pragma unroll
            for (int bj = 0; bj < 2; ++bj)
#pragma unroll
                for (int n = 0; n < 2; ++n) cur[bj][n] = nxt[bj][n]; }
    }
};
template <int CTRL> __device__ __forceinline__ float dpp_mov(float x) { return __int_as_float(__builtin_amdgcn_update_dpp(0, __float_as_int(x), CTRL, 0xF, 0xF, false)); }
struct EpiUp {
    static constexpr bool PERM = true;
    bf16_t* U; const float* ssq; const float* cw; const float* cb;
    __device__ __forceinline__ void operator()(const f32x4 (&acc)[2][2][4][2], const pg8::Unit& u, int wr, int wc, int fr, int fq) const {
        const int row0 = u.pm * 256 + wr * 64 + fr, cl = u.pn * 128 + wc * 32 + 8 * fq;
#pragma unroll
        for (int n = 0; n < 2; ++n) {
            const int c4 = cl + 4 * n;
            const f32x4 w0 = *(const f32x4*)(cw + c4), w1 = *(const f32x4*)(cw + DFF + c4), w2 = *(const f32x4*)(cw + 2 * DFF + c4), bs = *(const f32x4*)(cb + c4);
            f32x4 cs4[4], ns4[4];
            f32x4 avp = {0.f, 0.f, 0.f, 0.f};
#pragma unroll
            for (int q = 0; q < 4; ++q) { cs4[q] = ((const f32x4*)(ssq + (size_t)row0 * 16))[q]; ns4[q] = cs4[q]; }
#pragma unroll
            for (int g = 0; g < 8; ++g) { const int ai = g >> 2, m = g & 3; const size_t row = (size_t)(row0 + ai * 128 + m * 16);
                if (g + 1 < 8) { const size_t rown = (size_t)(row0 + ((g + 1) >> 2) * 128 + ((g + 1) & 3) * 16);
#pragma unroll
                    for (int q = 0; q < 4; ++q) ns4[q] = ((const f32x4*)(ssq + rown * 16))[q];
                    asm volatile("" ::: "memory"); }
                const f32x4 sa_ = cs4[0], sb_ = cs4[1], sc_ = cs4[2], sd_ = cs4[3];
                const float ss = ((sa_[0] + sa_[1]) + (sa_[2] + sa_[3])) + ((sb_[0] + sb_[1]) + (sb_[2] + sb_[3])) + ((sc_[0] + sc_[1]) + (sc_[2] + sc_[3])) + ((sd_[0] + sd_[1]) + (sd_[2] + sd_[3]));
                const float rstd = rsqrtf(ss * (1.f / 1024.f) + 1e-6f);
                const f32x4 av = acc[ai][0][m][n] * rstd, bv = acc[ai][1][m][n] * rstd; f32x4 o;
#pragma unroll
                for (int i = 0; i < 4; ++i) {
                    const float o1 = m > 0 ? dpp_mov<0x121>(avp[i]) : 0.f, o2 = m > 0 ? dpp_mov<0x122>(avp[i]) : 0.f;
                    const float p1 = __int_as_float(__builtin_amdgcn_update_dpp(__float_as_int(o1), __float_as_int(av[i]), 0x111, 0xF, 0xF, false));
                    const float p2 = __int_as_float(__builtin_amdgcn_update_dpp(__float_as_int(o2), __float_as_int(av[i]), 0x112, 0xF, 0xF, false));
                    const float v = w0[i] * p2 + w1[i] * p1 + w2[i] * av[i] + bs[i]; o[i] = gelu_erf(v) * bv[i]; }
                bf16_t* ua = U + row * NPROJ + c4; bf16_t* ub = ua + DFF;
                u32x2 pa, pb, po; pa.x = cvt_pk_bf16(av[0], av[1]); pa.y = cvt_pk_bf16(av[2], av[3]); pb.x = cvt_pk_bf16(bv[0], bv[1]); pb.y = cvt_pk_bf16(bv[2], bv[3]);
                po.x = cvt_pk_bf16(o[0], o[1]); po.y = cvt_pk_bf16(o[2], o[3]);
                if (fr >= 2 || m > 0) { *(u32x2*)ub = po; if (fr >= 14 && m == 3) *(u32x2*)ua = pa; }
                else { *(u32x2*)ua = pa; *(u32x2*)ub = pb; }
                avp = av;
#pragma unroll
                for (int q = 0; q < 4; ++q) cs4[q] = ns4[q]; }
        }
    }
};
struct EpiDown {
    static constexpr bool PERM = true;
    float* out; const bf16_t* x1b; bool dry;
    __device__ __forceinline__ void operator()(const f32x4 (&acc)[2][2][4][2], const pg8::Unit& u, int wr, int wc, int fr, int fq) const {
        const int row0 = u.pm * 256 + wr * 64 + fr, col0 = u.pn * 256 + wc * 32 + 8 * fq;
        u32x4 cur[2], nxt[2];
#pragma unroll
        for (int bj = 0; bj < 2; ++bj) { cur[bj] = *(const u32x4*)(x1b + (size_t)row0 * 1024 + col0 + bj * 128); nxt[bj] = cur[bj]; }
#pragma unroll
        for (int g = 0; g < 8; ++g) { const int ai = g >> 2, m = g & 3; const size_t row = (size_t)(row0 + ai * 128 + m * 16);
            if (g + 1 < 8) { const size_t rown = (size_t)(row0 + ((g + 1) >> 2) * 128 + ((g + 1) & 3) * 16);
#pragma unroll
                for (int bj = 0; bj < 2; ++bj) nxt[bj] = *(const u32x4*)(x1b + rown * 1024 + col0 + bj * 128);
                asm volatile("" ::: "memory"); }
#pragma unroll
            for (int bj = 0; bj < 2; ++bj) { const size_t off = row * 1024 + col0 + bj * 128; const u32x4 xb = cur[bj];
                const f32x4 x0 = {bf_lo(xb.x), bf_hi(xb.x), bf_lo(xb.y), bf_hi(xb.y)}, x1 = {bf_lo(xb.z), bf_hi(xb.z), bf_lo(xb.w), bf_hi(xb.w)};
                const f32x4 r0 = x0 + acc[ai][bj][m][0], r1 = x1 + acc[ai][bj][m][1];
                if (!dry) { *(f32x4*)(out + off) = r0; *(f32x4*)(out + off + 4) = r1; } }
#pragma unroll
            for (int bj = 0; bj < 2; ++bj) cur[bj] = nxt[bj]; }
    }
};

__device__ __forceinline__ void tr_item(const float* W, int Ksrc, int Nsrc, int srccol0, const float* rowscale, bf16_t* WT, int ldk, int n0, int k0, float* scr, int lane) {
    float v[32]; const int nn = lane & 31; const bool colok = srccol0 >= 0; const float* Wc = W + (colok ? srccol0 : 0) + nn;
#pragma unroll
    for (int i = 0; i < 32; ++i) { const int k = k0 + 2 * i + (lane >> 5); const bool ok = colok && k < Ksrc; const int kc = ok ? k : 0;
        float t = Wc[(size_t)kc * Nsrc]; if (rowscale) t *= rowscale[kc]; v[i] = ok ? t : 0.f; }
#pragma unroll
    for (int i = 0; i < 32; ++i) scr[(2 * i + (lane >> 5)) * 33 + nn] = v[i];
    asm volatile("s_waitcnt lgkmcnt(0)" ::: "memory");
    const int c = lane & 7;
#pragma unroll
    for (int j = 0; j < 4; ++j) { const int n = (lane >> 3) + 8 * j; const float* s = scr + (8 * c) * 33 + n;
        u32x4 o; o.x = cvt_pk_bf16(s[0 * 33], s[1 * 33]); o.y = cvt_pk_bf16(s[2 * 33], s[3 * 33]); o.z = cvt_pk_bf16(s[4 * 33], s[5 * 33]); o.w = cvt_pk_bf16(s[6 * 33], s[7 * 33]);
        *(u32x4*)(WT + (size_t)(n0 + n) * ldk + k0 + 8 * c) = o; }
    asm volatile("s_waitcnt lgkmcnt(0)" ::: "memory");
}
__device__ __forceinline__ void phase0(const Params& p, unsigned char* lds) {
    const int tid = threadIdx.x, lane = tid & 63, wave = tid >> 6;
    float* scr = (float*)(lds + wave * 16384);
    const int gw = blockIdx.x * 8 + wave, NGW = gridDim.x * 8;
    unsigned char* ws = p.ws;
    constexpr int I_1 = 16 * 176, I_2 = 16 * 176, I_3 = 44 * 32, I_4 = 16 * 32, I_5 = 8 * 32, I_6 = 8 * 32, I_7 = 2 * 16, I_8 = 2 * 16, I_9 = 4 * 16;
    constexpr int NIT = I_1 + I_2 + I_3 + I_4 + I_5 + I_6 + I_7 + I_8 + I_9;
    for (int it = gw; it < NIT; it += NGW) {
        int r = it;
        if (r < I_1) { const int kb = r / 176, nb = r % 176, n0 = nb * 32; const int sc = n0 < 1824 ? n0 : (n0 < 2048 ? -1 : n0 - 224);
            tr_item(p.in[I_WIN], 1024, IN_COLS, sc, nullptr, (bf16_t*)(ws + WS_WIN), 1024, n0, kb * 64, scr, lane); continue; } r -= I_1;
        if (r < I_2) { const int kb = r / 176, nb = r % 176; const int n0 = nb * 32, pn_ = n0 >> 8, w_ = n0 & 255; const int sc = w_ < 128 ? 128 * pn_ + w_ : DFF + 128 * pn_ + (w_ - 128);
            tr_item(p.in[I_WUP], 1024, 5632, sc, p.in[I_N2G], (bf16_t*)(ws + WS_WUP), 1024, n0, kb * 64, scr, lane); continue; } r -= I_2;
        if (r < I_3) { const int kb = r / 32, nb = r % 32; tr_item(p.in[I_WDN], 2816, 1024, nb * 32, nullptr, (bf16_t*)(ws + WS_WDN), 2816, nb * 32, kb * 64, scr, lane); continue; } r -= I_3;
        if (r < I_4) { const int kb = r / 32, nb = r % 32; tr_item(p.in[I_WOUT], 1024, 1024, nb * 32, nullptr, (bf16_t*)(ws + WS_WOUT), 1024, nb * 32, kb * 64, scr, lane); continue; } r -= I_4;
        if (r < I_5) { const int kb = r / 32, nb = r % 32; tr_item(p.in[I_WBA], 512, 1024, nb * 32, nullptr, (bf16_t*)(ws + WS_WBA), 512, nb * 32, kb * 64, scr, lane); continue; } r -= I_5;
        if (r < I_6) { const int kb = r / 32, nb = r % 32; tr_item(p.in[I_WBB], 512, 1024, nb * 32, nullptr, (bf16_t*)(ws + WS_WBB), 512, nb * 32, kb * 64, scr, lane); continue; } r -= I_6;
        if (r < I_7) { const int kb = r / 16, nb = r % 16; tr_item(p.in[I_WDU], 64, 512, nb * 32, nullptr, (bf16_t*)(ws + WS_WD), 128, nb * 32, kb * 64, scr, lane); continue; } r -= I_7;
        if (r < I_8) { const int kb = r / 16, nb = r % 16; tr_item(p.in[I_WAU], 64, 512, nb * 32, nullptr, (bf16_t*)(ws + WS_WA), 128, nb * 32, kb * 64, scr, lane); continue; } r -= I_8;
        { const int kb = r / 16, nb = r % 16; tr_item(p.in[I_WGU], 160, 512, nb * 32, nullptr, (bf16_t*)(ws + WS_WG), 256, nb * 32, kb * 64, scr, lane); }
    }
    const float* x = p.in[I_X]; const float* g1 = p.in[I_N1G]; bf16_t* hb = (bf16_t*)(ws + WS_HB);
    f32x4 gv[4];
#pragma unroll
    for (int j = 0; j < 4; ++j) gv[j] = *(const f32x4*)(g1 + 4 * lane + 256 * j);
    for (int m0 = gw; m0 < T; m0 += 4 * NGW) {
        f32x4 v[4][4];
#pragma unroll
        for (int j = 0; j < 4; ++j) { const f32x4* xr = (const f32x4*)(x + (size_t)(m0 + j * NGW) * DM) + lane;
#pragma unroll
            for (int q = 0; q < 4; ++q) v[j][q] = xr[64 * q]; }
#pragma unroll
        for (int j = 0; j < 4; ++j) { float s = 0.f;
#pragma unroll
            for (int q = 0; q < 4; ++q) s += (v[j][q][0] * v[j][q][0] + v[j][q][1] * v[j][q][1]) + (v[j][q][2] * v[j][q][2] + v[j][q][3] * v[j][q][3]);
            const float rstd = rsqrtf(wave_sum(s) * (1.f / DM) + 1e-6f);
            u32x2* o8 = (u32x2*)(hb + (size_t)(m0 + j * NGW) * DM) + lane;
#pragma unroll
            for (int q = 0; q < 4; ++q) { const f32x4 y = v[j][q] * rstd * gv[q]; u32x2 w; w.x = cvt_pk_bf16(y[0], y[1]); w.y = cvt_pk_bf16(y[2], y[3]); o8[64 * q] = w; } }
    }
}

__device__ __forceinline__ void phase2(const Params& p, unsigned char* lds, int parts) {
    const int tid = threadIdx.x;
    unsigned char* ws = p.ws;
    const bf16_t* ZM = (const bf16_t*)(ws + WS_ZM); const bf16_t* ZR = (const bf16_t*)(ws + WS_ZR);
    bf16_t* Qp = (bf16_t*)((unsigned char*)p.out + OUT_Q); bf16_t* Kp = (bf16_t*)((unsigned char*)p.out + OUT_KP); bf16_t* VT = (bf16_t*)((unsigned char*)p.out + OUT_VT);
    bf16_t* LA = (bf16_t*)((unsigned char*)p.out + OUT_LA);
    float* KMEAN = (float*)(ws + WS_KMEAN);
    const int* pos = (const int*)p.in[I_POS];
    float* kl = (float*)lds;
    unsigned short* vl = (unsigned short*)(lds + 256 * 65 * 4);
    const int tok = tid >> 1, half = tid & 1;
    const float rvh[8] = {0.15915493667125702f, 0.030863763764500618f, 0.005985185503959656f, 0.0011606636689975858f, 0.0002250790857942775f, 4.3647953134495765e-05f, 8.464330676360987e-06f, 1.6414262518082978e-06f};
    const float rvl[8] = {6.4206382432985265e-09f, -6.060805191054897e-10f, 1.7242327010613678e-10f, -4.8028716420622786e-11f, -6.753226016592562e-12f, 1.6772382094298877e-12f, -1.2670839041623722e-13f, -9.854460929453572e-15f};
    u32x4 nraw[2][4]; int npos = 0;
#define P2_LOAD(it_) do { const int h_ = (it_) & 7, blk_ = ((it_) >> 3) & 15, b_ = (it_) >> 7; const size_t t_ = (size_t)b_ * SEQ + blk_ * 256 + tok; npos = pos[t_]; \
        _Pragma("unroll") for (int w3 = 1; w3 < 2; ++w3) _Pragma("unroll") for (int j = 0; j < 4; ++j) nraw[w3][j] = *(const u32x4*)(ZM + t_ * 1536 + w3 * 512 + h_ * 64 + 32 * half + 8 * j); } while (0)
    if ((parts & 1) && (int)blockIdx.x < 1024) P2_LOAD((int)blockIdx.x);
    if (parts & 1)
    for (int item = blockIdx.x; item < 1024; item += gridDim.x) {
        const int h = item & 7, blk = (item >> 3) & 15, b = item >> 7;
        const size_t t = (size_t)b * SEQ + blk * 256 + tok;
        u32x4 raw[2][4]; const int cpos = npos;
#pragma unroll
        for (int w3 = 1; w3 < 2; ++w3)
#pragma unroll
            for (int j = 0; j < 4; ++j) raw[w3][j] = nraw[w3][j];
        if (item + (int)gridDim.x < 1024) P2_LOAD(item + (int)gridDim.x);
        float cs[8], sn[8];
        { const float ps = (float)cpos;
#pragma unroll
          for (int i = 0; i < 8; ++i) { const float hi_ = ps * rvh[i], lo_ = fmaf(ps, rvh[i], -hi_) + ps * rvl[i];
              const float fx = (hi_ - floorf(hi_)) + lo_; sn[i] = __builtin_amdgcn_sinf(fx); cs[i] = __builtin_amdgcn_cosf(fx); } }
#pragma unroll
        for (int which = 1; which < 2; ++which) {
            const float* gg = p.in[which ? I_KNG : I_QNG] + 32 * half;
            float v[32];
#pragma unroll
            for (int j = 0; j < 4; ++j) unpack8(raw[which][j], v + 8 * j);
            float ss = 0.f;
#pragma unroll
            for (int i = 0; i < 32; ++i) ss += v[i] * v[i];
            ss += __shfl_xor(ss, 1);
            const float rstd = rsqrtf(ss * (1.f / 64.f) + 1e-6f);
#pragma unroll
            for (int i = 0; i < 32; ++i) v[i] = v[i] * rstd * gg[i];
            if (half == 0) {
#pragma unroll
                for (int i = 0; i < 8; ++i) { const float x1 = v[i], x2 = v[8 + i]; v[i] = x1 * cs[i] - x2 * sn[i]; v[8 + i] = x2 * cs[i] + x1 * sn[i]; }
            }
            bf16_t* dst = (which ? Kp : Qp) + t * 512 + h * 64 + 32 * half;
#pragma unroll
            for (int j = 0; j < 4; ++j) *(u32x4*)(dst + 8 * j) = pack8(v + 8 * j);
            if (which == 1) {
#pragma unroll
                for (int i = 0; i < 32; ++i) kl[tok * 65 + 32 * half + i] = v[i];
            }
        }
        __syncthreads();
        { float* kp = (float*)(lds + 256 * 65 * 4); const int d_ = tid & 63, part = tid >> 6; float s0_ = 0.f, s1_ = 0.f;
#pragma unroll 8
          for (int r = 0; r < 32; r += 2) { s0_ += kl[(part * 32 + r) * 65 + d_]; s1_ += kl[(part * 32 + r + 1) * 65 + d_]; }
          kp[part * 64 + d_] = s0_ + s1_; }
        __syncthreads();
        if (tid < 64) { const float* kp = (const float*)(lds + 256 * 65 * 4); float s_ = 0.f;
#pragma unroll
            for (int q8 = 0; q8 < 8; ++q8) s_ += kp[q8 * 64 + tid];
            KMEAN[((size_t)(b * 8 + h) * 16 + blk) * 64 + tid] = s_ * (1.f / 256.f); }
    }
    __syncthreads();
    const float* mu = p.in[I_MU];
    const size_t NG = (parts & 2) ? (size_t)(T / 64) * 64 : 0;
    for (size_t idx = (size_t)blockIdx.x * 512 + tid; idx < NG; idx += (size_t)gridDim.x * 512) {
        const size_t t = (idx >> 6) * 64; const int dc = (int)(idx & 63) * 8; int sc = -1, mode = 0;
        if (dc < 64) { sc = 1536 + dc; mode = 1; } else if (dc >= 128 && dc < 192) { sc = 1600 + dc - 128; mode = 0; } else if (dc >= 256 && dc < 416) { sc = 1664 + dc - 256; mode = 2; }
        float v[8];
#pragma unroll
        for (int i = 0; i < 8; ++i) v[i] = 0.f;
        if (sc >= 0) { float a[8], pr[8]; unpack8(*(const u32x4*)(ZR + t * 2048 + sc), a);
            if ((t & (SEQ - 1)) != 0) unpack8(*(const u32x4*)(ZR + (t - 1) * 2048 + sc), pr); else {
#pragma unroll
                for (int i = 0; i < 8; ++i) pr[i] = 0.f; }
#pragma unroll
            for (int i = 0; i < 8; ++i) { const float z = a[i] + mu[sc + i] * (pr[i] - a[i]); v[i] = mode == 1 ? tanhf(z) : (mode == 2 ? sigmoidf_(z) : z); } }
        *(u32x4*)(LA + t * 512 + dc) = pack8(v);
    }
}

__device__ __forceinline__ void phase4(const Params& p) {
    const int tid = threadIdx.x; unsigned char* ws = p.ws;
    const bf16_t* ZR = (const bf16_t*)(ws + WS_ZR); const bf16_t* ALR = (const bf16_t*)(ws + WS_ALR);
    bf16_t* R = (bf16_t*)(ws + WS_R); bf16_t* K = (bf16_t*)(ws + WS_K); bf16_t* V = (bf16_t*)(ws + WS_V); bf16_t* KK = (bf16_t*)((unsigned char*)p.out + OUT_KK);
    float* SBON = (float*)(ws + WS_SBON);
    const float* mu = p.in[I_MU]; const float* k_k = p.in[I_KK]; const float* k_a = p.in[I_KA]; const float* r_k = p.in[I_RK];
    const size_t NG = (size_t)(T / 2) * 64;
    for (size_t idx = (size_t)blockIdx.x * 512 + tid; idx < NG; idx += (size_t)gridDim.x * 512) {
        const size_t t0 = (idx >> 6) * 2; const int c0 = (int)(idx & 63) * 8;
        const bool first = (t0 & (SEQ - 1)) == 0;
        u32x4 raw[3][3], ral[2];
#pragma unroll
        for (int j = 0; j < 3; ++j)
#pragma unroll
            for (int w3 = 0; w3 < 3; ++w3) { if (j > 0 || !first) raw[j][w3] = *(const u32x4*)(ZR + (t0 + j - 1) * 2048 + w3 * 512 + c0); else raw[j][w3] = (u32x4){0u, 0u, 0u, 0u}; }
        const size_t hm0 = hm_idx(t0, c0);
        ral[0] = *(const u32x4*)(ALR + hm0); ral[1] = *(const u32x4*)(ALR + hm0 + 64);
        float muv[3][8], kkw[8], kaw[8], rkw[8];
#pragma unroll
        for (int i = 0; i < 8; ++i) { muv[0][i] = mu[c0 + i]; muv[1][i] = mu[512 + c0 + i]; muv[2][i] = mu[1024 + c0 + i]; kkw[i] = k_k[c0 + i]; kaw[i] = k_a[c0 + i]; rkw[i] = r_k[c0 + i]; }
#pragma unroll
        for (int j = 0; j < 2; ++j) {
            float z[3][8], pr[8], al[8];
#pragma unroll
            for (int w3 = 0; w3 < 3; ++w3) { unpack8(raw[j + 1][w3], z[w3]); unpack8(raw[j][w3], pr);
#pragma unroll
                for (int i = 0; i < 8; ++i) z[w3][i] = z[w3][i] + muv[w3][i] * (pr[i] - z[w3][i]); }
            unpack8(ral[j], al);
            float kk[8], km[8]; float ss = 0.f, sb = 0.f;
#pragma unroll
            for (int i = 0; i < 8; ++i) { kk[i] = z[1][i] * kkw[i]; ss += kk[i] * kk[i]; km[i] = z[1][i] * (1.f + (al[i] - 1.f) * kaw[i]); sb += z[0][i] * km[i] * rkw[i]; }
            ss += __shfl_xor(ss, 1); ss += __shfl_xor(ss, 2); ss += __shfl_xor(ss, 4);
            sb += __shfl_xor(sb, 1); sb += __shfl_xor(sb, 2); sb += __shfl_xor(sb, 4);
            const float inv = 1.f / fmaxf(sqrtf(ss), 1e-12f);
#pragma unroll
            for (int i = 0; i < 8; ++i) kk[i] *= inv;
            const size_t hm = hm0 + 64 * j;
            *(u32x4*)(R + hm) = pack8(z[0]); *(u32x4*)(K + hm) = pack8(km); *(u32x4*)(V + hm) = pack8(z[2]); *(u32x4*)(KK + hm) = pack8(kk);
            if ((idx & 7) == 0) SBON[(t0 + j) * 8 + (c0 >> 6)] = sb;
        }
    }
}

template <int CTRL> __device__ __forceinline__ float dpp_add(float x) {
    const int y = __builtin_amdgcn_update_dpp(0, __float_as_int(x), CTRL, 0xF, 0xF, false);
    return x + __int_as_float(y);
}
__device__ __forceinline__ float row16_sum(float x) {
    x = dpp_add<0xB1>(x);
    x = dpp_add<0x4E>(x);
    x = dpp_add<0x141>(x);
    x = dpp_add<0x140>(x);
    return x;
}
typedef float f32x2 __attribute__((ext_vector_type(2)));
__device__ __forceinline__ float fmul_(float a, float b) { float d; asm("v_mul_f32_e32 %0, %1, %2" : "=v"(d) : "v"(a), "v"(b)); return d; }
__device__ __forceinline__ float fadd_(float a, float b) { float d; asm("v_add_f32_e32 %0, %1, %2" : "=v"(d) : "v"(a), "v"(b)); return d; }
__device__ __forceinline__ float ffma_(float a, float b, float c) { float d; asm("v_fma_f32 %0, %1, %2, %3" : "=v"(d) : "v"(a), "v"(b), "v"(c)); return d; }
__device__ __forceinline__ float row16_sum_asm(float x) {
    float d;
    asm("s_nop 1\n\tv_add_f32_dpp %0, %1, %1 quad_perm:[1,0,3,2] row_mask:0xf bank_mask:0xf\n\t"
        "s_nop 1\n\tv_add_f32_dpp %0, %0, %0 quad_perm:[2,3,0,1] row_mask:0xf bank_mask:0xf\n\t"
        "s_nop 1\n\tv_add_f32_dpp %0, %0, %0 row_half_mirror row_mask:0xf bank_mask:0xf\n\t"
        "s_nop 1\n\tv_add_f32_dpp %0, %0, %0 row_mirror row_mask:0xf bank_mask:0xf" : "=&v"(d) : "v"(x));
    return d;
}
constexpr int SC_STEPS = 32, SC_ROW = 336;
__device__ __forceinline__ void scan_block(const Params& p, unsigned char* lds, int sb) {
    const int tid = threadIdx.x, lane = tid & 63, wave = __builtin_amdgcn_readfirstlane(tid >> 6);
    unsigned char* ws = p.ws;
    const bf16_t* ALR = (const bf16_t*)(ws + WS_ALR); const bf16_t* E = (const bf16_t*)(ws + WS_E);
    bf16_t* Y = (bf16_t*)((unsigned char*)p.out + OUT_VT);
    const int xi_ = sb >> 3, quarter = xi_ & 3, bh = (sb & 7) + 8 * (xi_ >> 2), b = bh >> 3, h = bh & 7;
    float* buf = (float*)lds;
    float* ybuf = (float*)(lds + 2 * SC_STEPS * SC_ROW * 4);
    const size_t rowbase = (size_t)b * SEQ;
    constexpr int NCH = SEQ / SC_STEPS;
    if (wave >= 4) {
        const int lt = tid - 256, st_tok = lt >> 3, st_c = lt & 7;
        const bf16_t* ZR = (const bf16_t*)(ws + WS_ZR); float* SBON = (float*)(ws + WS_SBON);
        const int hc = h * 64 + st_c * 8;
        float mur[8], muk[8], muv[8], kkw[8], kaw[8], rkw[8];
#pragma unroll
        for (int i = 0; i < 8; ++i) { mur[i] = p.in[I_MU][hc + i]; muk[i] = p.in[I_MU][512 + hc + i]; muv[i] = p.in[I_MU][1024 + hc + i]; kkw[i] = p.in[I_KK][hc + i]; kaw[i] = p.in[I_KA][hc + i]; rkw[i] = p.in[I_RK][hc + i]; }
        u32x4 Pr, Pk, Pv, Ppr, Ppk, Ppv, Pa, Pe, Qr, Qk, Qv, Qpr, Qpk, Qpv, Qa, Qe;
#define SC_LOAD(X, ch) do { const int s_ = (ch) * SC_STEPS + st_tok; const bf16_t* zr_ = ZR + (rowbase + s_) * 2048 + hc; \
        X##r = *(const u32x4*)(zr_); X##k = *(const u32x4*)(zr_ + 512); X##v = *(const u32x4*)(zr_ + 1024); \
        if (s_ > 0) { X##pr = *(const u32x4*)(zr_ - 2048); X##pk = *(const u32x4*)(zr_ - 2048 + 512); X##pv = *(const u32x4*)(zr_ - 2048 + 1024); } \
        else { X##pr = (u32x4){0u, 0u, 0u, 0u}; X##pk = X##pr; X##pv = X##pr; } \
        const size_t o_ = (((size_t)bh * SEQ) + s_) * 64 + st_c * 8; X##a = *(const u32x4*)(ALR + o_); X##e = *(const u32x4*)(E + o_); } while (0)
#define SC_STORE(X, ch) do { float* bq = buf + ((ch) & 1) * SC_STEPS * SC_ROW; \
        float fr_[8], fk_[8], fv_[8], fp_[8], fa_[8], fe_[8], fkk_[8], fkm_[8]; \
        unpack8(X##r, fr_); unpack8(X##pr, fp_); _Pragma("unroll") for (int i_ = 0; i_ < 8; ++i_) fr_[i_] = fr_[i_] + mur[i_] * (fp_[i_] - fr_[i_]); \
        unpack8(X##k, fk_); unpack8(X##pk, fp_); _Pragma("unroll") for (int i_ = 0; i_ < 8; ++i_) fk_[i_] = fk_[i_] + muk[i_] * (fp_[i_] - fk_[i_]); \
        unpack8(X##v, fv_); unpack8(X##pv, fp_); _Pragma("unroll") for (int i_ = 0; i_ < 8; ++i_) fv_[i_] = fv_[i_] + muv[i_] * (fp_[i_] - fv_[i_]); \
        unpack8(X##a, fa_); unpack8(X##e, fe_); \
        float ss_ = 0.f, sb_ = 0.f; \
        _Pragma("unroll") for (int i_ = 0; i_ < 8; ++i_) { fkk_[i_] = fk_[i_] * kkw[i_]; ss_ += fkk_[i_] * fkk_[i_]; fkm_[i_] = fk_[i_] * (1.f + (fa_[i_] - 1.f) * kaw[i_]); sb_ += fr_[i_] * fkm_[i_] * rkw[i_]; } \
        ss_ += __shfl_xor(ss_, 1); ss_ += __shfl_xor(ss_, 2); ss_ += __shfl_xor(ss_, 4); \
        sb_ += __shfl_xor(sb_, 1); sb_ += __shfl_xor(sb_, 2); sb_ += __shfl_xor(sb_, 4); \
        const float inv_ = 1.f / fmaxf(sqrtf(ss_), 1e-12f); \
        _Pragma("unroll") for (int i_ = 0; i_ < 8; ++i_) fkk_[i_] *= inv_; \
        if (quarter == 0 && st_c == 0) SBON[(rowbase + (size_t)(ch) * SC_STEPS + st_tok) * 8 + h] = sb_; \
        { float* q = bq + st_tok * SC_ROW + st_c * 8; f32x4 o0, o1; \
          o0 = (f32x4){fr_[0], fr_[1], fr_[2], fr_[3]}; o1 = (f32x4){fr_[4], fr_[5], fr_[6], fr_[7]}; *(f32x4*)(q) = o0; *(f32x4*)(q + 4) = o1; \
          o0 = (f32x4){__expf(-fe_[0]), __expf(-fe_[1]), __expf(-fe_[2]), __expf(-fe_[3])}; o1 = (f32x4){__expf(-fe_[4]), __expf(-fe_[5]), __expf(-fe_[6]), __expf(-fe_[7])}; *(f32x4*)(q + 64) = o0; *(f32x4*)(q + 68) = o1; \
          o0 = (f32x4){fkm_[0], fkm_[1], fkm_[2], fkm_[3]}; o1 = (f32x4){fkm_[4], fkm_[5], fkm_[6], fkm_[7]}; *(f32x4*)(q + 128) = o0; *(f32x4*)(q + 132) = o1; \
          o0 = (f32x4){-fkk_[0], -fkk_[1], -fkk_[2], -fkk_[3]}; o1 = (f32x4){-fkk_[4], -fkk_[5], -fkk_[6], -fkk_[7]}; *(f32x4*)(q + 192) = o0; *(f32x4*)(q + 196) = o1; \
          o0 = (f32x4){fkk_[0] * fa_[0], fkk_[1] * fa_[1], fkk_[2] * fa_[2], fkk_[3] * fa_[3]}; o1 = (f32x4){fkk_[4] * fa_[4], fkk_[5] * fa_[5], fkk_[6] * fa_[6], fkk_[7] * fa_[7]}; *(f32x4*)(q + 256) = o0; *(f32x4*)(q + 260) = o1; } \
        if ((st_c >> 1) == quarter) { float* q = bq + st_tok * SC_ROW + 320 + (st_c & 1) * 8; \
          *(f32x4*)(q) = (f32x4){fv_[0], fv_[1], fv_[2], fv_[3]}; *(f32x4*)(q + 4) = (f32x4){fv_[4], fv_[5], fv_[6], fv_[7]}; } } while (0)
#define SC_FLUSH(ch) do { const float* yq = ybuf + ((ch) & 1) * 512; const int tk = lt >> 3, r2 = (lt & 7) * 2; \
        f32x2 o; o.x = yq[r2 * 32 + tk]; o.y = yq[(r2 + 1) * 32 + tk]; \
        *(unsigned*)(Y + (rowbase + (size_t)(ch) * SC_STEPS + tk) * 512 + h * 64 + quarter * 16 + r2) = cvt_pk_bf16(o.x, o.y); } while (0)
        SC_LOAD(Q, 0); SC_STORE(Q, 0); SC_LOAD(P, 1); SC_LOAD(Q, 2);
        __syncthreads();
        for (int ch = 0; ch < NCH; ch += 2) {
            SC_STORE(P, ch + 1);
            if (ch + 3 < NCH) SC_LOAD(P, ch + 3);
            if (ch >= 1) SC_FLUSH(ch - 1);
            __syncthreads();
            if (ch + 2 < NCH) SC_STORE(Q, ch + 2);
            if (ch + 4 < NCH) SC_LOAD(Q, ch + 4);
            SC_FLUSH(ch);
            __syncthreads();
        }
        SC_FLUSH(NCH - 1);
#undef SC_LOAD
#undef SC_STORE
#undef SC_FLUSH
    } else {
        __syncthreads();
        const int c = lane & 15, rowq = wave * 4 + (lane >> 4);
#define SC_LDG(X, base) do { _Pragma("unroll") for (int u_ = 0; u_ < 2; ++u_) { const float* q_ = (base) + u_ * SC_ROW; \
            X##r[u_] = *(const f32x4*)(q_ + 4 * c); X##w[u_] = *(const f32x4*)(q_ + 64 + 4 * c); X##k[u_] = *(const f32x4*)(q_ + 128 + 4 * c); \
            X##a[u_] = *(const f32x4*)(q_ + 192 + 4 * c); X##b[u_] = *(const f32x4*)(q_ + 256 + 4 * c); X##v[u_] = q_[320 + rowq]; } } while (0)
#define SC_STEP(Xa, Xb, Xw, Xk, Xv, RP, yprev) do { float dA_, dB_, vk0_, vk1_, vk2_, vk3_; \
        asm volatile("v_mul_f32_e32 %0, %2, %6\n\tv_mul_f32_e32 %1, %2, %10\n\t" \
                     "v_fma_f32 %0, %3, %7, %0\n\tv_fma_f32 %1, %3, %11, %1\n\t" \
                     "v_fma_f32 %0, %4, %8, %0\n\tv_fma_f32 %1, %4, %12, %1\n\t" \
                     "v_fma_f32 %0, %5, %9, %0\n\tv_fma_f32 %1, %5, %13, %1" \
                     : "=&v"(dA_), "=&v"(dB_) \
                     : "v"(s0), "v"(s1), "v"(s2), "v"(s3), "v"(Xa[0]), "v"(Xa[1]), "v"(Xa[2]), "v"(Xa[3]), "v"(RP[0]), "v"(RP[1]), "v"(RP[2]), "v"(RP[3])); \
        asm volatile("v_mul_f32_e32 %2, %6, %10\n\t" \
                     "v_add_f32_dpp %0, %0, %0 quad_perm:[1,0,3,2] row_mask:0xf bank_mask:0xf\n\tv_add_f32_dpp %1, %1, %1 quad_perm:[1,0,3,2] row_mask:0xf bank_mask:0xf\n\t" \
                     "v_mul_f32_e32 %3, %7, %10\n\t" \
                     "v_add_f32_dpp %0, %0, %0 quad_perm:[2,3,0,1] row_mask:0xf bank_mask:0xf\n\tv_add_f32_dpp %1, %1, %1 quad_perm:[2,3,0,1] row_mask:0xf bank_mask:0xf\n\t" \
                     "v_mul_f32_e32 %4, %8, %10\n\t" \
                     "v_add_f32_dpp %0, %0, %0 row_half_mirror row_mask:0xf bank_mask:0xf\n\tv_add_f32_dpp %1, %1, %1 row_half_mirror row_mask:0xf bank_mask:0xf\n\t" \
                     "v_mul_f32_e32 %5, %9, %10\n\t" \
                     "v_add_f32_dpp %0, %0, %0 row_mirror row_mask:0xf bank_mask:0xf\n\tv_add_f32_dpp %1, %1, %1 row_mirror row_mask:0xf bank_mask:0xf" \
                     : "+v"(dA_), "+v"(dB_), "=&v"(vk0_), "=&v"(vk1_), "=&v"(vk2_), "=&v"(vk3_) \
                     : "v"(Xk[0]), "v"(Xk[1]), "v"(Xk[2]), "v"(Xk[3]), "v"(Xv)); \
        asm volatile("v_fma_f32 %4, %8, %9, %4\n\tv_fma_f32 %5, %8, %10, %5\n\tv_fma_f32 %6, %8, %11, %6\n\tv_fma_f32 %7, %8, %12, %7\n\t" \
                     "v_fma_f32 %0, %0, %13, %4\n\tv_fma_f32 %1, %1, %14, %5\n\tv_fma_f32 %2, %2, %15, %6\n\tv_fma_f32 %3, %3, %16, %7" \
                     : "+v"(s0), "+v"(s1), "+v"(s2), "+v"(s3), "+v"(vk0_), "+v"(vk1_), "+v"(vk2_), "+v"(vk3_) \
                     : "v"(dA_), "v"(Xb[0]), "v"(Xb[1]), "v"(Xb[2]), "v"(Xb[3]), "v"(Xw[0]), "v"(Xw[1]), "v"(Xw[2]), "v"(Xw[3])); \
        yprev = dB_; } while (0)
#define SC_CMP(X, j0) do { _Pragma("unroll") for (int u_ = 0; u_ < 2; ++u_) { float yp_; \
            SC_STEP(X##a[u_], X##b[u_], X##w[u_], X##k[u_], X##v[u_], rp, yp_); rp = X##r[u_]; \
            ykeep = ((((j0) + u_ + 31) & 15) == c) ? yp_ : ykeep; if (((j0) + u_) == 16) yb[c] = ykeep; } } while (0)
        float s0 = 0.f, s1 = 0.f, s2 = 0.f, s3 = 0.f;
        f32x4 rp = {0.f, 0.f, 0.f, 0.f}; float ykeep = 0.f;
        f32x4 Ar[2], Aw[2], Ak[2], Aa[2], Ab[2], Br[2], Bw[2], Bk[2], Ba[2], Bb[2]; float Av[2], Bv[2];
        for (int ch = 0; ch < NCH; ++ch) {
            const float* bp = buf + (ch & 1) * SC_STEPS * SC_ROW; float* yb = ybuf + (ch & 1) * 512 + rowq * 32;
            SC_LDG(A, bp);
#pragma unroll 2
            for (int g = 0; g < 16; g += 2) {
                SC_LDG(B, bp + (g + 1) * 2 * SC_ROW);
                __builtin_amdgcn_sched_barrier(0);
                SC_CMP(A, 2 * g);
                __builtin_amdgcn_sched_barrier(0);
                if (g + 2 < 16) SC_LDG(A, bp + (g + 2) * 2 * SC_ROW);
                __builtin_amdgcn_sched_barrier(0);
                SC_CMP(B, 2 * g + 2);
                __builtin_amdgcn_sched_barrier(0);
            }
            { const float y_ = row16_sum_asm(fadd_(ffma_(s1, rp[1], fmul_(s0, rp[0])), ffma_(s3, rp[3], fmul_(s2, rp[2])))); ykeep = (c == 15) ? y_ : ykeep; yb[16 + c] = ykeep; }
            __syncthreads();
        }
#undef SC_LDG
#undef SC_CMP
#undef SC_STEP
    }
    __syncthreads();
}

__device__ __forceinline__ int crow(int r, int hi) { return (r & 3) + 8 * (r >> 2) + 4 * hi; }
constexpr int AT_KROW = 144, AT_VROW = 144, AT_KB = 64 * AT_KROW, AT_VB = 64 * AT_VROW;
constexpr int AT_K0 = 0, AT_V0 = 4 * AT_KB, AT_KM = 4 * AT_KB + 4 * AT_VB;
typedef short tr4_t __attribute__((ext_vector_type(4)));
typedef __attribute__((address_space(3))) tr4_t tr4_lds_t;
typedef __attribute__((address_space(3))) const char* tr_lds_cptr;
__device__ __forceinline__ void attn_unit(const Params& p, unsigned char* lds, int bh, int qb) {
    const int tid = threadIdx.x, lane = tid & 63, wave = __builtin_amdgcn_readfirstlane(tid >> 6), q = lane & 31, hi = lane >> 5;
    const int b = bh >> 3, h = bh & 7;
    const bf16_t* Kp = (const bf16_t*)((const unsigned char*)p.out + OUT_KP);
    const bf16_t* ZMv = (const bf16_t*)(p.ws + WS_ZM); bf16_t* YB = (bf16_t*)p.out;
    const float* KMEAN = (const float*)(p.ws + WS_KMEAN);
    const int ld_r = tid >> 3, ld_c = tid & 7;
    const bf16_t* kbase = Kp + ((size_t)b * SEQ + ld_r) * 512 + h * 64 + ld_c * 8;
    const bf16_t* vbase = ZMv + ((size_t)b * SEQ + ld_r) * 1536 + 1024 + h * 64 + ld_c * 8;
    const int NT = 4 * (qb + 1);
    u32x4 kreg = *(const u32x4*)(kbase), vreg = *(const u32x4*)(vbase), kreg2 = *(const u32x4*)(kbase + (size_t)64 * 512), vreg2 = *(const u32x4*)(vbase + (size_t)64 * 1536);
    float* km = (float*)(lds + AT_KM);
    const float km0 = KMEAN[(size_t)bh * 1024 + tid], km1 = KMEAN[(size_t)bh * 1024 + 512 + tid];
    const size_t qrow = (size_t)b * SEQ + qb * 256 + wave * 32 + q;
    bf16x8 qf[4];
    {
        float qn[32]; u32x4 qraw[4];
#pragma unroll
        for (int kk = 0; kk < 4; ++kk) qraw[kk] = *(const u32x4*)(ZMv + qrow * 1536 + h * 64 + 16 * kk + 8 * hi);
        const int qpos = ((const int*)p.in[I_POS])[qrow];
        km[tid] = km0; km[512 + tid] = km1;
#pragma unroll
        for (int kk = 0; kk < 4; ++kk) unpack8(qraw[kk], qn + 8 * kk);
        float ssq_ = 0.f;
#pragma unroll
        for (int e = 0; e < 32; ++e) ssq_ += qn[e] * qn[e];
        ssq_ += __shfl_xor(ssq_, 32);
        const float rq = rsqrtf(ssq_ * (1.f / 64.f) + 1e-6f);
        const float* qg = p.in[I_QNG];
#pragma unroll
        for (int kk = 0; kk < 4; ++kk)
#pragma unroll
            for (int e = 0; e < 8; ++e) qn[kk * 8 + e] = qn[kk * 8 + e] * rq * qg[16 * kk + 8 * hi + e];
        const float rvh[8] = {0.15915493667125702f, 0.030863763764500618f, 0.005985185503959656f, 0.0011606636689975858f, 0.0002250790857942775f, 4.3647953134495765e-05f, 8.464330676360987e-06f, 1.6414262518082978e-06f};
        const float rvl[8] = {6.4206382432985265e-09f, -6.060805191054897e-10f, 1.7242327010613678e-10f, -4.8028716420622786e-11f, -6.753226016592562e-12f, 1.6772382094298877e-12f, -1.2670839041623722e-13f, -9.854460929453572e-15f};
        const float ps = (float)qpos;
#pragma unroll
        for (int e = 0; e < 8; ++e) { const float hi_ = ps * rvh[e], lo_ = fmaf(ps, rvh[e], -hi_) + ps * rvl[e]; const float fx = (hi_ - floorf(hi_)) + lo_;
            const float sn_ = __builtin_amdgcn_sinf(fx), cs_ = __builtin_amdgcn_cosf(fx); const float other = __shfl_xor(qn[e], 32);
            qn[e] = qn[e] * cs_ + (hi ? other : -other) * sn_; }
#pragma unroll
        for (int kk = 0; kk < 4; ++kk) { const u32x4 w = pack8(qn + 8 * kk); qf[kk] = __builtin_bit_cast(bf16x8, w); }
    }
#define AT_PUT(slot, kr, vr) do { *(u32x4*)(lds + AT_K0 + (slot) * AT_KB + ld_r * AT_KROW + ld_c * 16) = (kr); *(u32x4*)(lds + AT_V0 + (slot) * AT_VB + ld_r * AT_VROW + ld_c * 16) = (vr); } while (0)
    AT_PUT(0, kreg, vreg); AT_PUT(1, kreg2, vreg2);
    __syncthreads();
    unsigned mask = 0u; float mc = 0.f;
    {
        float qv[32];
#pragma unroll
        for (int kk = 0; kk < 4; ++kk)
#pragma unroll
            for (int e = 0; e < 8; ++e) qv[kk * 8 + e] = __uint_as_float(((unsigned)(unsigned short)qf[kk][e]) << 16);
        { float qq = 0.f;
#pragma unroll
          for (int e = 0; e < 32; ++e) qq += qv[e] * qv[e];
          qq += __shfl_xor(qq, 32); mc = sqrtf(qq) * (10.f / 8.f) * 1.4426950408889634f; }
        float g[15];
#pragma unroll
        for (int j = 0; j < 15; ++j) { float s = 0.f;
#pragma unroll
            for (int kk = 0; kk < 4; ++kk)
#pragma unroll
                for (int e = 0; e < 8; ++e) s += qv[kk * 8 + e] * km[j * 64 + 16 * kk + 8 * hi + e];
            s += __shfl_xor(s, 32); g[j] = (j < qb) ? s : -INFINITY; }
#pragma unroll
        for (int pass = 0; pass < 3; ++pass) { float m = g[0]; int idx = 0;
#pragma unroll
            for (int j = 1; j < 15; ++j) if (g[j] > m) { m = g[j]; idx = j; }
            if (m > -INFINITY) mask |= 1u << idx;
#pragma unroll
            for (int j = 0; j < 15; ++j) if (j == idx) g[j] = -INFINITY; }
    }
    const float C = 0.125f * 1.4426950408889634f;
    float l = 0.f;
    f32x16 O0 = {}, O1 = {};
    const int qrel = 32 * wave + q;
    for (int i2 = 0; i2 < NT; i2 += 2) {
        if (i2 + 2 < NT) { const size_t adv = (size_t)(i2 + 2) * 64; kreg = *(const u32x4*)(kbase + adv * 512); vreg = *(const u32x4*)(vbase + adv * 1536);
            kreg2 = *(const u32x4*)(kbase + (adv + 64) * 512); vreg2 = *(const u32x4*)(vbase + (adv + 64) * 1536); }
#pragma unroll 1
      for (int sub = 0; sub < 2; ++sub) { const int i = i2 + sub;
        const int j = i >> 2, kt = i & 3;
        const unsigned char* Kb = lds + AT_K0 + (i & 3) * AT_KB; tr_lds_cptr Vb3 = (tr_lds_cptr)lds + AT_V0 + (i & 3) * AT_VB;
        const bool own = (j == qb);
        const bool act = own ? true : ((mask >> j) & 1u);
        const bool wave_on = own ? (64 * kt <= 32 * wave + 31) : (__ballot(act) != 0ull);
        if (wave_on) {
            f32x16 s0 = {}, s1 = {};
#pragma unroll
            for (int kk = 0; kk < 4; ++kk) {
                const bf16x8 k0 = *(const bf16x8*)(Kb + q * AT_KROW + (16 * kk + 8 * hi) * 2);
                const bf16x8 k1 = *(const bf16x8*)(Kb + (q + 32) * AT_KROW + (16 * kk + 8 * hi) * 2);
                s0 = __builtin_amdgcn_mfma_f32_32x32x16_bf16(k0, qf[kk], s0, 0, 0, 0);
                s1 = __builtin_amdgcn_mfma_f32_32x32x16_bf16(k1, qf[kk], s1, 0, 0, 0);
            }
            if (own) {
#pragma unroll
                for (int r = 0; r < 16; ++r) { const int key = 64 * kt + crow(r, hi); if (key > qrel) s0[r] = -1e30f; if (key + 32 > qrel) s1[r] = -1e30f; }
            } else if (!act) {
#pragma unroll
                for (int r = 0; r < 16; ++r) { s0[r] = -1e30f; s1[r] = -1e30f; }
            }
            float ls = 0.f;
#pragma unroll
            for (int r = 0; r < 16; ++r) { s0[r] = __builtin_amdgcn_exp2f(s0[r] * C - mc); s1[r] = __builtin_amdgcn_exp2f(s1[r] * C - mc); ls += s0[r] + s1[r]; }
            l += ls;
            bf16x8 pf[2][2];
#pragma unroll
            for (int s = 0; s < 2; ++s) {
                u32x4 w0, w1;
                w0.x = cvt_pk_bf16(s0[8 * s + 0], s0[8 * s + 1]); w0.y = cvt_pk_bf16(s0[8 * s + 2], s0[8 * s + 3]); w0.z = cvt_pk_bf16(s0[8 * s + 4], s0[8 * s + 5]); w0.w = cvt_pk_bf16(s0[8 * s + 6], s0[8 * s + 7]);
                w1.x = cvt_pk_bf16(s1[8 * s + 0], s1[8 * s + 1]); w1.y = cvt_pk_bf16(s1[8 * s + 2], s1[8 * s + 3]); w1.z = cvt_pk_bf16(s1[8 * s + 4], s1[8 * s + 5]); w1.w = cvt_pk_bf16(s1[8 * s + 6], s1[8 * s + 7]);
                pf[0][s] = __builtin_bit_cast(bf16x8, w0); pf[1][s] = __builtin_bit_cast(bf16x8, w1);
            }
#pragma unroll
            for (int kh = 0; kh < 2; ++kh)
#pragma unroll
                for (int s = 0; s < 2; ++s) {
                    const int keyq = 32 * kh + 16 * s + 4 * hi + ((lane & 15) >> 2), cb = (16 * ((lane >> 4) & 1) + 4 * (lane & 3)) * 2;
                    const tr4_t a0 = __builtin_amdgcn_ds_read_tr16_b64_v4i16((tr4_lds_t*)(Vb3 + keyq * AT_VROW + cb)), a1 = __builtin_amdgcn_ds_read_tr16_b64_v4i16((tr4_lds_t*)(Vb3 + (keyq + 8) * AT_VROW + cb));
                    const tr4_t c0 = __builtin_amdgcn_ds_read_tr16_b64_v4i16((tr4_lds_t*)(Vb3 + keyq * AT_VROW + cb + 64)), c1 = __builtin_amdgcn_ds_read_tr16_b64_v4i16((tr4_lds_t*)(Vb3 + (keyq + 8) * AT_VROW + cb + 64));
                    const bf16x8 va = {a0[0], a0[1], a0[2], a0[3], a1[0], a1[1], a1[2], a1[3]}, vc = {c0[0], c0[1], c0[2], c0[3], c1[0], c1[1], c1[2], c1[3]};
                    O0 = __builtin_amdgcn_mfma_f32_32x32x16_bf16(va, pf[kh][s], O0, 0, 0, 0);
                    O1 = __builtin_amdgcn_mfma_f32_32x32x16_bf16(vc, pf[kh][s], O1, 0, 0, 0);
                }
        }
      }
        if (i2 + 2 < NT) { AT_PUT((i2 + 2) & 3, kreg, vreg); AT_PUT((i2 + 3) & 3, kreg2, vreg2); }
        __syncthreads();
    }
#undef AT_PUT
    l += __shfl_xor(l, 32);
    const float inv = 1.f / l;
    bf16_t* orow = YB + qrow * 512 + h * 64;
#pragma unroll
    for (int g4 = 0; g4 < 4; ++g4) {
        u32x2 w0, w1;
        w0.x = cvt_pk_bf16(O0[4 * g4 + 0] * inv, O0[4 * g4 + 1] * inv); w0.y = cvt_pk_bf16(O0[4 * g4 + 2] * inv, O0[4 * g4 + 3] * inv);
        w1.x = cvt_pk_bf16(O1[4 * g4 + 0] * inv, O1[4 * g4 + 1] * inv); w1.y = cvt_pk_bf16(O1[4 * g4 + 2] * inv, O1[4 * g4 + 3] * inv);
        *(u32x2*)(orow + 8 * g4 + 4 * hi) = w0; *(u32x2*)(orow + 32 + 8 * g4 + 4 * hi) = w1;
    }
}

__device__ __forceinline__ void phase6(const Params& p) {
    const int tid = threadIdx.x; unsigned char* ws = p.ws;
    const bf16_t* Y = (const bf16_t*)((const unsigned char*)p.out + OUT_VT); const bf16_t* ZR = (const bf16_t*)(ws + WS_ZR); const float* mu = p.in[I_MU]; const bf16_t* G = (const bf16_t*)(ws + WS_G); const float* SBON = (const float*)(ws + WS_SBON);
    bf16_t* YA = (bf16_t*)(ws + WS_YA); const float* ln_g = p.in[I_LNG]; const float* ln_b = p.in[I_LNB];
    const size_t NG = (size_t)T * 64, STR = (size_t)gridDim.x * 512;
    for (size_t idx0 = (size_t)blockIdx.x * 512 + tid; idx0 < NG; idx0 += 4 * STR) {
        f32x4 ya[4][2]; u32x4 rv[4], rpv[4], rg[4]; float sbv[4];
#pragma unroll
        for (int j = 0; j < 4; ++j) { const size_t idx = idx0 + j * STR; const size_t t = idx >> 6; const int c0 = (int)(idx & 63) * 8;
            { const u32x4 yw = *(const u32x4*)(Y + t * 512 + c0); ya[j][0] = (f32x4){bf_lo(yw.x), bf_hi(yw.x), bf_lo(yw.y), bf_hi(yw.y)}; ya[j][1] = (f32x4){bf_lo(yw.z), bf_hi(yw.z), bf_lo(yw.w), bf_hi(yw.w)}; }
            rv[j] = *(const u32x4*)(ZR + t * 2048 + 1024 + c0); rpv[j] = (t & (SEQ - 1)) ? *(const u32x4*)(ZR + (t - 1) * 2048 + 1024 + c0) : (u32x4){0u, 0u, 0u, 0u}; rg[j] = *(const u32x4*)(G + t * 512 + c0); sbv[j] = SBON[t * 8 + (c0 >> 6)]; }
#pragma unroll
        for (int j = 0; j < 4; ++j) { const size_t idx = idx0 + j * STR; const size_t t = idx >> 6; const int c0 = (int)(idx & 63) * 8;
            float y[8] = {ya[j][0][0], ya[j][0][1], ya[j][0][2], ya[j][0][3], ya[j][1][0], ya[j][1][1], ya[j][1][2], ya[j][1][3]};
            float s_ = 0.f;
#pragma unroll
            for (int i = 0; i < 8; ++i) s_ += y[i];
            s_ += __shfl_xor(s_, 1); s_ += __shfl_xor(s_, 2); s_ += __shfl_xor(s_, 4);
            const float mean = s_ * (1.f / 64.f); float q = 0.f;
#pragma unroll
            for (int i = 0; i < 8; ++i) { y[i] -= mean; q += y[i] * y[i]; }
            q += __shfl_xor(q, 1); q += __shfl_xor(q, 2); q += __shfl_xor(q, 4);
            const float rstd = rsqrtf(q * (1.f / 64.f) + 64e-5f);
            float v[8], pv_[8], g[8]; unpack8(rv[j], v); unpack8(rpv[j], pv_); unpack8(rg[j], g);
#pragma unroll
            for (int i = 0; i < 8; ++i) v[i] = v[i] + mu[1024 + c0 + i] * (pv_[i] - v[i]);
#pragma unroll
            for (int i = 0; i < 8; ++i) y[i] = (y[i] * rstd * ln_g[c0 + i] + ln_b[c0 + i] + sbv[j] * v[i]) * g[i];
            *(u32x4*)(YA + t * 512 + c0) = pack8(y); }
    }
}

__device__ __forceinline__ void phase10(const Params& p, bool dry) {
    const int tid = threadIdx.x; bf16_t* U = (bf16_t*)(p.ws + WS_U);
    const float* cw = p.in[I_CW]; const float* cb = p.in[I_CB];
    const size_t NG = (size_t)(T / 64) * 352;
    for (size_t idx = (size_t)blockIdx.x * 512 + tid; idx < NG; idx += (size_t)gridDim.x * 512) {
        const size_t tq = idx / 352; const int c0 = (int)(idx - tq * 352) * 8; const size_t t0 = tq * 64; const int s0 = (int)(t0 & (SEQ - 1));
        u32x4 ra[4], rb[2];
#pragma unroll
        for (int j = 0; j < 4; ++j) { if (j >= 2 || s0 > 0) ra[j] = *(const u32x4*)(U + (t0 + j - 2) * NPROJ + c0); else ra[j] = (u32x4){0u, 0u, 0u, 0u}; }
#pragma unroll
        for (int j = 0; j < 2; ++j) rb[j] = *(const u32x4*)(U + (t0 + j) * NPROJ + DFF + c0);
        float w0[8], w1[8], w2[8], bs[8];
#pragma unroll
        for (int i = 0; i < 8; ++i) { w0[i] = cw[c0 + i]; w1[i] = cw[DFF + c0 + i]; w2[i] = cw[2 * DFF + c0 + i]; bs[i] = cb[c0 + i]; }
        float a2[8], a1[8], a0[8];
        unpack8(ra[0], a2); unpack8(ra[1], a1);
#pragma unroll
        for (int j = 0; j < 2; ++j) {
            float bv[8], o[8]; unpack8(ra[j + 2], a0); unpack8(rb[j], bv);
#pragma unroll
            for (int i = 0; i < 8; ++i) { const float v = w0[i] * a2[i] + w1[i] * a1[i] + w2[i] * a0[i] + bs[i]; o[i] = gelu_erf(v) * bv[i]; a2[i] = a1[i]; a1[i] = a0[i]; }
            if (!dry) *(u32x4*)(U + (t0 + j) * NPROJ + DFF + c0) = pack8(o);
        }
    }
}

#define LAS __attribute__((address_space(3)))
#define XB_TMO      128
#define XB_XCNT(j)  (256  + 64 * (j))
#define XB_XSUB(j)  (1280 + 64 * (j))
#define XB_XGEN(j)  (2304 + 64 * (j))
#define XB_TOP      3328
#define XB_TOPGEN   3392
#define XCD_BAR_WORDS 3456
#define XB_SPIN_CAP (1u << 20)
__device__ __forceinline__ unsigned xb_ld(unsigned* p)              { return __hip_atomic_load(p, __ATOMIC_RELAXED, __HIP_MEMORY_SCOPE_AGENT); }
__device__ __forceinline__ unsigned xb_add(unsigned* p, unsigned v) { return __hip_atomic_fetch_add(p, v, __ATOMIC_RELAXED, __HIP_MEMORY_SCOPE_AGENT); }
__device__ __forceinline__ unsigned xb_xcc_id() { return (unsigned)__builtin_amdgcn_s_getreg((3 << 11) | 20) & 0xFu; }
#define XB_SPIN(cond, bar) do { unsigned _sp = 0; while (cond) { __builtin_amdgcn_s_sleep(1); \
    if ((++_sp & 255u) == 0u) { if (xb_ld(&(bar)[XB_TMO])) break; if (_sp > XB_SPIN_CAP) { atomicAdd(&(bar)[XB_TMO], 1u); break; } } } } while (0)
struct XcdBarrier { unsigned* bar; unsigned x; volatile LAS unsigned* st; };
__device__ __forceinline__ XcdBarrier xcd_barrier_post(unsigned* bar, volatile LAS unsigned* st) {
    XcdBarrier b; b.bar = bar; b.x = xb_xcc_id(); b.st = st;
    if (threadIdx.x == 0) (void)xb_add(&bar[XB_XCNT(b.x)], 1u);
    return b;
}
__device__ __forceinline__ void xcd_barrier_complete(unsigned* bar, unsigned x, unsigned& nloc, unsigned& nx) {
    const unsigned G = gridDim.x * gridDim.y * gridDim.z;
    unsigned sum, cnt, mine, sp = 0u;
    for (;;) {
        sum = 0u; cnt = 0u; mine = 0u;
#pragma unroll
        for (unsigned j = 0; j < 16; ++j) { const unsigned c = xb_ld(&bar[XB_XCNT(j)]); sum += c; cnt += (c > 0u) ? 1u : 0u; mine = (j == x) ? c : mine; }
        if (sum == G) break;
        __builtin_amdgcn_s_sleep(1);
        if ((++sp & 255u) == 0u) { if (xb_ld(&bar[XB_TMO])) break; if (sp > XB_SPIN_CAP) { atomicAdd(&bar[XB_TMO], 1u); break; } }
    }
    nloc = mine > 0u ? mine : 1u; nx = cnt > 0u ? cnt : 1u;
}
__device__ __forceinline__ void xcd_barrier(const XcdBarrier& b) {
    asm volatile("s_waitcnt vmcnt(0)" ::: "memory");
    __syncthreads();
    if (threadIdx.x == 0) {
        unsigned* bar = b.bar;
        __builtin_amdgcn_s_waitcnt(0);
        unsigned nloc = b.st[0], nx = b.st[1];
        if (nloc == 0u) { xcd_barrier_complete(bar, b.x, nloc, nx); b.st[0] = nloc; b.st[1] = nx; }
        const unsigned old = xb_add(&bar[XB_XSUB(b.x)], 1u);
        const unsigned gen = old / nloc;
        if (old + 1u == (gen + 1u) * nloc) {
            __builtin_amdgcn_fence(__ATOMIC_RELEASE, "agent");
            asm volatile("s_waitcnt vmcnt(0)" ::: "memory");
            const unsigned og = xb_add(&bar[XB_TOP], 1u);
            const unsigned tg = og / nx;
            if (og + 1u == (tg + 1u) * nx) xb_add(&bar[XB_TOPGEN], 1u);
            else XB_SPIN(xb_ld(&bar[XB_TOPGEN]) == tg, bar);
            __builtin_amdgcn_fence(__ATOMIC_ACQUIRE, "agent");
            xb_add(&bar[XB_XGEN(b.x)], 1u);
            asm volatile("s_waitcnt vmcnt(0)" ::: "memory");
        } else {
            XB_SPIN(xb_ld(&bar[XB_XGEN(b.x)]) == gen, bar);
            __builtin_amdgcn_fence(__ATOMIC_ACQUIRE, "agent");
            asm volatile("s_waitcnt vmcnt(0)" ::: "memory");
        }
    }
    __syncthreads();
}

#ifndef PROBE_DRY1
#define PROBE_DRY1 0
#endif
#ifndef PROBE_P2PARTS
#define PROBE_P2PARTS 3
#endif
constexpr int NPHASE = 12;
__global__ void __launch_bounds__(512, 2) hybrid_fwd(Params p) {
    extern __shared__ __attribute__((aligned(16))) unsigned char lds[];
    cg::grid_group grid = cg::this_grid();
    PG8_LAS unsigned char* lds3 = (PG8_LAS unsigned char*)lds;
    unsigned char* ws = p.ws;
    const int G = gridDim.x, bx = blockIdx.x;
    const int lo = p.lo, hi = p.hi;
#ifndef PH_MASK
#define PH_MASK 0xFFF
#endif
#define IN(k) (((PH_MASK >> (k)) & 1) && lo <= (k) && (k) < hi)
    if (threadIdx.x < 16) ((volatile LAS unsigned*)(lds3 + LDS_MISC))[16 + threadIdx.x] = 0u;
    __syncthreads();
    const XcdBarrier xbar = xcd_barrier_post((unsigned*)(ws + WS_CTL) + 1024, (volatile LAS unsigned*)(lds3 + LDS_MISC) + 16);
#define RLOOP(k) _Pragma("unroll 1") for (int r_ = 0; r_ < p.rep[k]; ++r_)
#define SEAM(k) do { if (IN(k) && IN((k) + 1)) { if ((k) == 0 && lo < 0) grid.sync(); else xcd_barrier(xbar); } } while (0)
#ifndef REP_EW
#define REP_EW 1
#endif
    if (IN(0)) { RLOOP(0) phase0(p, lds); } SEAM(0);
    if (IN(1)) {
        pg8::Gemm g{(const bf16_t*)(ws + WS_HB), (const bf16_t*)(ws + WS_WIN), T, NPROJ, 1024, 1024, 1024}; pg8::StaticOrder S; S.init(T, NPROJ, G, bx);
        RLOOP(1) { EpiProj E{(bf16_t*)(ws + WS_ZR), (bf16_t*)(ws + WS_ZM), (bf16_t*)(ws + WS_GP), (bf16_t*)((unsigned char*)p.out + OUT_LA), p.in[I_MU], PROBE_DRY1 && (r_ + 1 < p.rep[1])}; pg8::gemm_phase<EpiProj, true>(lds3, g, S, E); }
    } SEAM(1);
    if (IN(2)) { RLOOP(2) phase2(p, lds, r_ == 0 ? 3 : PROBE_P2PARTS); } SEAM(2);
    if (IN(3)) {
        const bf16_t* LA = (const bf16_t*)((const unsigned char*)p.out + OUT_LA);
        RLOOP(3)
#pragma unroll 1
        for (int w = 0; w < 3; ++w) {
            const bf16_t* Bt = (const bf16_t*)(ws + (w == 0 ? WS_WD : (w == 1 ? WS_WA : WS_WG)));
            bf16_t* O = (bf16_t*)(ws + (w == 0 ? WS_E : (w == 1 ? WS_ALR : WS_G)));
            const float* bias = w == 0 ? p.in[I_DB] : p.in[I_AB];
            const int Kw = (w == 2) ? 256 : 128;
            pg8::Gemm g{LA + 128 * w, Bt, T, 512, Kw, 512, Kw}; pg8::StaticOrder S; S.init(T, 512, G, bx);
            EpiLora E{O, bias, w};
            pg8::gemm_phase<EpiLora, true>(lds3, g, S, E);
        }
    } do { if (IN(3) && IN(5)) xcd_barrier(xbar); } while (0);
    if (IN(5)) {
#ifndef REP_SCAN
#define REP_SCAN 1
#endif
        RLOOP(5) scan_block(p, lds, bx);
        volatile unsigned* sh = (volatile unsigned*)(lds + LDS_MISC);
#pragma unroll 1
        for (int rep = 0; rep < p.rep[12]; ++rep) {
        unsigned* qctr = (unsigned*)(ws + WS_CTL) + 64 + 64 * rep;
        unsigned u_next = 0u;
        if (threadIdx.x == 0) u_next = atomicAdd(qctr, 1u);
        for (;;) {
            __syncthreads();
            if (threadIdx.x == 0) sh[0] = u_next;
            __syncthreads();
            const unsigned u = sh[0];
            if (u >= 1024u) break;
            if (threadIdx.x == 0) u_next = atomicAdd(qctr, 1u);
            attn_unit(p, lds, (int)(u & 63u), 15 - (int)(u >> 6));
        }
        }
    } SEAM(5);
    if (IN(6)) { RLOOP(6) phase6(p); } SEAM(6);
#pragma unroll 1
    for (int r_ = 0; r_ < p.rep[13]; ++r_) xcd_barrier(xbar);

    if (IN(7)) {
        const bf16_t* GP = (const bf16_t*)(ws + WS_GP); bf16_t* MG = (bf16_t*)(ws + WS_MG);
#pragma unroll 1
        for (int w = 0; w < 2 * p.rep[7]; ++w) {
            const int second = w & 1;
            pg8::Gemm g{second ? (const bf16_t*)p.out : (const bf16_t*)(ws + WS_YA), (const bf16_t*)(ws + (second ? WS_WBB : WS_WBA)), T, 1024, 512, 512, 512}; pg8::StaticOrder S; S.init(T, 1024, G, bx);
            EpiBranch E{MG, GP, second}; pg8::gemm_phase<EpiBranch, true>(lds3, g, S, E);
        }
    } SEAM(7);
    if (IN(8)) {
        pg8::Gemm g{(const bf16_t*)(ws + WS_MG), (const bf16_t*)(ws + WS_WOUT), T, 1024, 1024, 1024, 1024}; pg8::StaticOrder S; S.init(T, 1024, G, bx);
        EpiOut E{p.in[I_X], p.out, (bf16_t*)(ws + WS_X1B), (float*)(ws + WS_SSQ)};
        RLOOP(8) pg8::gemm_phase<EpiOut, true>(lds3, g, S, E);
    } SEAM(8);
    if (IN(9)) {
        pg8::Gemm g{(const bf16_t*)(ws + WS_X1B), (const bf16_t*)(ws + WS_WUP), T, NPROJ, 1024, 1024, 1024}; pg8::StaticOrder S; S.init(T, NPROJ, G, bx);
        EpiUp E{(bf16_t*)(ws + WS_U), (const float*)(ws + WS_SSQ), p.in[I_CW], p.in[I_CB]};
        RLOOP(9) pg8::gemm_phase<EpiUp, true>(lds3, g, S, E);
    } SEAM(9);
    if (IN(10)) { RLOOP(10) phase10(p, r_ + 1 < p.rep[10]); } SEAM(10);
    if (IN(11)) {
        pg8::Gemm g{(const bf16_t*)(ws + WS_U) + DFF, (const bf16_t*)(ws + WS_WDN), T, 1024, DFF, NPROJ, DFF}; pg8::StaticOrder S; S.init(T, 1024, G, bx);
        RLOOP(11) { EpiDown E{p.out, (const bf16_t*)(ws + WS_X1B), r_ + 1 < p.rep[11]}; pg8::gemm_phase<EpiDown, true>(lds3, g, S, E); }
    }
#undef IN
#undef SEAM
}

extern "C" void kernel_launch(void* const* d_in, const int* in_sizes, int n_in, void* d_out, int out_size, void* d_ws, size_t ws_size, hipStream_t stream) {
    static int grid = 0;
    if (grid == 0) {
        if (n_in != 25 || out_size != T * DM || ws_size < WS_END) { fprintf(stderr, "kernel_launch: unexpected shapes (n_in %d out %d ws %zu)\n", n_in, out_size, ws_size); grid = -1; return; }
        int dev = 0, cus = 0, per_cu = 0;
        hipGetDevice(&dev); hipDeviceGetAttribute(&cus, hipDeviceAttributeMultiprocessorCount, dev);
        if (hipFuncSetAttribute((const void*)hybrid_fwd, hipFuncAttributeMaxDynamicSharedMemorySize, LDS_BYTES) != hipSuccess) { fprintf(stderr, "kernel_launch: hipFuncSetAttribute failed\n"); grid = -1; return; }
        hipOccupancyMaxActiveBlocksPerMultiprocessor(&per_cu, (const void*)hybrid_fwd, 512, LDS_BYTES);
        (void)hipGetLastError();
        if (per_cu < 1) per_cu = 1;
        grid = cus * per_cu; if (grid > 256) grid = 256;
        if (grid != 256) fprintf(stderr, "kernel_launch: grid %d (expected 256)\n", grid);
    }
    if (grid < 0) return;
    (void)hipMemsetAsync((char*)d_ws + WS_CTL, 0, 65536, stream);
    Params p{};
    for (int i = 0; i < 25; ++i) p.in[i] = (const float*)d_in[i];
    p.out = (float*)d_out; p.ws = (unsigned char*)d_ws;
    for (int i = 0; i < 14; ++i) p.rep[i] = 1;
    p.rep[13] = 0;
#ifdef PROBE_SYNCS
    p.rep[13] = PROBE_SYNCS;
#endif
#ifdef PROBE_PHASE
    p.rep[PROBE_PHASE] = 2;
#endif
#ifdef PROBE_PHASE2
    p.rep[PROBE_PHASE2] = 2;
#endif
#if MK_SPLIT
    for (int ph = 0; ph < NPHASE; ++ph) { p.lo = ph; p.hi = ph + 1; void* args[] = {&p};
        hipError_t e = hipLaunchCooperativeKernel((const void*)hybrid_fwd, dim3(grid), dim3(512), args, LDS_BYTES, stream);
        if (e != hipSuccess) { fprintf(stderr, "cooperative launch (phase %d) failed: %s\n", ph, hipGetErrorString(e)); break; } }
#else
    p.lo = 0; p.hi = NPHASE; void* args[] = {&p};
    hipError_t e = hipLaunchCooperativeKernel((const void*)hybrid_fwd, dim3(grid), dim3(512), args, LDS_BYTES, stream);
    if (e != hipSuccess) fprintf(stderr, "cooperative launch failed: %s (grid %d)\n", hipGetErrorString(e), grid);
#endif
}
```

```cpp
#include <hip/hip_runtime.h>
#include <hip/hip_cooperative_groups.h>
#include <cstdio>
#include <cstdint>
namespace cg = cooperative_groups;

#ifndef MK_SPLIT
#define MK_SPLIT 0
#endif

namespace pg8 {
#define PG8_LAS __attribute__((address_space(3)))
typedef unsigned short bf16_t;
typedef short bf16x8 __attribute__((ext_vector_type(8)));
typedef float f32x4 __attribute__((ext_vector_type(4)));
typedef unsigned u32x4 __attribute__((ext_vector_type(4)));
typedef unsigned u32x2 __attribute__((ext_vector_type(2)));
constexpr int BM = 256, BK = 64, HALF = 128, HTB = HALF * BK * 2, STAGE_BYTES = 8 * HTB, NXCD = 8, WGM = 4;

__host__ __device__ __forceinline__ int lds_byte(int r, int c) { const int st = (r >> 4) * 2 + (c >> 5), rr = r & 15, cc = c & 31, ob = rr * 64 + cc * 2; return st * 1024 + (ob ^ (((ob >> 9) & 1) << 5)); }
__host__ __device__ __forceinline__ void stage_rc(int b, int& R, int& C) { const int st = b / 1024, sb = b % 1024, swz = sb ^ (((sb >> 9) & 1) << 5); R = (st >> 1) * 16 + swz / 64; C = (st & 1) * 32 + (swz % 64) / 2; }
__host__ __device__ __forceinline__ int perm32(int rho) { const int n = rho >> 4, i = rho & 15; return 8 * (i >> 2) + 4 * n + (i & 3); }

struct Unit { int pm, pn; };
struct Gemm { const bf16_t* A; const bf16_t* Bt; int M, N, K, lda, ldb; };

struct StaticOrder {
    int nM, nN, nwg, G, c;
    __host__ __device__ void init(int M, int N, int G_, int c_) { nM = M / BM; nN = N / BM; nwg = nM * nN; G = G_; c = c_; }
    __host__ __device__ bool next(int i, Unit& u) const {
        const long L = (long)i * G + c; if (L >= nwg) return false;
        int wgid = (int)L; { const int q = nwg / NXCD, r = nwg % NXCD, xcd = wgid % NXCD, off = wgid / NXCD; wgid = (xcd < r ? xcd * (q + 1) : r * (q + 1) + (xcd - r) * q) + off; }
        const int nig = WGM * nN, gid = wgid / nig, fm = gid * WGM, gsz = (nM - fm) < WGM ? (nM - fm) : WGM;
        u.pm = fm + ((wgid % nig) % gsz); u.pn = (wgid % nig) / gsz; return true;
    }
};

__device__ __forceinline__ unsigned cvt_pk_bf16(float lo, float hi) { unsigned r; asm volatile("v_cvt_pk_bf16_f32 %0, %1, %2" : "=v"(r) : "v"(lo), "v"(hi)); return r; }

template <class Epi, bool ALIGN_EPI>
__device__ __forceinline__ void gemm_phase(PG8_LAS unsigned char* lds, const Gemm g, const StaticOrder& S, const Epi& E) {
    const int tid = threadIdx.x, wid = __builtin_amdgcn_readfirstlane(tid >> 6), lane = tid & 63, wr = wid >> 2, wc = wid & 3, fr = lane & 15, fq = lane >> 4;
    const int K = g.K, nt = K / BK;
    unsigned voffA[2], voffB[2];
#pragma unroll
    for (int i = 0; i < 2; ++i) { int R, C; stage_rc(tid * 16 + i * 8192, R, C); const int Rb = Epi::PERM ? ((R & ~31) + perm32(R & 31)) : R;
        voffA[i] = (unsigned)(R * g.lda + C) * 2u; voffB[i] = (unsigned)(Rb * g.ldb + C) * 2u; }
    const size_t kstep = (size_t)(BK * 2);
    const size_t hstepA = (size_t)HALF * g.lda * 2, hstepB = (size_t)HALF * g.ldb * 2;
    const size_t tstepA = 2 * hstepA, tstepB = 2 * hstepB;
    const unsigned ldsw = (unsigned)wid * 1024u;
    const int aoff = lds_byte(wr * 64 + fr, fq * 8), boff = lds_byte(wc * 32 + fr, fq * 8);
#define PG8_SA(b, h) (((b) * 2 + (h)) * HTB)
#define PG8_SB(b, h) ((4 + (b) * 2 + (h)) * HTB)
#define PG8_STAGE(bufoff, gbase, voff) do { _Pragma("unroll") for (int _i = 0; _i < 2; ++_i) \
        __builtin_amdgcn_global_load_lds((const unsigned*)((const char*)(gbase) + (voff)[_i]), (PG8_LAS unsigned*)(lds + (bufoff) + ldsw + _i * 8192), 16, 0, 0); } while (0)
#define PG8_LDA(dst, b, h) do { _Pragma("unroll") for (int m = 0; m < 4; ++m) _Pragma("unroll") for (int k = 0; k < 2; ++k) dst[m][k] = *(const PG8_LAS bf16x8*)(lds + PG8_SA(b, h) + aoff + m * 2048 + k * 1024); } while (0)
#define PG8_LDB(dst, b, h) do { _Pragma("unroll") for (int n = 0; n < 2; ++n) _Pragma("unroll") for (int k = 0; k < 2; ++k) dst[n][k] = *(const PG8_LAS bf16x8*)(lds + PG8_SB(b, h) + boff + n * 2048 + k * 1024); } while (0)
#define PG8_MMA(ai, bj, At, Bt) do { __builtin_amdgcn_s_setprio(1); _Pragma("unroll") for (int m = 0; m < 4; ++m) _Pragma("unroll") for (int n = 0; n < 2; ++n) _Pragma("unroll") for (int k = 0; k < 2; ++k) \
        acc[ai][bj][m][n] = __builtin_amdgcn_mfma_f32_16x16x32_bf16(Bt[n][k], At[m][k], acc[ai][bj][m][n], 0, 0, 0); __builtin_amdgcn_s_setprio(0); } while (0)
#define PG8_WAIT_V(n) asm volatile("s_waitcnt vmcnt(" #n ")" ::: "memory")
#define PG8_WAIT_L(n) asm volatile("s_waitcnt lgkmcnt(" #n ")" ::: "memory")
#define PG8_BAR __builtin_amdgcn_s_barrier()
#define PG8_SCHED __builtin_amdgcn_sched_barrier(0)
    Unit cur, nxt; int ui = 0;
    if (!S.next(0, cur)) return;
    f32x4 acc[2][2][4][2];
#pragma unroll
    for (int a = 0; a < 2; ++a)
#pragma unroll
        for (int b = 0; b < 2; ++b)
#pragma unroll
            for (int m = 0; m < 4; ++m)
#pragma unroll
                for (int n = 0; n < 2; ++n) acc[a][b][m][n] = (f32x4){0.f, 0.f, 0.f, 0.f};
    bf16x8 At[4][2], B0[2][2], B1[2][2];
    const char* cA = (const char*)g.A + (size_t)cur.pm * tstepA; const char* cB = (const char*)g.Bt + (size_t)cur.pn * tstepB;
    PG8_STAGE(PG8_SB(0, 0), cB, voffB); PG8_STAGE(PG8_SB(0, 1), cB + hstepB, voffB); PG8_STAGE(PG8_SA(0, 0), cA, voffA); PG8_STAGE(PG8_SA(0, 1), cA + hstepA, voffA);
    if (wr == 1) PG8_BAR;
    PG8_WAIT_V(2); PG8_BAR;
    PG8_STAGE(PG8_SB(1, 0), cB + kstep, voffB); PG8_STAGE(PG8_SA(1, 0), cA + kstep, voffA); PG8_STAGE(PG8_SB(1, 1), cB + hstepB + kstep, voffB);
    PG8_WAIT_V(6); PG8_BAR;
    for (;;) {
        const bool has_next = S.next(ui + 1, nxt);
        const char* nA = has_next ? (const char*)g.A + (size_t)nxt.pm * tstepA : cA; const char* nB = has_next ? (const char*)g.Bt + (size_t)nxt.pn * tstepB : cB;
        for (int t = 0; t < nt; t += 2) {
            const bool last = (t == nt - 2);
            const char* a1 = cA + (size_t)(t + 1) * kstep;
            const char* a2 = last ? nA : cA + (size_t)(t + 2) * kstep; const char* b2 = last ? nB : cB + (size_t)(t + 2) * kstep;
            const char* a3 = a2 + kstep; const char* b3 = b2 + kstep;
            PG8_LDB(B0, 0, 0); PG8_LDB(B1, 0, 1); PG8_SCHED; PG8_LDA(At, 0, 0); PG8_STAGE(PG8_SA(1, 1), a1 + hstepA, voffA);
            PG8_WAIT_V(8); PG8_WAIT_L(0); PG8_BAR; PG8_MMA(0, 0, At, B0); PG8_MMA(0, 1, At, B1); PG8_BAR; PG8_SCHED;
            PG8_LDA(At, 0, 1); PG8_STAGE(PG8_SB(0, 0), b2, voffB); PG8_STAGE(PG8_SB(0, 1), b2 + hstepB, voffB); PG8_STAGE(PG8_SA(0, 0), a2, voffA);
            PG8_WAIT_V(8); PG8_WAIT_L(0); PG8_BAR; PG8_MMA(1, 0, At, B0); PG8_MMA(1, 1, At, B1); PG8_BAR; PG8_SCHED;
            PG8_LDB(B0, 1, 0); PG8_LDB(B1, 1, 1); PG8_SCHED; PG8_LDA(At, 1, 0); PG8_STAGE(PG8_SA(0, 1), a2 + hstepA, voffA);
            PG8_WAIT_V(8); PG8_WAIT_L(0); PG8_BAR; PG8_MMA(0, 0, At, B0); PG8_MMA(0, 1, At, B1); PG8_BAR; PG8_SCHED;
            PG8_LDA(At, 1, 1); PG8_STAGE(PG8_SB(1, 0), b3, voffB); PG8_STAGE(PG8_SB(1, 1), b3 + hstepB, voffB); PG8_STAGE(PG8_SA(1, 0), a3, voffA);
            PG8_WAIT_V(8); PG8_WAIT_L(0); PG8_BAR; PG8_MMA(1, 0, At, B0); PG8_MMA(1, 1, At, B1); PG8_BAR; PG8_SCHED;
        }
        if constexpr (ALIGN_EPI) { if (wr == 0) PG8_BAR; }
        E(acc, cur, wr, wc, fr, fq);
        if (!has_next) break;
#pragma unroll
        for (int a = 0; a < 2; ++a)
#pragma unroll
            for (int b = 0; b < 2; ++b)
#pragma unroll
                for (int m = 0; m < 4; ++m)
#pragma unroll
                    for (int n = 0; n < 2; ++n) acc[a][b][m][n] = (f32x4){0.f, 0.f, 0.f, 0.f};
        cur = nxt; cA = nA; cB = nB; ++ui;
        if constexpr (ALIGN_EPI) { if (wr == 1) PG8_BAR; }
    }
    PG8_WAIT_V(0);
    if constexpr (!ALIGN_EPI) { if (wr == 0) PG8_BAR; }
    PG8_BAR;
#undef PG8_SA
#undef PG8_SB
#undef PG8_STAGE
#undef PG8_LDA
#undef PG8_LDB
#undef PG8_MMA
#undef PG8_WAIT_V
#undef PG8_WAIT_L
#undef PG8_BAR
#undef PG8_SCHED
}
}

using pg8::bf16_t; using pg8::f32x4; using pg8::u32x4; using pg8::u32x2; using pg8::bf16x8; using pg8::cvt_pk_bf16;
typedef float f32x16 __attribute__((ext_vector_type(16)));

constexpr int NB = 8, SEQ = 4096, DM = 1024, T = NB * SEQ;
constexpr int NPROJ = 5632;
constexpr int IN_COLS = 5408, DFF = 2816;
constexpr size_t MiB = 1u << 20;
constexpr size_t WS_CTL = 0;
constexpr size_t WS_WIN = 1 * MiB, WS_WUP = 12 * MiB, WS_WDN = 23 * MiB, WS_WOUT = 29 * MiB, WS_WBA = 31 * MiB, WS_WBB = 32 * MiB;
constexpr size_t WS_WD = 33 * MiB, WS_WA = 33 * MiB + 256 * 1024, WS_WG = 33 * MiB + 512 * 1024;
constexpr size_t WS_KMEAN = 34 * MiB, WS_SBON = 35 * MiB, WS_SSQ = 36 * MiB;
constexpr size_t WS_GP = 38 * MiB, WS_ZR = 166 * MiB, WS_ZM = 294 * MiB, WS_HB = 390 * MiB, WS_EX = 454 * MiB, WS_END = 486 * MiB;
constexpr size_t WS_E = WS_HB, WS_ALR = WS_HB + 32 * MiB, WS_G = WS_EX;
constexpr size_t WS_R = WS_ZM, WS_K = WS_ZM + 32 * MiB, WS_V = WS_ZM + 64 * MiB;
constexpr size_t WS_YA = WS_ZM + 64 * MiB,         WS_MG = WS_ZM, WS_X1B = WS_HB, WS_U = WS_GP;
constexpr size_t OUT_LA = 0, OUT_KK = 0, OUT_Q = 32 * MiB, OUT_KP = 64 * MiB, OUT_VT = 96 * MiB;
constexpr int LDS_BYTES = 147456, LDS_MISC = 131072;

struct Params {
    const float* in[25]; float* out; unsigned char* ws; int lo, hi; int rep[14];
};
enum { I_X = 0, I_POS, I_N1G, I_WIN, I_MU, I_WDU, I_DB, I_WAU, I_AB, I_WGU, I_KK, I_KA, I_RK, I_LNG, I_LNB, I_QNG, I_KNG, I_WBA, I_WBB, I_WOUT, I_N2G, I_WUP, I_CW, I_CB, I_WDN };

__device__ __forceinline__ float bf_lo(unsigned w) { return __uint_as_float(w << 16); }
__device__ __forceinline__ float bf_hi(unsigned w) { return __uint_as_float(w & 0xffff0000u); }
__device__ __forceinline__ void unpack8(const u32x4 w, float* f) { f[0] = bf_lo(w.x); f[1] = bf_hi(w.x); f[2] = bf_lo(w.y); f[3] = bf_hi(w.y); f[4] = bf_lo(w.z); f[5] = bf_hi(w.z); f[6] = bf_lo(w.w); f[7] = bf_hi(w.w); }
__device__ __forceinline__ u32x4 pack8(const float* f) { u32x4 w; w.x = cvt_pk_bf16(f[0], f[1]); w.y = cvt_pk_bf16(f[2], f[3]); w.z = cvt_pk_bf16(f[4], f[5]); w.w = cvt_pk_bf16(f[6], f[7]); return w; }
__device__ __forceinline__ size_t hm_idx(size_t t, int c) { return ((((t >> 12) * 8 + (size_t)(c >> 6)) * 4096 + (t & 4095)) << 6) + (size_t)(c & 63); }
__device__ __forceinline__ float sigmoidf_(float x) { return 1.f / (1.f + __expf(-x)); }
__device__ __forceinline__ float wave_sum(float v) {
#pragma unroll
    for (int o = 1; o < 64; o <<= 1) v += __shfl_xor(v, o);
    return v;
}

__device__ __forceinline__ float gelu_erf(float v) {
    const float av = fabsf(v), t = __builtin_amdgcn_rcpf(av * 0.2316418882f + 1.0f);
    float q = t * 0.5307027145f + (-0.7265760135f); q = q * t + 0.7107068705f; q = q * t + (-0.142248368f); q = q * t + 0.127414796f; q = q * t;
    const float e = __builtin_amdgcn_exp2f((v * v) * (-0.72134752044f));
    const float m = v * (q * e);
    return v < 0.f ? m : v - m;
}
template <int CTRL> __device__ __forceinline__ float dpp_mov0(float x) { return __int_as_float(__builtin_amdgcn_update_dpp(0, __float_as_int(x), CTRL, 0xF, 0xF, false)); }
struct EpiProj {
    static constexpr bool PERM = true;
    bf16_t* zr; bf16_t* zm; bf16_t* gp; bf16_t* la; const float* mu; bool dry;
    __device__ __forceinline__ void operator()(const f32x4 (&acc)[2][2][4][2], const pg8::Unit& u, int wr, int wc, int fr, int fq) const {
        if (u.pn == 6 || u.pn == 7) {
            const int row0 = u.pm * 256 + wr * 64 + fr;
#pragma unroll
            for (int bj = 0; bj < 2; ++bj) {
                const int c = u.pn * 256 + bj * 128 + wc * 32 + 8 * fq;
                const int mode = c < 1600 ? 1 : (c < 1664 ? 0 : (c < 1824 ? 2 : 3));
                const int kq = c - 1824;
                const int dc = c < 1600 ? c - 1536 : (c < 1664 ? c - 1600 + 128 : (c < 1824 ? c - 1664 + 256 : (kq < 64 ? 64 + kq : (kq < 128 ? 192 + (kq - 64) : 416 + (kq - 128)))));
                const int mc_ = mode == 3 ? 0 : c;
                const f32x4 mu0 = *(const f32x4*)(mu + mc_), mu1 = *(const f32x4*)(mu + mc_ + 4);
#pragma unroll
                for (int ai = 0; ai < 2; ++ai)
#pragma unroll
                    for (int m = 0; m < 4; ++m) { const size_t row = (size_t)(row0 + ai * 128 + m * 16); float o[8], rawv[8];
#pragma unroll
                        for (int i = 0; i < 8; ++i) { const float cur = acc[ai][bj][m][i >> 2][i & 3];
                            const float oldv = m > 0 ? dpp_mov0<0x121>(acc[ai][bj][m > 0 ? m - 1 : 0][i >> 2][i & 3]) : 0.f;
                            const float prev = __int_as_float(__builtin_amdgcn_update_dpp(__float_as_int(oldv), __float_as_int(cur), 0x111, 0xF, 0xF, false));
                            const float mui = i < 4 ? mu0[i & 3] : mu1[i & 3];
                            const float z = cur + mui * (prev - cur), zz = mode == 1 ? 2.f * z : z, sg = 1.f / (1.f + __expf(-zz));
                            o[i] = mode == 1 ? 2.f * sg - 1.f : (mode == 2 ? sg : (mode == 0 ? z : 0.f)); rawv[i] = cur; }
                        if (!(m == 0 && fr == 0)) *(u32x4*)(la + row * 512 + dc) = pack8(o);
                        if ((m == 0 && fr == 0) || (m == 3 && fr == 15)) *(u32x4*)(zr + row * 2048 + c) = pack8(rawv);
                        asm volatile("" ::: "memory"); }
            }
            return;
        }
        bf16_t* base; int ldc, colt;
        if (u.pn < 8) { base = zr; ldc = 2048; colt = u.pn * 256; } else if (u.pn < 14) { base = zm; ldc = 1536; colt = (u.pn - 8) * 256; } else { base = gp; ldc = 2048; colt = (u.pn - 14) * 256; }
        const int row0 = u.pm * 256 + wr * 64 + fr, col0 = colt + wc * 32 + 8 * fq;
#pragma unroll
        for (int ai = 0; ai < 2; ++ai)
#pragma unroll
            for (int m = 0; m < 4; ++m) { bf16_t* rowp = base + (size_t)(row0 + ai * 128 + m * 16) * ldc + col0;
#pragma unroll
                for (int bj = 0; bj < 2; ++bj) { const f32x4 v0 = acc[ai][bj][m][0], v1 = acc[ai][bj][m][1]; u32x4 w;
                    w.x = cvt_pk_bf16(v0[0], v0[1]); w.y = cvt_pk_bf16(v0[2], v0[3]); w.z = cvt_pk_bf16(v1[0], v1[1]); w.w = cvt_pk_bf16(v1[2], v1[3]);
                    if (!dry) *(u32x4*)(rowp + bj * 128) = w; } }
    }
};
struct EpiLora {
    static constexpr bool PERM = true;
    bf16_t* O; const float* bias; int mode;
    __device__ __forceinline__ void operator()(const f32x4 (&acc)[2][2][4][2], const pg8::Unit& u, int wr, int wc, int fr, int fq) const {
        const int row0 = u.pm * 256 + wr * 64 + fr, col0 = u.pn * 256 + wc * 32 + 8 * fq;
        const float sc = mode == 0 ? 0.6065306597126334f : 1.f;
#pragma unroll
        for (int bj = 0; bj < 2; ++bj) {
            f32x4 b0 = {0.f, 0.f, 0.f, 0.f}, b1 = {0.f, 0.f, 0.f, 0.f};
            if (mode != 2) { b0 = *(const f32x4*)(bias + col0 + bj * 128); b1 = *(const f32x4*)(bias + col0 + bj * 128 + 4); }
#pragma unroll
            for (int ai = 0; ai < 2; ++ai)
#pragma unroll
                for (int m = 0; m < 4; ++m) { const size_t row_ = (size_t)(row0 + ai * 128 + m * 16); bf16_t* rowp = O + (mode == 2 ? row_ * 512 + col0 + bj * 128 : hm_idx(row_, col0 + bj * 128));
                    f32x4 v0 = acc[ai][bj][m][0] + b0, v1 = acc[ai][bj][m][1] + b1;
                    if (mode != 2) {
#pragma unroll
                        for (int i = 0; i < 4; ++i) { v0[i] = sigmoidf_(v0[i]) * sc; v1[i] = sigmoidf_(v1[i]) * sc; } }
                    u32x4 w; w.x = cvt_pk_bf16(v0[0], v0[1]); w.y = cvt_pk_bf16(v0[2], v0[3]); w.z = cvt_pk_bf16(v1[0], v1[1]); w.w = cvt_pk_bf16(v1[2], v1[3]);
                    *(u32x4*)rowp = w;
                    asm volatile("" ::: "memory"); }
        }
    }
};
struct EpiBranch {
    static constexpr bool PERM = true;
    bf16_t* MG; const bf16_t* GP; int second;
    __device__ __forceinline__ void operator()(const f32x4 (&acc)[2][2][4][2], const pg8::Unit& u, int wr, int wc, int fr, int fq) const {
        const int row0 = u.pm * 256 + wr * 64 + fr, col0 = u.pn * 256 + wc * 32 + 8 * fq;
        u32x4 cg[2], cm[2], ng[2], nm[2];
#pragma unroll
        for (int bj = 0; bj < 2; ++bj) { cg[bj] = *(const u32x4*)(GP + (size_t)row0 * 2048 + second * 1024 + col0 + bj * 128);
            cm[bj] = second ? *(const u32x4*)(MG + (size_t)row0 * 1024 + col0 + bj * 128) : (u32x4){0u, 0u, 0u, 0u}; ng[bj] = cg[bj]; nm[bj] = cm[bj]; }
#pragma unroll
        for (int g = 0; g < 8; ++g) { const int ai = g >> 2, m = g & 3; const size_t row = (size_t)(row0 + ai * 128 + m * 16);
            if (g + 1 < 8) { const size_t rown = (size_t)(row0 + ((g + 1) >> 2) * 128 + ((g + 1) & 3) * 16);
#pragma unroll
                for (int bj = 0; bj < 2; ++bj) { ng[bj] = *(const u32x4*)(GP + rown * 2048 + second * 1024 + col0 + bj * 128);
                    if (second) nm[bj] = *(const u32x4*)(MG + rown * 1024 + col0 + bj * 128); }
                asm volatile("" ::: "memory"); }
#pragma unroll
            for (int bj = 0; bj < 2; ++bj) { const int col = col0 + bj * 128; float v[8], gt[8], pv[8];
#pragma unroll
                for (int i = 0; i < 4; ++i) { v[i] = acc[ai][bj][m][0][i]; v[4 + i] = acc[ai][bj][m][1][i]; }
                unpack8(cg[bj], gt); unpack8(cm[bj], pv);
#pragma unroll
                for (int i = 0; i < 8; ++i) v[i] = v[i] * sigmoidf_(gt[i]) + pv[i];
                *(u32x4*)(MG + row * 1024 + col) = pack8(v); }
#pragma unroll
            for (int bj = 0; bj < 2; ++bj) { cg[bj] = ng[bj]; cm[bj] = nm[bj]; } }
    }
};
struct EpiOut {
    static constexpr bool PERM = true;
    const float* x; float* x1; bf16_t* x1b; float* ssq;
    __device__ __forceinline__ void operator()(const f32x4 (&acc)[2][2][4][2], const pg8::Unit& u, int wr, int wc, int fr, int fq) const {
        const int row0 = u.pm * 256 + wr * 64 + fr, col0 = u.pn * 256 + wc * 32 + 8 * fq;
        f32x4 cur[2][2], nxt[2][2];
#pragma unroll
        for (int bj = 0; bj < 2; ++bj)
#pragma unroll
            for (int n = 0; n < 2; ++n) { cur[bj][n] = *(const f32x4*)(x + (size_t)row0 * 1024 + col0 + bj * 128 + n * 4); nxt[bj][n] = cur[bj][n]; }
#pragma unroll
        for (int g = 0; g < 8; ++g) { const int ai = g >> 2, m = g & 3; const size_t row = (size_t)(row0 + ai * 128 + m * 16); float s = 0.f;
            if (g + 1 < 8) { const size_t rown = (size_t)(row0 + ((g + 1) >> 2) * 128 + ((g + 1) & 3) * 16);
#pragma unroll
                for (int bj = 0; bj < 2; ++bj)
#pragma unroll
                    for (int n = 0; n < 2; ++n) nxt[bj][n] = *(const f32x4*)(x + rown * 1024 + col0 + bj * 128 + n * 4);
                asm volatile("" ::: "memory"); }
#pragma unroll
            for (int bj = 0; bj < 2; ++bj) { const size_t off = row * 1024 + col0 + bj * 128;
                const f32x4 r0 = cur[bj][0] + acc[ai][bj][m][0], r1 = cur[bj][1] + acc[ai][bj][m][1];
                u32x4 w; w.x = cvt_pk_bf16(r0[0], r0[1]); w.y = cvt_pk_bf16(r0[2], r0[3]); w.z = cvt_pk_bf16(r1[0], r1[1]); w.w = cvt_pk_bf16(r1[2], r1[3]);
                *(u32x4*)(x1b + off) = w;
                s += ((r0[0] * r0[0] + r0[1] * r0[1]) + (r0[2] * r0[2] + r0[3] * r0[3])) + ((r1[0] * r1[0] + r1[1] * r1[1]) + (r1[2] * r1[2] + r1[3] * r1[3])); }
            s += __shfl_xor(s, 16); s += __shfl_xor(s, 32);
            if (fq == 0) ssq[row * 16 + u.pn * 4 + wc] = s;
#pragma unroll
            for (int bj = 0; bj < 2; ++bj)
#pragma unroll
                for (int n = 0; n < 2; ++n) cur[bj][n] = nxt[bj][n]; }
    }
};
template <int CTRL> __device__ __forceinline__ float dpp_mov(float x) { return __int_as_float(__builtin_amdgcn_update_dpp(0, __float_as_int(x), CTRL, 0xF, 0xF, false)); }
struct EpiUp {
    static constexpr bool PERM = true;
    bf16_t* U; const float* ssq; const float* cw; const float* cb;
    __device__ __forceinline__ void operator()(const f32x4 (&acc)[2][2][4][2], const pg8::Unit& u, int wr, int wc, int fr, int fq) const {
        const int row0 = u.pm * 256 + wr * 64 + fr, cl = u.pn * 128 + wc * 32 + 8 * fq;
#pragma unroll
        for (int n = 0; n < 2; ++n) {
            const int c4 = cl + 4 * n;
            const f32x4 w0 = *(const f32x4*)(cw + c4), w1 = *(const f32x4*)(cw + DFF + c4), w2 = *(const f32x4*)(cw + 2 * DFF + c4), bs = *(const f32x4*)(cb + c4);
            f32x4 cs4[4], ns4[4];
            f32x4 avp = {0.f, 0.f, 0.f, 0.f};
#pragma unroll
            for (int q = 0; q < 4; ++q) { cs4[q] = ((const f32x4*)(ssq + (size_t)row0 * 16))[q]; ns4[q] = cs4[q]; }
#pragma unroll
            for (int g = 0; g < 8; ++g) { const int ai = g >> 2, m = g & 3; const size_t row = (size_t)(row0 + ai * 128 + m * 16);
                if (g + 1 < 8) { const size_t rown = (size_t)(row0 + ((g + 1) >> 2) * 128 + ((g + 1) & 3) * 16);
#pragma unroll
                    for (int q = 0; q < 4; ++q) ns4[q] = ((const f32x4*)(ssq + rown * 16))[q];
                    asm volatile("" ::: "memory"); }
                const f32x4 sa_ = cs4[0], sb_ = cs4[1], sc_ = cs4[2], sd_ = cs4[3];
                const float ss = ((sa_[0] + sa_[1]) + (sa_[2] + sa_[3])) + ((sb_[0] + sb_[1]) + (sb_[2] + sb_[3])) + ((sc_[0] + sc_[1]) + (sc_[2] + sc_[3])) + ((sd_[0] + sd_[1]) + (sd_[2] + sd_[3]));
                const float rstd = rsqrtf(ss * (1.f / 1024.f) + 1e-6f);
                const f32x4 av = acc[ai][0][m][n] * rstd, bv = acc[ai][1][m][n] * rstd; f32x4 o;
#pragma unroll
                for (int i = 0; i < 4; ++i) {
                    const float o1 = m > 0 ? dpp_mov<0x121>(avp[i]) : 0.f, o2 = m > 0 ? dpp_mov<0x122>(avp[i]) : 0.f;
                    const float p1 = __int_as_float(__builtin_amdgcn_update_dpp(__float_as_int(o1), __float_as_int(av[i]), 0x111, 0xF, 0xF, false));
                    const float p2 = __int_as_float(__builtin_amdgcn_update_dpp(__float_as_int(o2), __float_as_int(av[i]), 0x112, 0xF, 0xF, false));
                    const float v = w0[i] * p2 + w1[i] * p1 + w2[i] * av[i] + bs[i]; o[i] = gelu_erf(v) * bv[i]; }
                bf16_t* ua = U + row * NPROJ + c4; bf16_t* ub = ua + DFF;
                u32x2 pa, pb, po; pa.x = cvt_pk_bf16(av[0], av[1]); pa.y = cvt_pk_bf16(av[2], av[3]); pb.x = cvt_pk_bf16(bv[0], bv[1]); pb.y = cvt_pk_bf16(bv[2], bv[3]);
                po.x = cvt_pk_bf16(o[0], o[1]); po.y = cvt_pk_bf16(o[2], o[3]);
                if (fr >= 2 || m > 0) { *(u32x2*)ub = po; if (fr >= 14 && m == 3) *(u32x2*)ua = pa; }
                else { *(u32x2*)ua = pa; *(u32x2*)ub = pb; }
                avp = av;
#pragma unroll
                for (int q = 0; q < 4; ++q) cs4[q] = ns4[q]; }
        }
    }
};
struct EpiDown {
    static constexpr bool PERM = true;
    float* out; const bf16_t* x1b; bool dry;
    __device__ __forceinline__ void operator()(const f32x4 (&acc)[2][2][4][2], const pg8::Unit& u, int wr, int wc, int fr, int fq) const {
        const int row0 = u.pm * 256 + wr * 64 + fr, col0 = u.pn * 256 + wc * 32 + 8 * fq;
        u32x4 cur[2], nxt[2];
#pragma unroll
        for (int bj = 0; bj < 2; ++bj) { cur[bj] = *(const u32x4*)(x1b + (size_t)row0 * 1024 + col0 + bj * 128); nxt[bj] = cur[bj]; }
#pragma unroll
        for (int g = 0; g < 8; ++g) { const int ai = g >> 2, m = g & 3; const size_t row = (size_t)(row0 + ai * 128 + m * 16);
            if (g + 1 < 8) { const size_t rown = (size_t)(row0 + ((g + 1) >> 2) * 128 + ((g + 1) & 3) * 16);
#pragma unroll
                for (int bj = 0; bj < 2; ++bj) nxt[bj] = *(const u32x4*)(x1b + rown * 1024 + col0 + bj * 128);
                asm volatile("" ::: "memory"); }
#pragma unroll
            for (int bj = 0; bj < 2; ++bj) { const size_t off = row * 1024 + col0 + bj * 128; const u32x4 xb = cur[bj];
                const f32x4 x0 = {bf_lo(xb.x), bf_hi(xb.x), bf_lo(xb.y), bf_hi(xb.y)}, x1 = {bf_lo(xb.z), bf_hi(xb.z), bf_lo(xb.w), bf_hi(xb.w)};
                const f32x4 r0 = x0 + acc[ai][bj][m][0], r1 = x1 + acc[ai][bj][m][1];
                if (!dry) { *(f32x4*)(out + off) = r0; *(f32x4*)(out + off + 4) = r1; } }
#pragma unroll
            for (int bj = 0; bj < 2; ++bj) cur[bj] = nxt[bj]; }
    }
};

__device__ __forceinline__ void tr_item(const float* W, int Ksrc, int Nsrc, int srccol0, const float* rowscale, bf16_t* WT, int ldk, int n0, int k0, float* scr, int lane) {
    float v[32]; const int nn = lane & 31; const bool colok = srccol0 >= 0; const float* Wc = W + (colok ? srccol0 : 0) + nn;
#pragma unroll
    for (int i = 0; i < 32; ++i) { const int k = k0 + 2 * i + (lane >> 5); const bool ok = colok && k < Ksrc; const int kc = ok ? k : 0;
        float t = Wc[(size_t)kc * Nsrc]; if (rowscale) t *= rowscale[kc]; v[i] = ok ? t : 0.f; }
#pragma unroll
    for (int i = 0; i < 32; ++i) scr[(2 * i + (lane >> 5)) * 33 + nn] = v[i];
    asm volatile("s_waitcnt lgkmcnt(0)" ::: "memory");
    const int c = lane & 7;
#pragma unroll
    for (int j = 0; j < 4; ++j) { const int n = (lane >> 3) + 8 * j; const float* s = scr + (8 * c) * 33 + n;
        u32x4 o; o.x = cvt_pk_bf16(s[0 * 33], s[1 * 33]); o.y = cvt_pk_bf16(s[2 * 33], s[3 * 33]); o.z = cvt_pk_bf16(s[4 * 33], s[5 * 33]); o.w = cvt_pk_bf16(s[6 * 33], s[7 * 33]);
        *(u32x4*)(WT + (size_t)(n0 + n) * ldk + k0 + 8 * c) = o; }
    asm volatile("s_waitcnt lgkmcnt(0)" ::: "memory");
}
__device__ __forceinline__ void phase0(const Params& p, unsigned char* lds) {
    const int tid = threadIdx.x, lane = tid & 63, wave = tid >> 6;
    float* scr = (float*)(lds + wave * 16384);
    const int gw = blockIdx.x * 8 + wave, NGW = gridDim.x * 8;
    unsigned char* ws = p.ws;
    constexpr int I_1 = 16 * 176, I_2 = 16 * 176, I_3 = 44 * 32, I_4 = 16 * 32, I_5 = 8 * 32, I_6 = 8 * 32, I_7 = 2 * 16, I_8 = 2 * 16, I_9 = 4 * 16;
    constexpr int NIT = I_1 + I_2 + I_3 + I_4 + I_5 + I_6 + I_7 + I_8 + I_9;
    for (int it = gw; it < NIT; it += NGW) {
        int r = it;
        if (r < I_1) { const int kb = r / 176, nb = r % 176, n0 = nb * 32; const int sc = n0 < 1824 ? n0 : (n0 < 2048 ? -1 : n0 - 224);
            tr_item(p.in[I_WIN], 1024, IN_COLS, sc, nullptr, (bf16_t*)(ws + WS_WIN), 1024, n0, kb * 64, scr, lane); continue; } r -= I_1;
        if (r < I_2) { const int kb = r / 176, nb = r % 176; const int n0 = nb * 32, pn_ = n0 >> 8, w_ = n0 & 255; const int sc = w_ < 128 ? 128 * pn_ + w_ : DFF + 128 * pn_ + (w_ - 128);
            tr_item(p.in[I_WUP], 1024, 5632, sc, p.in[I_N2G], (bf16_t*)(ws + WS_WUP), 1024, n0, kb * 64, scr, lane); continue; } r -= I_2;
        if (r < I_3) { const int kb = r / 32, nb = r % 32; tr_item(p.in[I_WDN], 2816, 1024, nb * 32, nullptr, (bf16_t*)(ws + WS_WDN), 2816, nb * 32, kb * 64, scr, lane); continue; } r -= I_3;
        if (r < I_4) { const int kb = r / 32, nb = r % 32; tr_item(p.in[I_WOUT], 1024, 1024, nb * 32, nullptr, (bf16_t*)(ws + WS_WOUT), 1024, nb * 32, kb * 64, scr, lane); continue; } r -= I_4;
        if (r < I_5) { const int kb = r / 32, nb = r % 32; tr_item(p.in[I_WBA], 512, 1024, nb * 32, nullptr, (bf16_t*)(ws + WS_WBA), 512, nb * 32, kb * 64, scr, lane); continue; } r -= I_5;
        if (r < I_6) { const int kb = r / 32, nb = r % 32; tr_item(p.in[I_WBB], 512, 1024, nb * 32, nullptr, (bf16_t*)(ws + WS_WBB), 512, nb * 32, kb * 64, scr, lane); continue; } r -= I_6;
        if (r < I_7) { const int kb = r / 16, nb = r % 16; tr_item(p.in[I_WDU], 64, 512, nb * 32, nullptr, (bf16_t*)(ws + WS_WD), 128, nb * 32, kb * 64, scr, lane); continue; } r -= I_7;
        if (r < I_8) { const int kb = r / 16, nb = r % 16; tr_item(p.in[I_WAU], 64, 512, nb * 32, nullptr, (bf16_t*)(ws + WS_WA), 128, nb * 32, kb * 64, scr, lane); continue; } r -= I_8;
        { const int kb = r / 16, nb = r % 16; tr_item(p.in[I_WGU], 160, 512, nb * 32, nullptr, (bf16_t*)(ws + WS_WG), 256, nb * 32, kb * 64, scr, lane); }
    }
    const float* x = p.in[I_X]; const float* g1 = p.in[I_N1G]; bf16_t* hb = (bf16_t*)(ws + WS_HB);
    f32x4 gv[4];
#pragma unroll
    for (int j = 0; j < 4; ++j) gv[j] = *(const f32x4*)(g1 + 4 * lane + 256 * j);
    for (int m0 = gw; m0 < T; m0 += 4 * NGW) {
        f32x4 v[4][4];
#pragma unroll
        for (int j = 0; j < 4; ++j) { const f32x4* xr = (const f32x4*)(x + (size_t)(m0 + j * NGW) * DM) + lane;
#pragma unroll
            for (int q = 0; q < 4; ++q) v[j][q] = xr[64 * q]; }
#pragma unroll
        for (int j = 0; j < 4; ++j) { float s = 0.f;
#pragma unroll
            for (int q = 0; q < 4; ++q) s += (v[j][q][0] * v[j][q][0] + v[j][q][1] * v[j][q][1]) + (v[j][q][2] * v[j][q][2] + v[j][q][3] * v[j][q][3]);
            const float rstd = rsqrtf(wave_sum(s) * (1.f / DM) + 1e-6f);
            u32x2* o8 = (u32x2*)(hb + (size_t)(m0 + j * NGW) * DM) + lane;
#pragma unroll
            for (int q = 0; q < 4; ++q) { const f32x4 y = v[j][q] * rstd * gv[q]; u32x2 w; w.x = cvt_pk_bf16(y[0], y[1]); w.y = cvt_pk_bf16(y[2], y[3]); o8[64 * q] = w; } }
    }
}

__device__ __forceinline__ void phase2(const Params& p, unsigned char* lds, int parts) {
    const int tid = threadIdx.x;
    unsigned char* ws = p.ws;
    const bf16_t* ZM = (const bf16_t*)(ws + WS_ZM); const bf16_t* ZR = (const bf16_t*)(ws + WS_ZR);
    bf16_t* Qp = (bf16_t*)((unsigned char*)p.out + OUT_Q); bf16_t* Kp = (bf16_t*)((unsigned char*)p.out + OUT_KP); bf16_t* VT = (bf16_t*)((unsigned char*)p.out + OUT_VT);
    bf16_t* LA = (bf16_t*)((unsigned char*)p.out + OUT_LA);
    float* KMEAN = (float*)(ws + WS_KMEAN);
    const int* pos = (const int*)p.in[I_POS];
    float* kl = (float*)lds;
    unsigned short* vl = (unsigned short*)(lds + 256 * 65 * 4);
    const int tok = tid >> 1, half = tid & 1;
    const float rvh[8] = {0.15915493667125702f, 0.030863763764500618f, 0.005985185503959656f, 0.0011606636689975858f, 0.0002250790857942775f, 4.3647953134495765e-05f, 8.464330676360987e-06f, 1.6414262518082978e-06f};
    const float rvl[8] = {6.4206382432985265e-09f, -6.060805191054897e-10f, 1.7242327010613678e-10f, -4.8028716420622786e-11f, -6.753226016592562e-12f, 1.6772382094298877e-12f, -1.2670839041623722e-13f, -9.854460929453572e-15f};
    u32x4 nraw[2][4]; int npos = 0;
#define P2_LOAD(it_) do { const int h_ = (it_) & 7, blk_ = ((it_) >> 3) & 15, b_ = (it_) >> 7; const size_t t_ = (size_t)b_ * SEQ + blk_ * 256 + tok; npos = pos[t_]; \
        _Pragma("unroll") for (int w3 = 1; w3 < 2; ++w3) _Pragma("unroll") for (int j = 0; j < 4; ++j) nraw[w3][j] = *(const u32x4*)(ZM + t_ * 1536 + w3 * 512 + h_ * 64 + 32 * half + 8 * j); } while (0)
    if ((parts & 1) && (int)blockIdx.x < 1024) P2_LOAD((int)blockIdx.x);
    if (parts & 1)
    for (int item = blockIdx.x; item < 1024; item += gridDim.x) {
        const int h = item & 7, blk = (item >> 3) & 15, b = item >> 7;
        const size_t t = (size_t)b * SEQ + blk * 256 + tok;
        u32x4 raw[2][4]; const int cpos = npos;
#pragma unroll
        for (int w3 = 1; w3 < 2; ++w3)
#pragma unroll
            for (int j = 0; j < 4; ++j) raw[w3][j] = nraw[w3][j];
        if (item + (int)gridDim.x < 1024) P2_LOAD(item + (int)gridDim.x);
        float cs[8], sn[8];
        { const float ps = (float)cpos;
#pragma unroll
          for (int i = 0; i < 8; ++i) { const float hi_ = ps * rvh[i], lo_ = fmaf(ps, rvh[i], -hi_) + ps * rvl[i];
              const float fx = (hi_ - floorf(hi_)) + lo_; sn[i] = __builtin_amdgcn_sinf(fx); cs[i] = __builtin_amdgcn_cosf(fx); } }
#pragma unroll
        for (int which = 1; which < 2; ++which) {
            const float* gg = p.in[which ? I_KNG : I_QNG] + 32 * half;
            float v[32];
#pragma unroll
            for (int j = 0; j < 4; ++j) unpack8(raw[which][j], v + 8 * j);
            float ss = 0.f;
#pragma unroll
            for (int i = 0; i < 32; ++i) ss += v[i] * v[i];
            ss += __shfl_xor(ss, 1);
            const float rstd = rsqrtf(ss * (1.f / 64.f) + 1e-6f);
#pragma unroll
            for (int i = 0; i < 32; ++i) v[i] = v[i] * rstd * gg[i];
            if (half == 0) {
#pragma unroll
                for (int i = 0; i < 8; ++i) { const float x1 = v[i], x2 = v[8 + i]; v[i] = x1 * cs[i] - x2 * sn[i]; v[8 + i] = x2 * cs[i] + x1 * sn[i]; }
            }
            bf16_t* dst = (which ? Kp : Qp) + t * 512 + h * 64 + 32 * half;
#pragma unroll
            for (int j = 0; j < 4; ++j) *(u32x4*)(dst + 8 * j) = pack8(v + 8 * j);
            if (which == 1) {
#pragma unroll
                for (int i = 0; i < 32; ++i) kl[tok * 65 + 32 * half + i] = v[i];
            }
        }
        __syncthreads();
        { float* kp = (float*)(lds + 256 * 65 * 4); const int d_ = tid & 63, part = tid >> 6; float s0_ = 0.f, s1_ = 0.f;
#pragma unroll 8
          for (int r = 0; r < 32; r += 2) { s0_ += kl[(part * 32 + r) * 65 + d_]; s1_ += kl[(part * 32 + r + 1) * 65 + d_]; }
          kp[part * 64 + d_] = s0_ + s1_; }
        __syncthreads();
        if (tid < 64) { const float* kp = (const float*)(lds + 256 * 65 * 4); float s_ = 0.f;
#pragma unroll
            for (int q8 = 0; q8 < 8; ++q8) s_ += kp[q8 * 64 + tid];
            KMEAN[((size_t)(b * 8 + h) * 16 + blk) * 64 + tid] = s_ * (1.f / 256.f); }
    }
    __syncthreads();
    const float* mu = p.in[I_MU];
    const size_t NG = (parts & 2) ? (size_t)(T / 64) * 64 : 0;
    for (size_t idx = (size_t)blockIdx.x * 512 + tid; idx < NG; idx += (size_t)gridDim.x * 512) {
        const size_t t = (idx >> 6) * 64; const int dc = (int)(idx & 63) * 8; int sc = -1, mode = 0;
        if (dc < 64) { sc = 1536 + dc; mode = 1; } else if (dc >= 128 && dc < 192) { sc = 1600 + dc - 128; mode = 0; } else if (dc >= 256 && dc < 416) { sc = 1664 + dc - 256; mode = 2; }
        float v[8];
#pragma unroll
        for (int i = 0; i < 8; ++i) v[i] = 0.f;
        if (sc >= 0) { float a[8], pr[8]; unpack8(*(const u32x4*)(ZR + t * 2048 + sc), a);
            if ((t & (SEQ - 1)) != 0) unpack8(*(const u32x4*)(ZR + (t - 1) * 2048 + sc), pr); else {
#pragma unroll
                for (int i = 0; i < 8; ++i) pr[i] = 0.f; }
#pragma unroll
            for (int i = 0; i < 8; ++i) { const float z = a[i] + mu[sc + i] * (pr[i] - a[i]); v[i] = mode == 1 ? tanhf(z) : (mode == 2 ? sigmoidf_(z) : z); } }
        *(u32x4*)(LA + t * 512 + dc) = pack8(v);
    }
}

__device__ __forceinline__ void phase4(const Params& p) {
    const int tid = threadIdx.x; unsigned char* ws = p.ws;
    const bf16_t* ZR = (const bf16_t*)(ws + WS_ZR); const bf16_t* ALR = (const bf16_t*)(ws + WS_ALR);
    bf16_t* R = (bf16_t*)(ws + WS_R); bf16_t* K = (bf16_t*)(ws + WS_K); bf16_t* V = (bf16_t*)(ws + WS_V); bf16_t* KK = (bf16_t*)((unsigned char*)p.out + OUT_KK);
    float* SBON = (float*)(ws + WS_SBON);
    const float* mu = p.in[I_MU]; const float* k_k = p.in[I_KK]; const float* k_a = p.in[I_KA]; const float* r_k = p.in[I_RK];
    const size_t NG = (size_t)(T / 2) * 64;
    for (size_t idx = (size_t)blockIdx.x * 512 + tid; idx < NG; idx += (size_t)gridDim.x * 512) {
        const size_t t0 = (idx >> 6) * 2; const int c0 = (int)(idx & 63) * 8;
        const bool first = (t0 & (SEQ - 1)) == 0;
        u32x4 raw[3][3], ral[2];
#pragma unroll
        for (int j = 0; j < 3; ++j)
#pragma unroll
            for (int w3 = 0; w3 < 3; ++w3) { if (j > 0 || !first) raw[j][w3] = *(const u32x4*)(ZR + (t0 + j - 1) * 2048 + w3 * 512 + c0); else raw[j][w3] = (u32x4){0u, 0u, 0u, 0u}; }
        const size_t hm0 = hm_idx(t0, c0);
        ral[0] = *(const u32x4*)(ALR + hm0); ral[1] = *(const u32x4*)(ALR + hm0 + 64);
        float muv[3][8], kkw[8], kaw[8], rkw[8];
#pragma unroll
        for (int i = 0; i < 8; ++i) { muv[0][i] = mu[c0 + i]; muv[1][i] = mu[512 + c0 + i]; muv[2][i] = mu[1024 + c0 + i]; kkw[i] = k_k[c0 + i]; kaw[i] = k_a[c0 + i]; rkw[i] = r_k[c0 + i]; }
#pragma unroll
        for (int j = 0; j < 2; ++j) {
            float z[3][8], pr[8], al[8];
#pragma unroll
            for (int w3 = 0; w3 < 3; ++w3) { unpack8(raw[j + 1][w3], z[w3]); unpack8(raw[j][w3], pr);
#pragma unroll
                for (int i = 0; i < 8; ++i) z[w3][i] = z[w3][i] + muv[w3][i] * (pr[i] - z[w3][i]); }
            unpack8(ral[j], al);
            float kk[8], km[8]; float ss = 0.f, sb = 0.f;
#pragma unroll
            for (int i = 0; i < 8; ++i) { kk[i] = z[1][i] * kkw[i]; ss += kk[i] * kk[i]; km[i] = z[1][i] * (1.f + (al[i] - 1.f) * kaw[i]); sb += z[0][i] * km[i] * rkw[i]; }
            ss += __shfl_xor(ss, 1); ss += __shfl_xor(ss, 2); ss += __shfl_xor(ss, 4);
            sb += __shfl_xor(sb, 1); sb += __shfl_xor(sb, 2); sb += __shfl_xor(sb, 4);
            const float inv = 1.f / fmaxf(sqrtf(ss), 1e-12f);
#pragma unroll
            for (int i = 0; i < 8; ++i) kk[i] *= inv;
            const size_t hm = hm0 + 64 * j;
            *(u32x4*)(R + hm) = pack8(z[0]); *(u32x4*)(K + hm) = pack8(km); *(u32x4*)(V + hm) = pack8(z[2]); *(u32x4*)(KK + hm) = pack8(kk);
            if ((idx & 7) == 0) SBON[(t0 + j) * 8 + (c0 >> 6)] = sb;
        }
    }
}

template <int CTRL> __device__ __forceinline__ float dpp_add(float x) {
    const int y = __builtin_amdgcn_update_dpp(0, __float_as_int(x), CTRL, 0xF, 0xF, false);
    return x + __int_as_float(y);
}
__device__ __forceinline__ float row16_sum(float x) {
    x = dpp_add<0xB1>(x);
    x = dpp_add<0x4E>(x);
    x = dpp_add<0x141>(x);
    x = dpp_add<0x140>(x);
    return x;
}
typedef float f32x2 __attribute__((ext_vector_type(2)));
__device__ __forceinline__ float fmul_(float a, float b) { float d; asm("v_mul_f32_e32 %0, %1, %2" : "=v"(d) : "v"(a), "v"(b)); return d; }
__device__ __forceinline__ float fadd_(float a, float b) { float d; asm("v_add_f32_e32 %0, %1, %2" : "=v"(d) : "v"(a), "v"(b)); return d; }
__device__ __forceinline__ float ffma_(float a, float b, float c) { float d; asm("v_fma_f32 %0, %1, %2, %3" : "=v"(d) : "v"(a), "v"(b), "v"(c)); return d; }
__device__ __forceinline__ float row16_sum_asm(float x) {
    float d;
    asm("s_nop 1\n\tv_add_f32_dpp %0, %1, %1 quad_perm:[1,0,3,2] row_mask:0xf bank_mask:0xf\n\t"
        "s_nop 1\n\tv_add_f32_dpp %0, %0, %0 quad_perm:[2,3,0,1] row_mask:0xf bank_mask:0xf\n\t"
        "s_nop 1\n\tv_add_f32_dpp %0, %0, %0 row_half_mirror row_mask:0xf bank_mask:0xf\n\t"
        "s_nop 1\n\tv_add_f32_dpp %0, %0, %0 row_mirror row_mask:0xf bank_mask:0xf" : "=&v"(d) : "v"(x));
    return d;
}
constexpr int SC_STEPS = 32, SC_ROW = 336;
__device__ __forceinline__ void scan_block(const Params& p, unsigned char* lds, int sb) {
    const int tid = threadIdx.x, lane = tid & 63, wave = __builtin_amdgcn_readfirstlane(tid >> 6);
    unsigned char* ws = p.ws;
    const bf16_t* ALR = (const bf16_t*)(ws + WS_ALR); const bf16_t* E = (const bf16_t*)(ws + WS_E);
    bf16_t* Y = (bf16_t*)((unsigned char*)p.out + OUT_VT);
    const int xi_ = sb >> 3, quarter = xi_ & 3, bh = (sb & 7) + 8 * (xi_ >> 2), b = bh >> 3, h = bh & 7;
    float* buf = (float*)lds;
    float* ybuf = (float*)(lds + 2 * SC_STEPS * SC_ROW * 4);
    const size_t rowbase = (size_t)b * SEQ;
    constexpr int NCH = SEQ / SC_STEPS;
    if (wave >= 4) {
        const int lt = tid - 256, st_tok = lt >> 3, st_c = lt & 7;
        const bf16_t* ZR = (const bf16_t*)(ws + WS_ZR); float* SBON = (float*)(ws + WS_SBON);
        const int hc = h * 64 + st_c * 8;
        float mur[8], muk[8], muv[8], kkw[8], kaw[8], rkw[8];
#pragma unroll
        for (int i = 0; i < 8; ++i) { mur[i] = p.in[I_MU][hc + i]; muk[i] = p.in[I_MU][512 + hc + i]; muv[i] = p.in[I_MU][1024 + hc + i]; kkw[i] = p.in[I_KK][hc + i]; kaw[i] = p.in[I_KA][hc + i]; rkw[i] = p.in[I_RK][hc + i]; }
        u32x4 Pr, Pk, Pv, Ppr, Ppk, Ppv, Pa, Pe, Qr, Qk, Qv, Qpr, Qpk, Qpv, Qa, Qe;
#define SC_LOAD(X, ch) do { const int s_ = (ch) * SC_STEPS + st_tok; const bf16_t* zr_ = ZR + (rowbase + s_) * 2048 + hc; \
        X##r = *(const u32x4*)(zr_); X##k = *(const u32x4*)(zr_ + 512); X##v = *(const u32x4*)(zr_ + 1024); \
        if (s_ > 0) { X##pr = *(const u32x4*)(zr_ - 2048); X##pk = *(const u32x4*)(zr_ - 2048 + 512); X##pv = *(const u32x4*)(zr_ - 2048 + 1024); } \
        else { X##pr = (u32x4){0u, 0u, 0u, 0u}; X##pk = X##pr; X##pv = X##pr; } \
        const size_t o_ = (((size_t)bh * SEQ) + s_) * 64 + st_c * 8; X##a = *(const u32x4*)(ALR + o_); X##e = *(const u32x4*)(E + o_); } while (0)
#define SC_STORE(X, ch) do { float* bq = buf + ((ch) & 1) * SC_STEPS * SC_ROW; \
        float fr_[8], fk_[8], fv_[8], fp_[8], fa_[8], fe_[8], fkk_[8], fkm_[8]; \
        unpack8(X##r, fr_); unpack8(X##pr, fp_); _Pragma("unroll") for (int i_ = 0; i_ < 8; ++i_) fr_[i_] = fr_[i_] + mur[i_] * (fp_[i_] - fr_[i_]); \
        unpack8(X##k, fk_); unpack8(X##pk, fp_); _Pragma("unroll") for (int i_ = 0; i_ < 8; ++i_) fk_[i_] = fk_[i_] + muk[i_] * (fp_[i_] - fk_[i_]); \
        unpack8(X##v, fv_); unpack8(X##pv, fp_); _Pragma("unroll") for (int i_ = 0; i_ < 8; ++i_) fv_[i_] = fv_[i_] + muv[i_] * (fp_[i_] - fv_[i_]); \
        unpack8(X##a, fa_); unpack8(X##e, fe_); \
        float ss_ = 0.f, sb_ = 0.f; \
        _Pragma("unroll") for (int i_ = 0; i_ < 8; ++i_) { fkk_[i_] = fk_[i_] * kkw[i_]; ss_ += fkk_[i_] * fkk_[i_]; fkm_[i_] = fk_[i_] * (1.f + (fa_[i_] - 1.f) * kaw[i_]); sb_ += fr_[i_] * fkm_[i_] * rkw[i_]; } \
        ss_ += __shfl_xor(ss_, 1); ss_ += __shfl_xor(ss_, 2); ss_ += __shfl_xor(ss_, 4); \
        sb_ += __shfl_xor(sb_, 1); sb_ += __shfl_xor(sb_, 2); sb_ += __shfl_xor(sb_, 4); \
        const float inv_ = 1.f / fmaxf(sqrtf(ss_), 1e-12f); \
        _Pragma("unroll") for (int i_ = 0; i_ < 8; ++i_) fkk_[i_] *= inv_; \
        if (quarter == 0 && st_c == 0) SBON[(rowbase + (size_t)(ch) * SC_STEPS + st_tok) * 8 + h] = sb_; \
        { float* q = bq + st_tok * SC_ROW + st_c * 8; f32x4 o0, o1; \
          o0 = (f32x4){fr_[0], fr_[1], fr_[2], fr_[3]}; o1 = (f32x4){fr_[4], fr_[5], fr_[6], fr_[7]}; *(f32x4*)(q) = o0; *(f32x4*)(q + 4) = o1; \
          o0 = (f32x4){__expf(-fe_[0]), __expf(-fe_[1]), __expf(-fe_[2]), __expf(-fe_[3])}; o1 = (f32x4){__expf(-fe_[4]), __expf(-fe_[5]), __expf(-fe_[6]), __expf(-fe_[7])}; *(f32x4*)(q + 64) = o0; *(f32x4*)(q + 68) = o1; \
          o0 = (f32x4){fkm_[0], fkm_[1], fkm_[2], fkm_[3]}; o1 = (f32x4){fkm_[4], fkm_[5], fkm_[6], fkm_[7]}; *(f32x4*)(q + 128) = o0; *(f32x4*)(q + 132) = o1; \
          o0 = (f32x4){-fkk_[0], -fkk_[1], -fkk_[2], -fkk_[3]}; o1 = (f32x4){-fkk_[4], -fkk_[5], -fkk_[6], -fkk_[7]}; *(f32x4*)(q + 192) = o0; *(f32x4*)(q + 196) = o1; \
          o0 = (f32x4){fkk_[0] * fa_[0], fkk_[1] * fa_[1], fkk_[2] * fa_[2], fkk_[3] * fa_[3]}; o1 = (f32x4){fkk_[4] * fa_[4], fkk_[5] * fa_[5], fkk_[6] * fa_[6], fkk_[7] * fa_[7]}; *(f32x4*)(q + 256) = o0; *(f32x4*)(q + 260) = o1; } \
        if ((st_c >> 1) == quarter) { float* q = bq + st_tok * SC_ROW + 320 + (st_c & 1) * 8; \
          *(f32x4*)(q) = (f32x4){fv_[0], fv_[1], fv_[2], fv_[3]}; *(f32x4*)(q + 4) = (f32x4){fv_[4], fv_[5], fv_[6], fv_[7]}; } } while (0)
#define SC_FLUSH(ch) do { const float* yq = ybuf + ((ch) & 1) * 512; const int tk = lt >> 3, r2 = (lt & 7) * 2; \
        f32x2 o; o.x = yq[r2 * 32 + tk]; o.y = yq[(r2 + 1) * 32 + tk]; \
        *(unsigned*)(Y + (rowbase + (size_t)(ch) * SC_STEPS + tk) * 512 + h * 64 + quarter * 16 + r2) = cvt_pk_bf16(o.x, o.y); } while (0)
        SC_LOAD(Q, 0); SC_STORE(Q, 0); SC_LOAD(P, 1); SC_LOAD(Q, 2);
        __syncthreads();
        for (int ch = 0; ch < NCH; ch += 2) {
            SC_STORE(P, ch + 1);
            if (ch + 3 < NCH) SC_LOAD(P, ch + 3);
            if (ch >= 1) SC_FLUSH(ch - 1);
            __syncthreads();
            if (ch + 2 < NCH) SC_STORE(Q, ch + 2);
            if (ch + 4 < NCH) SC_LOAD(Q, ch + 4);
            SC_FLUSH(ch);
            __syncthreads();
        }
        SC_FLUSH(NCH - 1);
#undef SC_LOAD
#undef SC_STORE
#undef SC_FLUSH
    } else {
        __syncthreads();
        const int c = lane & 15, rowq = wave * 4 + (lane >> 4);
#define SC_LDG(X, base) do { _Pragma("unroll") for (int u_ = 0; u_ < 2; ++u_) { const float* q_ = (base) + u_ * SC_ROW; \
            X##r[u_] = *(const f32x4*)(q_ + 4 * c); X##w[u_] = *(const f32x4*)(q_ + 64 + 4 * c); X##k[u_] = *(const f32x4*)(q_ + 128 + 4 * c); \
            X##a[u_] = *(const f32x4*)(q_ + 192 + 4 * c); X##b[u_] = *(const f32x4*)(q_ + 256 + 4 * c); X##v[u_] = q_[320 + rowq]; } } while (0)
#define SC_STEP(Xa, Xb, Xw, Xk, Xv, RP, yprev) do { float dA_, dB_, vk0_, vk1_, vk2_, vk3_; \
        asm volatile("v_mul_f32_e32 %0, %2, %6\n\tv_mul_f32_e32 %1, %2, %10\n\t" \
                     "v_fma_f32 %0, %3, %7, %0\n\tv_fma_f32 %1, %3, %11, %1\n\t" \
                     "v_fma_f32 %0, %4, %8, %0\n\tv_fma_f32 %1, %4, %12, %1\n\t" \
                     "v_fma_f32 %0, %5, %9, %0\n\tv_fma_f32 %1, %5, %13, %1" \
                     : "=&v"(dA_), "=&v"(dB_) \
                     : "v"(s0), "v"(s1), "v"(s2), "v"(s3), "v"(Xa[0]), "v"(Xa[1]), "v"(Xa[2]), "v"(Xa[3]), "v"(RP[0]), "v"(RP[1]), "v"(RP[2]), "v"(RP[3])); \
        asm volatile("v_mul_f32_e32 %2, %6, %10\n\t" \
                     "v_add_f32_dpp %0, %0, %0 quad_perm:[1,0,3,2] row_mask:0xf bank_mask:0xf\n\tv_add_f32_dpp %1, %1, %1 quad_perm:[1,0,3,2] row_mask:0xf bank_mask:0xf\n\t" \
                     "v_mul_f32_e32 %3, %7, %10\n\t" \
                     "v_add_f32_dpp %0, %0, %0 quad_perm:[2,3,0,1] row_mask:0xf bank_mask:0xf\n\tv_add_f32_dpp %1, %1, %1 quad_perm:[2,3,0,1] row_mask:0xf bank_mask:0xf\n\t" \
                     "v_mul_f32_e32 %4, %8, %10\n\t" \
                     "v_add_f32_dpp %0, %0, %0 row_half_mirror row_mask:0xf bank_mask:0xf\n\tv_add_f32_dpp %1, %1, %1 row_half_mirror row_mask:0xf bank_mask:0xf\n\t" \
                     "v_mul_f32_e32 %5, %9, %10\n\t" \
                     "v_add_f32_dpp %0, %0, %0 row_mirror row_mask:0xf bank_mask:0xf\n\tv_add_f32_dpp %1, %1, %1 row_mirror row_mask:0xf bank_mask:0xf" \
                     : "+v"(dA_), "+v"(dB_), "=&v"(vk0_), "=&v"(vk1_), "=&v"(vk2_), "=&v"(vk3_) \
                     : "v"(Xk[0]), "v"(Xk[1]), "v"(Xk[2]), "v"(Xk[3]), "v"(Xv)); \
        asm volatile("v_fma_f32 %4, %8, %9, %4\n\tv_fma_f32 %5, %8, %10, %5\n\tv_fma_f32 %6, %8, %11, %6\n\tv_fma_f32 %7, %8, %12, %7\n\t" \
                     "v_fma_f32 %0, %0, %13, %4\n\tv_fma_f32 %1, %1, %14, %5\n\tv_fma_f32 %2, %2, %15, %6\n\tv_fma_f32 %3, %3, %16, %7" \
                     : "+v"(s0), "+v"(s1), "+v"(s2), "+v"(s3), "+v"(vk0_), "+v"(vk1_), "+v"(vk2_), "+v"(vk3_) \
                     : "v"(dA_), "v"(Xb[0]), "v"(Xb[1]), "v"(Xb[2]), "v"(Xb[3]), "v"(Xw[0]), "v"(Xw[1]), "v"(Xw[2]), "v"(Xw[3])); \
        yprev = dB_; } while (0)
#define SC_CMP(X, j0) do { _Pragma("unroll") for (int u_ = 0; u_ < 2; ++u_) { float yp_; \
            SC_STEP(X##a[u_], X##b[u_], X##w[u_], X##k[u_], X##v[u_], rp, yp_); rp = X##r[u_]; \
            { const unsigned long long km_ = 0x0001000100010001ull << (((j0) + u_ + 31) & 15);     \
              asm("v_cndmask_b32_e64 %0, %0, %1, %2" : "+v"(ykeep) : "v"(yp_), "s"(km_)); } \
            if (((j0) + u_) == 16) yb[c] = ykeep; } } while (0)
        float s0 = 0.f, s1 = 0.f, s2 = 0.f, s3 = 0.f;
        f32x4 rp = {0.f, 0.f, 0.f, 0.f}; float ykeep = 0.f;
        f32x4 Ar[2], Aw[2], Ak[2], Aa[2], Ab[2], Br[2], Bw[2], Bk[2], Ba[2], Bb[2]; float Av[2], Bv[2];
        for (int ch = 0; ch < NCH; ++ch) {
            const float* bp = buf + (ch & 1) * SC_STEPS * SC_ROW; float* yb = ybuf + (ch & 1) * 512 + rowq * 32;
            SC_LDG(A, bp);
#pragma unroll 2
            for (int g = 0; g < 16; g += 2) {
                SC_LDG(B, bp + (g + 1) * 2 * SC_ROW);
                __builtin_amdgcn_sched_barrier(0);
                SC_CMP(A, 2 * g);
                __builtin_amdgcn_sched_barrier(0);
                if (g + 2 < 16) SC_LDG(A, bp + (g + 2) * 2 * SC_ROW);
                __builtin_amdgcn_sched_barrier(0);
                SC_CMP(B, 2 * g + 2);
                __builtin_amdgcn_sched_barrier(0);
            }
            { const float y_ = row16_sum_asm(fadd_(ffma_(s1, rp[1], fmul_(s0, rp[0])), ffma_(s3, rp[3], fmul_(s2, rp[2])))); ykeep = (c == 15) ? y_ : ykeep; yb[16 + c] = ykeep; }
            __syncthreads();
        }
#undef SC_LDG
#undef SC_CMP
#undef SC_STEP
    }
    __syncthreads();
}

__device__ __forceinline__ int crow(int r, int hi) { return (r & 3) + 8 * (r >> 2) + 4 * hi; }
constexpr int AT_KROW = 144, AT_VROW = 144, AT_KB = 64 * AT_KROW, AT_VB = 64 * AT_VROW;
constexpr int AT_K0 = 0, AT_V0 = 4 * AT_KB, AT_KM = 4 * AT_KB + 4 * AT_VB;
typedef short tr4_t __attribute__((ext_vector_type(4)));
typedef __attribute__((address_space(3))) tr4_t tr4_lds_t;
typedef __attribute__((address_space(3))) const char* tr_lds_cptr;
__device__ __forceinline__ void attn_unit(const Params& p, unsigned char* lds, int bh, int qb) {
    const int tid = threadIdx.x, lane = tid & 63, wave = __builtin_amdgcn_readfirstlane(tid >> 6), q = lane & 31, hi = lane >> 5;
    const int b = bh >> 3, h = bh & 7;
    const bf16_t* Kp = (const bf16_t*)((const unsigned char*)p.out + OUT_KP);
    const bf16_t* ZMv = (const bf16_t*)(p.ws + WS_ZM); bf16_t* YB = (bf16_t*)p.out;
    const float* KMEAN = (const float*)(p.ws + WS_KMEAN);
    const int ld_r = tid >> 3, ld_c = tid & 7;
    const bf16_t* kbase = Kp + ((size_t)b * SEQ + ld_r) * 512 + h * 64 + ld_c * 8;
    const bf16_t* vbase = ZMv + ((size_t)b * SEQ + ld_r) * 1536 + 1024 + h * 64 + ld_c * 8;
    const int NT = 4 * (qb + 1);
    u32x4 kreg = *(const u32x4*)(kbase), vreg = *(const u32x4*)(vbase), kreg2 = *(const u32x4*)(kbase + (size_t)64 * 512), vreg2 = *(const u32x4*)(vbase + (size_t)64 * 1536);
    float* km = (float*)(lds + AT_KM);
    const float km0 = KMEAN[(size_t)bh * 1024 + tid], km1 = KMEAN[(size_t)bh * 1024 + 512 + tid];
    const size_t qrow = (size_t)b * SEQ + qb * 256 + wave * 32 + q;
    bf16x8 qf[4];
    {
        float qn[32]; u32x4 qraw[4];
#pragma unroll
        for (int kk = 0; kk < 4; ++kk) qraw[kk] = *(const u32x4*)(ZMv + qrow * 1536 + h * 64 + 16 * kk + 8 * hi);
        const int qpos = ((const int*)p.in[I_POS])[qrow];
        km[tid] = km0; km[512 + tid] = km1;
#pragma unroll
        for (int kk = 0; kk < 4; ++kk) unpack8(qraw[kk], qn + 8 * kk);
        float ssq_ = 0.f;
#pragma unroll
        for (int e = 0; e < 32; ++e) ssq_ += qn[e] * qn[e];
        ssq_ += __shfl_xor(ssq_, 32);
        const float rq = rsqrtf(ssq_ * (1.f / 64.f) + 1e-6f);
        const float* qg = p.in[I_QNG];
#pragma unroll
        for (int kk = 0; kk < 4; ++kk)
#pragma unroll
            for (int e = 0; e < 8; ++e) qn[kk * 8 + e] = qn[kk * 8 + e] * rq * qg[16 * kk + 8 * hi + e];
        const float rvh[8] = {0.15915493667125702f, 0.030863763764500618f, 0.005985185503959656f, 0.0011606636689975858f, 0.0002250790857942775f, 4.3647953134495765e-05f, 8.464330676360987e-06f, 1.6414262518082978e-06f};
        const float rvl[8] = {6.4206382432985265e-09f, -6.060805191054897e-10f, 1.7242327010613678e-10f, -4.8028716420622786e-11f, -6.753226016592562e-12f, 1.6772382094298877e-12f, -1.2670839041623722e-13f, -9.854460929453572e-15f};
        const float ps = (float)qpos;
#pragma unroll
        for (int e = 0; e < 8; ++e) { const float hi_ = ps * rvh[e], lo_ = fmaf(ps, rvh[e], -hi_) + ps * rvl[e]; const float fx = (hi_ - floorf(hi_)) + lo_;
            const float sn_ = __builtin_amdgcn_sinf(fx), cs_ = __builtin_amdgcn_cosf(fx); const float other = __shfl_xor(qn[e], 32);
            qn[e] = qn[e] * cs_ + (hi ? other : -other) * sn_; }
#pragma unroll
        for (int kk = 0; kk < 4; ++kk) { const u32x4 w = pack8(qn + 8 * kk); qf[kk] = __builtin_bit_cast(bf16x8, w); }
    }
#define AT_PUT(slot, kr, vr) do { *(u32x4*)(lds + AT_K0 + (slot) * AT_KB + ld_r * AT_KROW + ld_c * 16) = (kr); *(u32x4*)(lds + AT_V0 + (slot) * AT_VB + ld_r * AT_VROW + ld_c * 16) = (vr); } while (0)
    AT_PUT(0, kreg, vreg); AT_PUT(1, kreg2, vreg2);
    __syncthreads();
    unsigned mask = 0u; float mc = 0.f;
    {
        float qv[32];
#pragma unroll
        for (int kk = 0; kk < 4; ++kk)
#pragma unroll
            for (int e = 0; e < 8; ++e) qv[kk * 8 + e] = __uint_as_float(((unsigned)(unsigned short)qf[kk][e]) << 16);
        { float qq = 0.f;
#pragma unroll
          for (int e = 0; e < 32; ++e) qq += qv[e] * qv[e];
          qq += __shfl_xor(qq, 32); mc = sqrtf(qq) * (10.f / 8.f) * 1.4426950408889634f; }
        float g[15];
#pragma unroll
        for (int j = 0; j < 15; ++j) { float s = 0.f;
#pragma unroll
            for (int kk = 0; kk < 4; ++kk)
#pragma unroll
                for (int e = 0; e < 8; ++e) s += qv[kk * 8 + e] * km[j * 64 + 16 * kk + 8 * hi + e];
            s += __shfl_xor(s, 32); g[j] = (j < qb) ? s : -INFINITY; }
#pragma unroll
        for (int pass = 0; pass < 3; ++pass) { float m = g[0]; int idx = 0;
#pragma unroll
            for (int j = 1; j < 15; ++j) if (g[j] > m) { m = g[j]; idx = j; }
            if (m > -INFINITY) mask |= 1u << idx;
#pragma unroll
            for (int j = 0; j < 15; ++j) if (j == idx) g[j] = -INFINITY; }
    }
    const float C = 0.125f * 1.4426950408889634f;
    float l = 0.f;
    f32x16 O0 = {}, O1 = {};
    const int qrel = 32 * wave + q;
    for (int i2 = 0; i2 < NT; i2 += 2) {
        if (i2 + 2 < NT) { const size_t adv = (size_t)(i2 + 2) * 64; kreg = *(const u32x4*)(kbase + adv * 512); vreg = *(const u32x4*)(vbase + adv * 1536);
            kreg2 = *(const u32x4*)(kbase + (adv + 64) * 512); vreg2 = *(const u32x4*)(vbase + (adv + 64) * 1536); }
#pragma unroll 1
      for (int sub = 0; sub < 2; ++sub) { const int i = i2 + sub;
        const int j = i >> 2, kt = i & 3;
        const unsigned char* Kb = lds + AT_K0 + (i & 3) * AT_KB; tr_lds_cptr Vb3 = (tr_lds_cptr)lds + AT_V0 + (i & 3) * AT_VB;
        const bool own = (j == qb);
        const bool act = own ? true : ((mask >> j) & 1u);
        const bool wave_on = own ? (64 * kt <= 32 * wave + 31) : (__ballot(act) != 0ull);
        if (wave_on) {
            f32x16 s0 = {}, s1 = {};
#pragma unroll
            for (int kk = 0; kk < 4; ++kk) {
                const bf16x8 k0 = *(const bf16x8*)(Kb + q * AT_KROW + (16 * kk + 8 * hi) * 2);
                const bf16x8 k1 = *(const bf16x8*)(Kb + (q + 32) * AT_KROW + (16 * kk + 8 * hi) * 2);
                s0 = __builtin_amdgcn_mfma_f32_32x32x16_bf16(k0, qf[kk], s0, 0, 0, 0);
                s1 = __builtin_amdgcn_mfma_f32_32x32x16_bf16(k1, qf[kk], s1, 0, 0, 0);
            }
            if (own) {
#pragma unroll
                for (int r = 0; r < 16; ++r) { const int key = 64 * kt + crow(r, hi); if (key > qrel) s0[r] = -1e30f; if (key + 32 > qrel) s1[r] = -1e30f; }
            } else if (!act) {
#pragma unroll
                for (int r = 0; r < 16; ++r) { s0[r] = -1e30f; s1[r] = -1e30f; }
            }
            float ls = 0.f;
#pragma unroll
            for (int r = 0; r < 16; ++r) { s0[r] = __builtin_amdgcn_exp2f(s0[r] * C - mc); s1[r] = __builtin_amdgcn_exp2f(s1[r] * C - mc); ls += s0[r] + s1[r]; }
            l += ls;
            bf16x8 pf[2][2];
#pragma unroll
            for (int s = 0; s < 2; ++s) {
                u32x4 w0, w1;
                w0.x = cvt_pk_bf16(s0[8 * s + 0], s0[8 * s + 1]); w0.y = cvt_pk_bf16(s0[8 * s + 2], s0[8 * s + 3]); w0.z = cvt_pk_bf16(s0[8 * s + 4], s0[8 * s + 5]); w0.w = cvt_pk_bf16(s0[8 * s + 6], s0[8 * s + 7]);
                w1.x = cvt_pk_bf16(s1[8 * s + 0], s1[8 * s + 1]); w1.y = cvt_pk_bf16(s1[8 * s + 2], s1[8 * s + 3]); w1.z = cvt_pk_bf16(s1[8 * s + 4], s1[8 * s + 5]); w1.w = cvt_pk_bf16(s1[8 * s + 6], s1[8 * s + 7]);
                pf[0][s] = __builtin_bit_cast(bf16x8, w0); pf[1][s] = __builtin_bit_cast(bf16x8, w1);
            }
#pragma unroll
            for (int kh = 0; kh < 2; ++kh)
#pragma unroll
                for (int s = 0; s < 2; ++s) {
                    const int keyq = 32 * kh + 16 * s + 4 * hi + ((lane & 15) >> 2), cb = (16 * ((lane >> 4) & 1) + 4 * (lane & 3)) * 2;
                    const tr4_t a0 = __builtin_amdgcn_ds_read_tr16_b64_v4i16((tr4_lds_t*)(Vb3 + keyq * AT_VROW + cb)), a1 = __builtin_amdgcn_ds_read_tr16_b64_v4i16((tr4_lds_t*)(Vb3 + (keyq + 8) * AT_VROW + cb));
                    const tr4_t c0 = __builtin_amdgcn_ds_read_tr16_b64_v4i16((tr4_lds_t*)(Vb3 + keyq * AT_VROW + cb + 64)), c1 = __builtin_amdgcn_ds_read_tr16_b64_v4i16((tr4_lds_t*)(Vb3 + (keyq + 8) * AT_VROW + cb + 64));
                    const bf16x8 va = {a0[0], a0[1], a0[2], a0[3], a1[0], a1[1], a1[2], a1[3]}, vc = {c0[0], c0[1], c0[2], c0[3], c1[0], c1[1], c1[2], c1[3]};
                    O0 = __builtin_amdgcn_mfma_f32_32x32x16_bf16(va, pf[kh][s], O0, 0, 0, 0);
                    O1 = __builtin_amdgcn_mfma_f32_32x32x16_bf16(vc, pf[kh][s], O1, 0, 0, 0);
                }
        }
      }
        if (i2 + 2 < NT) { AT_PUT((i2 + 2) & 3, kreg, vreg); AT_PUT((i2 + 3) & 3, kreg2, vreg2); }
        __syncthreads();
    }
#undef AT_PUT
    l += __shfl_xor(l, 32);
    const float inv = 1.f / l;
    bf16_t* orow = YB + qrow * 512 + h * 64;
#pragma unroll
    for (int g4 = 0; g4 < 4; ++g4) {
        u32x2 w0, w1;
        w0.x = cvt_pk_bf16(O0[4 * g4 + 0] * inv, O0[4 * g4 + 1] * inv); w0.y = cvt_pk_bf16(O0[4 * g4 + 2] * inv, O0[4 * g4 + 3] * inv);
        w1.x = cvt_pk_bf16(O1[4 * g4 + 0] * inv, O1[4 * g4 + 1] * inv); w1.y = cvt_pk_bf16(O1[4 * g4 + 2] * inv, O1[4 * g4 + 3] * inv);
        *(u32x2*)(orow + 8 * g4 + 4 * hi) = w0; *(u32x2*)(orow + 32 + 8 * g4 + 4 * hi) = w1;
    }
}

__device__ __forceinline__ void phase6(const Params& p) {
    const int tid = threadIdx.x; unsigned char* ws = p.ws;
    const bf16_t* Y = (const bf16_t*)((const unsigned char*)p.out + OUT_VT); const bf16_t* ZR = (const bf16_t*)(ws + WS_ZR); const float* mu = p.in[I_MU]; const bf16_t* G = (const bf16_t*)(ws + WS_G); const float* SBON = (const float*)(ws + WS_SBON);
    bf16_t* YA = (bf16_t*)(ws + WS_YA); const float* ln_g = p.in[I_LNG]; const float* ln_b = p.in[I_LNB];
    const size_t NG = (size_t)T * 64, STR = (size_t)gridDim.x * 512;
    for (size_t idx0 = (size_t)blockIdx.x * 512 + tid; idx0 < NG; idx0 += 4 * STR) {
        f32x4 ya[4][2]; u32x4 rv[4], rpv[4], rg[4]; float sbv[4];
#pragma unroll
        for (int j = 0; j < 4; ++j) { const size_t idx = idx0 + j * STR; const size_t t = idx >> 6; const int c0 = (int)(idx & 63) * 8;
            { const u32x4 yw = *(const u32x4*)(Y + t * 512 + c0); ya[j][0] = (f32x4){bf_lo(yw.x), bf_hi(yw.x), bf_lo(yw.y), bf_hi(yw.y)}; ya[j][1] = (f32x4){bf_lo(yw.z), bf_hi(yw.z), bf_lo(yw.w), bf_hi(yw.w)}; }
            rv[j] = *(const u32x4*)(ZR + t * 2048 + 1024 + c0); rpv[j] = (t & (SEQ - 1)) ? *(const u32x4*)(ZR + (t - 1) * 2048 + 1024 + c0) : (u32x4){0u, 0u, 0u, 0u}; rg[j] = *(const u32x4*)(G + t * 512 + c0); sbv[j] = SBON[t * 8 + (c0 >> 6)]; }
#pragma unroll
        for (int j = 0; j < 4; ++j) { const size_t idx = idx0 + j * STR; const size_t t = idx >> 6; const int c0 = (int)(idx & 63) * 8;
            float y[8] = {ya[j][0][0], ya[j][0][1], ya[j][0][2], ya[j][0][3], ya[j][1][0], ya[j][1][1], ya[j][1][2], ya[j][1][3]};
            float s_ = 0.f;
#pragma unroll
            for (int i = 0; i < 8; ++i) s_ += y[i];
            s_ += __shfl_xor(s_, 1); s_ += __shfl_xor(s_, 2); s_ += __shfl_xor(s_, 4);
            const float mean = s_ * (1.f / 64.f); float q = 0.f;
#pragma unroll
            for (int i = 0; i < 8; ++i) { y[i] -= mean; q += y[i] * y[i]; }
            q += __shfl_xor(q, 1); q += __shfl_xor(q, 2); q += __shfl_xor(q, 4);
            const float rstd = rsqrtf(q * (1.f / 64.f) + 64e-5f);
            float v[8], pv_[8], g[8]; unpack8(rv[j], v); unpack8(rpv[j], pv_); unpack8(rg[j], g);
#pragma unroll
            for (int i = 0; i < 8; ++i) v[i] = v[i] + mu[1024 + c0 + i] * (pv_[i] - v[i]);
#pragma unroll
            for (int i = 0; i < 8; ++i) y[i] = (y[i] * rstd * ln_g[c0 + i] + ln_b[c0 + i] + sbv[j] * v[i]) * g[i];
            *(u32x4*)(YA + t * 512 + c0) = pack8(y); }
    }
}

__device__ __forceinline__ void phase10(const Params& p, bool dry) {
    const int tid = threadIdx.x; bf16_t* U = (bf16_t*)(p.ws + WS_U);
    const float* cw = p.in[I_CW]; const float* cb = p.in[I_CB];
    const size_t NG = (size_t)(T / 64) * 352;
    for (size_t idx = (size_t)blockIdx.x * 512 + tid; idx < NG; idx += (size_t)gridDim.x * 512) {
        const size_t tq = idx / 352; const int c0 = (int)(idx - tq * 352) * 8; const size_t t0 = tq * 64; const int s0 = (int)(t0 & (SEQ - 1));
        u32x4 ra[4], rb[2];
#pragma unroll
        for (int j = 0; j < 4; ++j) { if (j >= 2 || s0 > 0) ra[j] = *(const u32x4*)(U + (t0 + j - 2) * NPROJ + c0); else ra[j] = (u32x4){0u, 0u, 0u, 0u}; }
#pragma unroll
        for (int j = 0; j < 2; ++j) rb[j] = *(const u32x4*)(U + (t0 + j) * NPROJ + DFF + c0);
        float w0[8], w1[8], w2[8], bs[8];
#pragma unroll
        for (int i = 0; i < 8; ++i) { w0[i] = cw[c0 + i]; w1[i] = cw[DFF + c0 + i]; w2[i] = cw[2 * DFF + c0 + i]; bs[i] = cb[c0 + i]; }
        float a2[8], a1[8], a0[8];
        unpack8(ra[0], a2); unpack8(ra[1], a1);
#pragma unroll
        for (int j = 0; j < 2; ++j) {
            float bv[8], o[8]; unpack8(ra[j + 2], a0); unpack8(rb[j], bv);
#pragma unroll
            for (int i = 0; i < 8; ++i) { const float v = w0[i] * a2[i] + w1[i] * a1[i] + w2[i] * a0[i] + bs[i]; o[i] = gelu_erf(v) * bv[i]; a2[i] = a1[i]; a1[i] = a0[i]; }
            if (!dry) *(u32x4*)(U + (t0 + j) * NPROJ + DFF + c0) = pack8(o);
        }
    }
}

#define LAS __attribute__((address_space(3)))
#define XB_TMO      128
#define XB_XCNT(j)  (256  + 64 * (j))
#define XB_XSUB(j)  (1280 + 64 * (j))
#define XB_XGEN(j)  (2304 + 64 * (j))
#define XB_TOP      3328
#define XB_TOPGEN   3392
#define XCD_BAR_WORDS 3456
#define XB_SPIN_CAP (1u << 20)
__device__ __forceinline__ unsigned xb_ld(unsigned* p)              { return __hip_atomic_load(p, __ATOMIC_RELAXED, __HIP_MEMORY_SCOPE_AGENT); }
__device__ __forceinline__ unsigned xb_add(unsigned* p, unsigned v) { return __hip_atomic_fetch_add(p, v, __ATOMIC_RELAXED, __HIP_MEMORY_SCOPE_AGENT); }
__device__ __forceinline__ unsigned xb_xcc_id() { return (unsigned)__builtin_amdgcn_s_getreg((3 << 11) | 20) & 0xFu; }
#define XB_SPIN(cond, bar) do { unsigned _sp = 0; while (cond) { __builtin_amdgcn_s_sleep(1); \
    if ((++_sp & 255u) == 0u) { if (xb_ld(&(bar)[XB_TMO])) break; if (_sp > XB_SPIN_CAP) { atomicAdd(&(bar)[XB_TMO], 1u); break; } } } } while (0)
struct XcdBarrier { unsigned* bar; unsigned x; volatile LAS unsigned* st; };
__device__ __forceinline__ XcdBarrier xcd_barrier_post(unsigned* bar, volatile LAS unsigned* st) {
    XcdBarrier b; b.bar = bar; b.x = xb_xcc_id(); b.st = st;
    if (threadIdx.x == 0) (void)xb_add(&bar[XB_XCNT(b.x)], 1u);
    return b;
}
__device__ __forceinline__ void xcd_barrier_complete(unsigned* bar, unsigned x, unsigned& nloc, unsigned& nx) {
    const unsigned G = gridDim.x * gridDim.y * gridDim.z;
    unsigned sum, cnt, mine, sp = 0u;
    for (;;) {
        sum = 0u; cnt = 0u; mine = 0u;
#pragma unroll
        for (unsigned j = 0; j < 16; ++j) { const unsigned c = xb_ld(&bar[XB_XCNT(j)]); sum += c; cnt += (c > 0u) ? 1u : 0u; mine = (j == x) ? c : mine; }
        if (sum == G) break;
        __builtin_amdgcn_s_sleep(1);
        if ((++sp & 255u) == 0u) { if (xb_ld(&bar[XB_TMO])) break; if (sp > XB_SPIN_CAP) { atomicAdd(&bar[XB_TMO], 1u); break; } }
    }
    nloc = mine > 0u ? mine : 1u; nx = cnt > 0u ? cnt : 1u;
}
__device__ __forceinline__ void xcd_barrier(const XcdBarrier& b) {
    asm volatile("s_waitcnt vmcnt(0)" ::: "memory");
    __syncthreads();
    if (threadIdx.x == 0) {
        unsigned* bar = b.bar;
        __builtin_amdgcn_s_waitcnt(0);
        unsigned nloc = b.st[0], nx = b.st[1];
        if (nloc == 0u) { xcd_barrier_complete(bar, b.x, nloc, nx); b.st[0] = nloc; b.st[1] = nx; }
        const unsigned old = xb_add(&bar[XB_XSUB(b.x)], 1u);
        const unsigned gen = old / nloc;
        if (old + 1u == (gen + 1u) * nloc) {
            __builtin_amdgcn_fence(__ATOMIC_RELEASE, "agent");
            asm volatile("s_waitcnt vmcnt(0)" ::: "memory");
            const unsigned og = xb_add(&bar[XB_TOP], 1u);
            const unsigned tg = og / nx;
            if (og + 1u == (tg + 1u) * nx) xb_add(&bar[XB_TOPGEN], 1u);
            else XB_SPIN(xb_ld(&bar[XB_TOPGEN]) == tg, bar);
            __builtin_amdgcn_fence(__ATOMIC_ACQUIRE, "agent");
            xb_add(&bar[XB_XGEN(b.x)], 1u);
            asm volatile("s_waitcnt vmcnt(0)" ::: "memory");
        } else {
            XB_SPIN(xb_ld(&bar[XB_XGEN(b.x)]) == gen, bar);
            __builtin_amdgcn_fence(__ATOMIC_ACQUIRE, "agent");
            asm volatile("s_waitcnt vmcnt(0)" ::: "memory");
        }
    }
    __syncthreads();
}

#ifndef PROBE_DRY1
#define PROBE_DRY1 0
#endif
#ifndef PROBE_P2PARTS
#define PROBE_P2PARTS 3
#endif
constexpr int NPHASE = 12;
__global__ void __launch_bounds__(512, 2) hybrid_fwd(Params p) {
    extern __shared__ __attribute__((aligned(16))) unsigned char lds[];
    cg::grid_group grid = cg::this_grid();
    PG8_LAS unsigned char* lds3 = (PG8_LAS unsigned char*)lds;
    unsigned char* ws = p.ws;
    const int G = gridDim.x, bx = blockIdx.x;
    const int lo = p.lo, hi = p.hi;
#ifndef PH_MASK
#define PH_MASK 0xFFF
#endif
#define IN(k) (((PH_MASK >> (k)) & 1) && lo <= (k) && (k) < hi)
    if (threadIdx.x < 16) ((volatile LAS unsigned*)(lds3 + LDS_MISC))[16 + threadIdx.x] = 0u;
    __syncthreads();
    const XcdBarrier xbar = xcd_barrier_post((unsigned*)(ws + WS_CTL) + 1024, (volatile LAS unsigned*)(lds3 + LDS_MISC) + 16);
#define RLOOP(k) _Pragma("unroll 1") for (int r_ = 0; r_ < p.rep[k]; ++r_)
#define SEAM(k) do { if (IN(k) && IN((k) + 1)) { if ((k) == 0 && lo < 0) grid.sync(); else xcd_barrier(xbar); } } while (0)
#ifndef REP_EW
#define REP_EW 1
#endif
    if (IN(0)) { RLOOP(0) phase0(p, lds); } SEAM(0);
    if (IN(1)) {
        pg8::Gemm g{(const bf16_t*)(ws + WS_HB), (const bf16_t*)(ws + WS_WIN), T, NPROJ, 1024, 1024, 1024}; pg8::StaticOrder S; S.init(T, NPROJ, G, bx);
        RLOOP(1) { EpiProj E{(bf16_t*)(ws + WS_ZR), (bf16_t*)(ws + WS_ZM), (bf16_t*)(ws + WS_GP), (bf16_t*)((unsigned char*)p.out + OUT_LA), p.in[I_MU], PROBE_DRY1 && (r_ + 1 < p.rep[1])}; pg8::gemm_phase<EpiProj, true>(lds3, g, S, E); }
    } SEAM(1);
    if (IN(2)) { RLOOP(2) phase2(p, lds, r_ == 0 ? 3 : PROBE_P2PARTS); } SEAM(2);
    if (IN(3)) {
        const bf16_t* LA = (const bf16_t*)((const unsigned char*)p.out + OUT_LA);
        RLOOP(3)
#pragma unroll 1
        for (int w = 0; w < 3; ++w) {
            const bf16_t* Bt = (const bf16_t*)(ws + (w == 0 ? WS_WD : (w == 1 ? WS_WA : WS_WG)));
            bf16_t* O = (bf16_t*)(ws + (w == 0 ? WS_E : (w == 1 ? WS_ALR : WS_G)));
            const float* bias = w == 0 ? p.in[I_DB] : p.in[I_AB];
            const int Kw = (w == 2) ? 256 : 128;
            pg8::Gemm g{LA + 128 * w, Bt, T, 512, Kw, 512, Kw}; pg8::StaticOrder S; S.init(T, 512, G, bx);
            EpiLora E{O, bias, w};
            pg8::gemm_phase<EpiLora, true>(lds3, g, S, E);
        }
    } do { if (IN(3) && IN(5)) xcd_barrier(xbar); } while (0);
    if (IN(5)) {
#ifndef REP_SCAN
#define REP_SCAN 1
#endif
        RLOOP(5) scan_block(p, lds, bx);
        volatile unsigned* sh = (volatile unsigned*)(lds + LDS_MISC);
#pragma unroll 1
        for (int rep = 0; rep < p.rep[12]; ++rep) {
        unsigned* qctr = (unsigned*)(ws + WS_CTL) + 64 + 64 * rep;
        unsigned u_next = 0u;
        if (threadIdx.x == 0) u_next = atomicAdd(qctr, 1u);
        for (;;) {
            __syncthreads();
            if (threadIdx.x == 0) sh[0] = u_next;
            __syncthreads();
            const unsigned u = sh[0];
            if (u >= 1024u) break;
            if (threadIdx.x == 0) u_next = atomicAdd(qctr, 1u);
            attn_unit(p, lds, (int)(u & 63u), 15 - (int)(u >> 6));
        }
        }
    } SEAM(5);
    if (IN(6)) { RLOOP(6) phase6(p); } SEAM(6);
#pragma unroll 1
    for (int r_ = 0; r_ < p.rep[13]; ++r_) xcd_barrier(xbar);

    if (IN(7)) {
        const bf16_t* GP = (const bf16_t*)(ws + WS_GP); bf16_t* MG = (bf16_t*)(ws + WS_MG);
#pragma unroll 1
        for (int w = 0; w < 2 * p.rep[7]; ++w) {
            const int second = w & 1;
            pg8::Gemm g{second ? (const bf16_t*)p.out : (const bf16_t*)(ws + WS_YA), (const bf16_t*)(ws + (second ? WS_WBB : WS_WBA)), T, 1024, 512, 512, 512}; pg8::StaticOrder S; S.init(T, 1024, G, bx);
            EpiBranch E{MG, GP, second}; pg8::gemm_phase<EpiBranch, true>(lds3, g, S, E);
        }
    } SEAM(7);
    if (IN(8)) {
        pg8::Gemm g{(const bf16_t*)(ws + WS_MG), (const bf16_t*)(ws + WS_WOUT), T, 1024, 1024, 1024, 1024}; pg8::StaticOrder S; S.init(T, 1024, G, bx);
        EpiOut E{p.in[I_X], p.out, (bf16_t*)(ws + WS_X1B), (float*)(ws + WS_SSQ)};
        RLOOP(8) pg8::gemm_phase<EpiOut, true>(lds3, g, S, E);
    } SEAM(8);
    if (IN(9)) {
        pg8::Gemm g{(const bf16_t*)(ws + WS_X1B), (const bf16_t*)(ws + WS_WUP), T, NPROJ, 1024, 1024, 1024}; pg8::StaticOrder S; S.init(T, NPROJ, G, bx);
        EpiUp E{(bf16_t*)(ws + WS_U), (const float*)(ws + WS_SSQ), p.in[I_CW], p.in[I_CB]};
        RLOOP(9) pg8::gemm_phase<EpiUp, true>(lds3, g, S, E);
    } SEAM(9);
    if (IN(10)) { RLOOP(10) phase10(p, r_ + 1 < p.rep[10]); } SEAM(10);
    if (IN(11)) {
        pg8::Gemm g{(const bf16_t*)(ws + WS_U) + DFF, (const bf16_t*)(ws + WS_WDN), T, 1024, DFF, NPROJ, DFF}; pg8::StaticOrder S; S.init(T, 1024, G, bx);
        RLOOP(11) { EpiDown E{p.out, (const bf16_t*)(ws + WS_X1B), r_ + 1 < p.rep[11]}; pg8::gemm_phase<EpiDown, true>(lds3, g, S, E); }
    }
#undef IN
#undef SEAM
}

extern "C" void kernel_launch(void* const* d_in, const int* in_sizes, int n_in, void* d_out, int out_size, void* d_ws, size_t ws_size, hipStream_t stream) {
    static int grid = 0;
    if (grid == 0) {
        if (n_in != 25 || out_size != T * DM || ws_size < WS_END) { fprintf(stderr, "kernel_launch: unexpected shapes (n_in %d out %d ws %zu)\n", n_in, out_size, ws_size); grid = -1; return; }
        int dev = 0, cus = 0, per_cu = 0;
        hipGetDevice(&dev); hipDeviceGetAttribute(&cus, hipDeviceAttributeMultiprocessorCount, dev);
        if (hipFuncSetAttribute((const void*)hybrid_fwd, hipFuncAttributeMaxDynamicSharedMemorySize, LDS_BYTES) != hipSuccess) { fprintf(stderr, "kernel_launch: hipFuncSetAttribute failed\n"); grid = -1; return; }
        hipOccupancyMaxActiveBlocksPerMultiprocessor(&per_cu, (const void*)hybrid_fwd, 512, LDS_BYTES);
        (void)hipGetLastError();
        if (per_cu < 1) per_cu = 1;
        grid = cus * per_cu; if (grid > 256) grid = 256;
        if (grid != 256) fprintf(stderr, "kernel_launch: grid %d (expected 256)\n", grid);
    }
    if (grid < 0) return;
    (void)hipMemsetAsync((char*)d_ws + WS_CTL, 0, 65536, stream);
    Params p{};
    for (int i = 0; i < 25; ++i) p.in[i] = (const float*)d_in[i];
    p.out = (float*)d_out; p.ws = (unsigned char*)d_ws;
    for (int i = 0; i < 14; ++i) p.rep[i] = 1;
    p.rep[13] = 0;
#ifdef PROBE_SYNCS
    p.rep[13] = PROBE_SYNCS;
#endif
#ifdef PROBE_PHASE
    p.rep[PROBE_PHASE] = 2;
#endif
#ifdef PROBE_PHASE2
    p.rep[PROBE_PHASE2] = 2;
#endif
#if MK_SPLIT
    for (int ph = 0; ph < NPHASE; ++ph) { p.lo = ph; p.hi = ph + 1; void* args[] = {&p};
        hipError_t e = hipLaunchCooperativeKernel((const void*)hybrid_fwd, dim3(grid), dim3(512), args, LDS_BYTES, stream);
        if (e != hipSuccess) { fprintf(stderr, "cooperative launch (phase %d) failed: %s\n", ph, hipGetErrorString(e)); break; } }
#else
    p.lo = 0; p.hi = NPHASE; void* args[] = {&p};
    hipError_t e = hipLaunchCooperativeKernel((const void*)hybrid_fwd, dim3(grid), dim3(512), args, LDS_BYTES, stream);
    if (e != hipSuccess) fprintf(stderr, "cooperative launch failed: %s (grid %d)\n", hipGetErrorString(e), grid);
#endif
}
```

```cpp
#include <hip/hip_runtime.h>
#include <hip/hip_cooperative_groups.h>
#include <cstdio>
#include <cstdint>
namespace cg = cooperative_groups;

#ifndef MK_SPLIT
#define MK_SPLIT 0
#endif

namespace pg8 {
#define PG8_LAS __attribute__((address_space(3)))
typedef unsigned short bf16_t;
typedef short bf16x8 __attribute__((ext_vector_type(8)));
typedef float f32x4 __attribute__((ext_vector_type(4)));
typedef unsigned u32x4 __attribute__((ext_vector_type(4)));
typedef unsigned u32x2 __attribute__((ext_vector_type(2)));
constexpr int BM = 256, BK = 64, HALF = 128, HTB = HALF * BK * 2, STAGE_BYTES = 8 * HTB, NXCD = 8, WGM = 4;

__host__ __device__ __forceinline__ int lds_byte(int r, int c) { const int st = (r >> 4) * 2 + (c >> 5), rr = r & 15, cc = c & 31, ob = rr * 64 + cc * 2; return st * 1024 + (ob ^ (((ob >> 9) & 1) << 5)); }
__host__ __device__ __forceinline__ void stage_rc(int b, int& R, int& C) { const int st = b / 1024, sb = b % 1024, swz = sb ^ (((sb >> 9) & 1) << 5); R = (st >> 1) * 16 + swz / 64; C = (st & 1) * 32 + (swz % 64) / 2; }
__host__ __device__ __forceinline__ int perm32(int rho) { const int n = rho >> 4, i = rho & 15; return 8 * (i >> 2) + 4 * n + (i & 3); }

struct Unit { int pm, pn; };
struct Gemm { const bf16_t* A; const bf16_t* Bt; int M, N, K, lda, ldb; };

struct StaticOrder {
    int nM, nN, nwg, G, c;
    __host__ __device__ void init(int M, int N, int G_, int c_) { nM = M / BM; nN = N / BM; nwg = nM * nN; G = G_; c = c_; }
    __host__ __device__ bool next(int i, Unit& u) const {
        const long L = (long)i * G + c; if (L >= nwg) return false;
        int wgid = (int)L; { const int q = nwg / NXCD, r = nwg % NXCD, xcd = wgid % NXCD, off = wgid / NXCD; wgid = (xcd < r ? xcd * (q + 1) : r * (q + 1) + (xcd - r) * q) + off; }
        const int nig = WGM * nN, gid = wgid / nig, fm = gid * WGM, gsz = (nM - fm) < WGM ? (nM - fm) : WGM;
        u.pm = fm + ((wgid % nig) % gsz); u.pn = (wgid % nig) / gsz; return true;
    }
};

__device__ __forceinline__ unsigned cvt_pk_bf16(float lo, float hi) { unsigned r; asm volatile("v_cvt_pk_bf16_f32 %0, %1, %2" : "=v"(r) : "v"(lo), "v"(hi)); return r; }

template <class Epi, bool ALIGN_EPI>
__device__ __forceinline__ void gemm_phase(PG8_LAS unsigned char* lds, const Gemm g, const StaticOrder& S, const Epi& E) {
    const int tid = threadIdx.x, wid = __builtin_amdgcn_readfirstlane(tid >> 6), lane = tid & 63, wr = wid >> 2, wc = wid & 3, fr = lane & 15, fq = lane >> 4;
    const int K = g.K, nt = K / BK;
    unsigned voffA[2], voffB[2];
#pragma unroll
    for (int i = 0; i < 2; ++i) { int R, C; stage_rc(tid * 16 + i * 8192, R, C); const int Rb = Epi::PERM ? ((R & ~31) + perm32(R & 31)) : R;
        voffA[i] = (unsigned)(R * g.lda + C) * 2u; voffB[i] = (unsigned)(Rb * g.ldb + C) * 2u; }
    const size_t kstep = (size_t)(BK * 2);
    const size_t hstepA = (size_t)HALF * g.lda * 2, hstepB = (size_t)HALF * g.ldb * 2;
    const size_t tstepA = 2 * hstepA, tstepB = 2 * hstepB;
    const unsigned ldsw = (unsigned)wid * 1024u;
    const int aoff = lds_byte(wr * 64 + fr, fq * 8), boff = lds_byte(wc * 32 + fr, fq * 8);
#define PG8_SA(b, h) (((b) * 2 + (h)) * HTB)
#define PG8_SB(b, h) ((4 + (b) * 2 + (h)) * HTB)
#define PG8_STAGE(bufoff, gbase, voff) do { _Pragma("unroll") for (int _i = 0; _i < 2; ++_i) \
        __builtin_amdgcn_global_load_lds((const unsigned*)((const char*)(gbase) + (voff)[_i]), (PG8_LAS unsigned*)(lds + (bufoff) + ldsw + _i * 8192), 16, 0, 0); } while (0)
#define PG8_LDA(dst, b, h) do { _Pragma("unroll") for (int m = 0; m < 4; ++m) _Pragma("unroll") for (int k = 0; k < 2; ++k) dst[m][k] = *(const PG8_LAS bf16x8*)(lds + PG8_SA(b, h) + aoff + m * 2048 + k * 1024); } while (0)
#define PG8_LDB(dst, b, h) do { _Pragma("unroll") for (int n = 0; n < 2; ++n) _Pragma("unroll") for (int k = 0; k < 2; ++k) dst[n][k] = *(const PG8_LAS bf16x8*)(lds + PG8_SB(b, h) + boff + n * 2048 + k * 1024); } while (0)
#define PG8_MMA(ai, bj, At, Bt) do { __builtin_amdgcn_s_setprio(1); _Pragma("unroll") for (int m = 0; m < 4; ++m) _Pragma("unroll") for (int n = 0; n < 2; ++n) _Pragma("unroll") for (int k = 0; k < 2; ++k) \
        acc[ai][bj][m][n] = __builtin_amdgcn_mfma_f32_16x16x32_bf16(Bt[n][k], At[m][k], acc[ai][bj][m][n], 0, 0, 0); __builtin_amdgcn_s_setprio(0); } while (0)
#define PG8_WAIT_V(n) asm volatile("s_waitcnt vmcnt(" #n ")" ::: "memory")
#define PG8_WAIT_L(n) asm volatile("s_waitcnt lgkmcnt(" #n ")" ::: "memory")
#define PG8_BAR __builtin_amdgcn_s_barrier()
#define PG8_SCHED __builtin_amdgcn_sched_barrier(0)
    Unit cur, nxt; int ui = 0;
    if (!S.next(0, cur)) return;
    f32x4 acc[2][2][4][2];
#pragma unroll
    for (int a = 0; a < 2; ++a)
#pragma unroll
        for (int b = 0; b < 2; ++b)
#pragma unroll
            for (int m = 0; m < 4; ++m)
#pragma unroll
                for (int n = 0; n < 2; ++n) acc[a][b][m][n] = (f32x4){0.f, 0.f, 0.f, 0.f};
    bf16x8 At[4][2], B0[2][2], B1[2][2];
    const char* cA = (const char*)g.A + (size_t)cur.pm * tstepA; const char* cB = (const char*)g.Bt + (size_t)cur.pn * tstepB;
    PG8_STAGE(PG8_SB(0, 0), cB, voffB); PG8_STAGE(PG8_SB(0, 1), cB + hstepB, voffB); PG8_STAGE(PG8_SA(0, 0), cA, voffA); PG8_STAGE(PG8_SA(0, 1), cA + hstepA, voffA);
    if (wr == 1) PG8_BAR;
    PG8_WAIT_V(2); PG8_BAR;
    PG8_STAGE(PG8_SB(1, 0), cB + kstep, voffB); PG8_STAGE(PG8_SA(1, 0), cA + kstep, voffA); PG8_STAGE(PG8_SB(1, 1), cB + hstepB + kstep, voffB);
    PG8_WAIT_V(6); PG8_BAR;
    for (;;) {
        const bool has_next = S.next(ui + 1, nxt);
        const char* nA = has_next ? (const char*)g.A + (size_t)nxt.pm * tstepA : cA; const char* nB = has_next ? (const char*)g.Bt + (size_t)nxt.pn * tstepB : cB;
        for (int t = 0; t < nt; t += 2) {
            const bool last = (t == nt - 2);
            const char* a1 = cA + (size_t)(t + 1) * kstep;
            const char* a2 = last ? nA : cA + (size_t)(t + 2) * kstep; const char* b2 = last ? nB : cB + (size_t)(t + 2) * kstep;
            const char* a3 = a2 + kstep; const char* b3 = b2 + kstep;
            PG8_LDB(B0, 0, 0); PG8_LDB(B1, 0, 1); PG8_SCHED; PG8_LDA(At, 0, 0); PG8_STAGE(PG8_SA(1, 1), a1 + hstepA, voffA);
            PG8_WAIT_V(8); PG8_WAIT_L(0); PG8_BAR; PG8_MMA(0, 0, At, B0); PG8_MMA(0, 1, At, B1); PG8_BAR; PG8_SCHED;
            PG8_LDA(At, 0, 1); PG8_STAGE(PG8_SB(0, 0), b2, voffB); PG8_STAGE(PG8_SB(0, 1), b2 + hstepB, voffB); PG8_STAGE(PG8_SA(0, 0), a2, voffA);
            PG8_WAIT_V(8); PG8_WAIT_L(0); PG8_BAR; PG8_MMA(1, 0, At, B0); PG8_MMA(1, 1, At, B1); PG8_BAR; PG8_SCHED;
            PG8_LDB(B0, 1, 0); PG8_LDB(B1, 1, 1); PG8_SCHED; PG8_LDA(At, 1, 0); PG8_STAGE(PG8_SA(0, 1), a2 + hstepA, voffA);
            PG8_WAIT_V(8); PG8_WAIT_L(0); PG8_BAR; PG8_MMA(0, 0, At, B0); PG8_MMA(0, 1, At, B1); PG8_BAR; PG8_SCHED;
            PG8_LDA(At, 1, 1); PG8_STAGE(PG8_SB(1, 0), b3, voffB); PG8_STAGE(PG8_SB(1, 1), b3 + hstepB, voffB); PG8_STAGE(PG8_SA(1, 0), a3, voffA);
            PG8_WAIT_V(8); PG8_WAIT_L(0); PG8_BAR; PG8_MMA(1, 0, At, B0); PG8_MMA(1, 1, At, B1); PG8_BAR; PG8_SCHED;
        }
        if constexpr (ALIGN_EPI) { if (wr == 0) PG8_BAR; }
        E(acc, cur, wr, wc, fr, fq);
        if (!has_next) break;
#pragma unroll
        for (int a = 0; a < 2; ++a)
#pragma unroll
            for (int b = 0; b < 2; ++b)
#pragma unroll
                for (int m = 0; m < 4; ++m)
#pragma unroll
                    for (int n = 0; n < 2; ++n) acc[a][b][m][n] = (f32x4){0.f, 0.f, 0.f, 0.f};
        cur = nxt; cA = nA; cB = nB; ++ui;
        if constexpr (ALIGN_EPI) { if (wr == 1) PG8_BAR; }
    }
    PG8_WAIT_V(0);
    if constexpr (!ALIGN_EPI) { if (wr == 0) PG8_BAR; }
    PG8_BAR;
#undef PG8_SA
#undef PG8_SB
#undef PG8_STAGE
#undef PG8_LDA
#undef PG8_LDB
#undef PG8_MMA
#undef PG8_WAIT_V
#undef PG8_WAIT_L
#undef PG8_BAR
#undef PG8_SCHED
}
}

using pg8::bf16_t; using pg8::f32x4; using pg8::u32x4; using pg8::u32x2; using pg8::bf16x8; using pg8::cvt_pk_bf16;
typedef float f32x16 __attribute__((ext_vector_type(16)));

constexpr int NB = 8, SEQ = 4096, DM = 1024, T = NB * SEQ;
constexpr int NPROJ = 5632;
constexpr int IN_COLS = 5408, DFF = 2816;
constexpr size_t MiB = 1u << 20;
constexpr size_t WS_CTL = 0;
constexpr size_t WS_WIN = 1 * MiB, WS_WUP = 12 * MiB, WS_WDN = 23 * MiB, WS_WOUT = 29 * MiB, WS_WBA = 31 * MiB, WS_WBB = 32 * MiB;
constexpr size_t WS_WD = 33 * MiB, WS_WA = 33 * MiB + 256 * 1024, WS_WG = 33 * MiB + 512 * 1024;
constexpr size_t WS_KMEAN = 34 * MiB, WS_SBON = 35 * MiB, WS_SSQ = 36 * MiB;
constexpr size_t WS_GP = 38 * MiB, WS_ZR = 166 * MiB, WS_ZM = 294 * MiB, WS_HB = 390 * MiB, WS_EX = 454 * MiB, WS_END = 486 * MiB;
constexpr size_t WS_E = WS_HB, WS_ALR = WS_HB + 32 * MiB, WS_G = WS_EX;
constexpr size_t WS_R = WS_ZM, WS_K = WS_ZM + 32 * MiB, WS_V = WS_ZM + 64 * MiB;
constexpr size_t WS_YA = WS_ZM + 64 * MiB,         WS_MG = WS_ZM, WS_X1B = WS_HB, WS_U = WS_GP;
constexpr size_t OUT_LA = 0, OUT_KK = 0, OUT_Q = 32 * MiB, OUT_KP = 64 * MiB, OUT_VT = 96 * MiB;
constexpr int LDS_BYTES = 147456, LDS_MISC = 131072;

struct Params {
    const float* in[25]; float* out; unsigned char* ws; int lo, hi; int rep[14];
};
enum { I_X = 0, I_POS, I_N1G, I_WIN, I_MU, I_WDU, I_DB, I_WAU, I_AB, I_WGU, I_KK, I_KA, I_RK, I_LNG, I_LNB, I_QNG, I_KNG, I_WBA, I_WBB, I_WOUT, I_N2G, I_WUP, I_CW, I_CB, I_WDN };

__device__ __forceinline__ float bf_lo(unsigned w) { return __uint_as_float(w << 16); }
__device__ __forceinline__ float bf_hi(unsigned w) { return __uint_as_float(w & 0xffff0000u); }
__device__ __forceinline__ void unpack8(const u32x4 w, float* f) { f[0] = bf_lo(w.x); f[1] = bf_hi(w.x); f[2] = bf_lo(w.y); f[3] = bf_hi(w.y); f[4] = bf_lo(w.z); f[5] = bf_hi(w.z); f[6] = bf_lo(w.w); f[7] = bf_hi(w.w); }
__device__ __forceinline__ u32x4 pack8(const float* f) { u32x4 w; w.x = cvt_pk_bf16(f[0], f[1]); w.y = cvt_pk_bf16(f[2], f[3]); w.z = cvt_pk_bf16(f[4], f[5]); w.w = cvt_pk_bf16(f[6], f[7]); return w; }
__device__ __forceinline__ size_t hm_idx(size_t t, int c) { return ((((t >> 12) * 8 + (size_t)(c >> 6)) * 4096 + (t & 4095)) << 6) + (size_t)(c & 63); }
__device__ __forceinline__ float sigmoidf_(float x) { return 1.f / (1.f + __expf(-x)); }
__device__ __forceinline__ float wave_sum(float v) {
#pragma unroll
    for (int o = 1; o < 64; o <<= 1) v += __shfl_xor(v, o);
    return v;
}

__device__ __forceinline__ float gelu_erf(float v) {
    const float av = fabsf(v), t = __builtin_amdgcn_rcpf(av * 0.2316418882f + 1.0f);
    float q = t * 0.5307027145f + (-0.7265760135f); q = q * t + 0.7107068705f; q = q * t + (-0.142248368f); q = q * t + 0.127414796f; q = q * t;
    const float e = __builtin_amdgcn_exp2f((v * v) * (-0.72134752044f));
    const float m = v * (q * e);
    return v < 0.f ? m : v - m;
}
template <int CTRL> __device__ __forceinline__ float dpp_mov0(float x) { return __int_as_float(__builtin_amdgcn_update_dpp(0, __float_as_int(x), CTRL, 0xF, 0xF, false)); }
struct EpiProj {
    static constexpr bool PERM = true;
    bf16_t* zr; bf16_t* zm; bf16_t* gp; bf16_t* la; const float* mu; bool dry;
    __device__ __forceinline__ void operator()(const f32x4 (&acc)[2][2][4][2], const pg8::Unit& u, int wr, int wc, int fr, int fq) const {
        if (u.pn == 6 || u.pn == 7) {
            const int row0 = u.pm * 256 + wr * 64 + fr;
#pragma unroll
            for (int bj = 0; bj < 2; ++bj) {
                const int c = u.pn * 256 + bj * 128 + wc * 32 + 8 * fq;
                const int mode = c < 1600 ? 1 : (c < 1664 ? 0 : (c < 1824 ? 2 : 3));
                const int kq = c - 1824;
                const int dc = c < 1600 ? c - 1536 : (c < 1664 ? c - 1600 + 128 : (c < 1824 ? c - 1664 + 256 : (kq < 64 ? 64 + kq : (kq < 128 ? 192 + (kq - 64) : 416 + (kq - 128)))));
                const int mc_ = mode == 3 ? 0 : c;
                const f32x4 mu0 = *(const f32x4*)(mu + mc_), mu1 = *(const f32x4*)(mu + mc_ + 4);
#pragma unroll
                for (int ai = 0; ai < 2; ++ai)
#pragma unroll
                    for (int m = 0; m < 4; ++m) { const size_t row = (size_t)(row0 + ai * 128 + m * 16); float o[8], rawv[8];
#pragma unroll
                        for (int i = 0; i < 8; ++i) { const float cur = acc[ai][bj][m][i >> 2][i & 3];
                            const float oldv = m > 0 ? dpp_mov0<0x121>(acc[ai][bj][m > 0 ? m - 1 : 0][i >> 2][i & 3]) : 0.f;
                            const float prev = __int_as_float(__builtin_amdgcn_update_dpp(__float_as_int(oldv), __float_as_int(cur), 0x111, 0xF, 0xF, false));
                            const float mui = i < 4 ? mu0[i & 3] : mu1[i & 3];
                            const float z = cur + mui * (prev - cur), zz = mode == 1 ? 2.f * z : z, sg = 1.f / (1.f + __expf(-zz));
                            o[i] = mode == 1 ? 2.f * sg - 1.f : (mode == 2 ? sg : (mode == 0 ? z : 0.f)); rawv[i] = cur; }
                        if (!(m == 0 && fr == 0)) *(u32x4*)(la + row * 512 + dc) = pack8(o);
                        if ((m == 0 && fr == 0) || (m == 3 && fr == 15)) *(u32x4*)(zr + row * 2048 + c) = pack8(rawv);
                        asm volatile("" ::: "memory"); }
            }
            return;
        }
        bf16_t* base; int ldc, colt;
        if (u.pn < 8) { base = zr; ldc = 2048; colt = u.pn * 256; } else if (u.pn < 14) { base = zm; ldc = 1536; colt = (u.pn - 8) * 256; } else { base = gp; ldc = 2048; colt = (u.pn - 14) * 256; }
        const int row0 = u.pm * 256 + wr * 64 + fr, col0 = colt + wc * 32 + 8 * fq;
#pragma unroll
        for (int ai = 0; ai < 2; ++ai)
#pragma unroll
            for (int m = 0; m < 4; ++m) { bf16_t* rowp = base + (size_t)(row0 + ai * 128 + m * 16) * ldc + col0;
#pragma unroll
                for (int bj = 0; bj < 2; ++bj) { const f32x4 v0 = acc[ai][bj][m][0], v1 = acc[ai][bj][m][1]; u32x4 w;
                    w.x = cvt_pk_bf16(v0[0], v0[1]); w.y = cvt_pk_bf16(v0[2], v0[3]); w.z = cvt_pk_bf16(v1[0], v1[1]); w.w = cvt_pk_bf16(v1[2], v1[3]);
                    if (!dry) *(u32x4*)(rowp + bj * 128) = w; } }
    }
};
struct EpiLora {
    static constexpr bool PERM = true;
    bf16_t* O; const float* bias; int mode;
    __device__ __forceinline__ void operator()(const f32x4 (&acc)[2][2][4][2], const pg8::Unit& u, int wr, int wc, int fr, int fq) const {
        const int row0 = u.pm * 256 + wr * 64 + fr, col0 = u.pn * 256 + wc * 32 + 8 * fq;
        const float sc = mode == 0 ? 0.6065306597126334f : 1.f;
#pragma unroll
        for (int bj = 0; bj < 2; ++bj) {
            f32x4 b0 = {0.f, 0.f, 0.f, 0.f}, b1 = {0.f, 0.f, 0.f, 0.f};
            if (mode != 2) { b0 = *(const f32x4*)(bias + col0 + bj * 128); b1 = *(const f32x4*)(bias + col0 + bj * 128 + 4); }
#pragma unroll
            for (int ai = 0; ai < 2; ++ai)
#pragma unroll
                for (int m = 0; m < 4; ++m) { const size_t row_ = (size_t)(row0 + ai * 128 + m * 16); bf16_t* rowp = O + (mode == 2 ? row_ * 512 + col0 + bj * 128 : hm_idx(row_, col0 + bj * 128));
                    f32x4 v0 = acc[ai][bj][m][0] + b0, v1 = acc[ai][bj][m][1] + b1;
                    if (mode != 2) {
#pragma unroll
                        for (int i = 0; i < 4; ++i) { v0[i] = sigmoidf_(v0[i]) * sc; v1[i] = sigmoidf_(v1[i]) * sc; } }
                    u32x4 w; w.x = cvt_pk_bf16(v0[0], v0[1]); w.y = cvt_pk_bf16(v0[2], v0[3]); w.z = cvt_pk_bf16(v1[0], v1[1]); w.w = cvt_pk_bf16(v1[2], v1[3]);
                    *(u32x4*)rowp = w;
                    asm volatile("" ::: "memory"); }
        }
    }
};
struct EpiBranch {
    static constexpr bool PERM = true;
    bf16_t* MG; const bf16_t* GP; int second;
    __device__ __forceinline__ void operator()(const f32x4 (&acc)[2][2][4][2], const pg8::Unit& u, int wr, int wc, int fr, int fq) const {
        const int row0 = u.pm * 256 + wr * 64 + fr, col0 = u.pn * 256 + wc * 32 + 8 * fq;
        u32x4 cg[2], cm[2], ng[2], nm[2];
#pragma unroll
        for (int bj = 0; bj < 2; ++bj) { cg[bj] = *(const u32x4*)(GP + (size_t)row0 * 2048 + second * 1024 + col0 + bj * 128);
            cm[bj] = second ? *(const u32x4*)(MG + (size_t)row0 * 1024 + col0 + bj * 128) : (u32x4){0u, 0u, 0u, 0u}; ng[bj] = cg[bj]; nm[bj] = cm[bj]; }
#pragma unroll
        for (int g = 0; g < 8; ++g) { const int ai = g >> 2, m = g & 3; const size_t row = (size_t)(row0 + ai * 128 + m * 16);
            if (g + 1 < 8) { const size_t rown = (size_t)(row0 + ((g + 1) >> 2) * 128 + ((g + 1) & 3) * 16);
#pragma unroll
                for (int bj = 0; bj < 2; ++bj) { ng[bj] = *(const u32x4*)(GP + rown * 2048 + second * 1024 + col0 + bj * 128);
                    if (second) nm[bj] = *(const u32x4*)(MG + rown * 1024 + col0 + bj * 128); }
                asm volatile("" ::: "memory"); }
#pragma unroll
            for (int bj = 0; bj < 2; ++bj) { const int col = col0 + bj * 128; float v[8], gt[8], pv[8];
#pragma unroll
                for (int i = 0; i < 4; ++i) { v[i] = acc[ai][bj][m][0][i]; v[4 + i] = acc[ai][bj][m][1][i]; }
                unpack8(cg[bj], gt); unpack8(cm[bj], pv);
#pragma unroll
                for (int i = 0; i < 8; ++i) v[i] = v[i] * sigmoidf_(gt[i]) + pv[i];
                *(u32x4*)(MG + row * 1024 + col) = pack8(v); }
#pragma unroll
            for (int bj = 0; bj < 2; ++bj) { cg[bj] = ng[bj]; cm[bj] = nm[bj]; } }
    }
};
struct EpiOut {
    static constexpr bool PERM = true;
    const float* x; float* x1; bf16_t* x1b; float* ssq;
    __device__ __forceinline__ void operator()(const f32x4 (&acc)[2][2][4][2], const pg8::Unit& u, int wr, int wc, int fr, int fq) const {
        const int row0 = u.pm * 256 + wr * 64 + fr, col0 = u.pn * 256 + wc * 32 + 8 * fq;
        f32x4 cur[2][2], nxt[2][2];
#pragma unroll
        for (int bj = 0; bj < 2; ++bj)
#pragma unroll
            for (int n = 0; n < 2; ++n) { cur[bj][n] = *(const f32x4*)(x + (size_t)row0 * 1024 + col0 + bj * 128 + n * 4); nxt[bj][n] = cur[bj][n]; }
#pragma unroll
        for (int g = 0; g < 8; ++g) { const int ai = g >> 2, m = g & 3; const size_t row = (size_t)(row0 + ai * 128 + m * 16); float s = 0.f;
            if (g + 1 < 8) { const size_t rown = (size_t)(row0 + ((g + 1) >> 2) * 128 + ((g + 1) & 3) * 16);
#pragma unroll
                for (int bj = 0; bj < 2; ++bj)
#pragma unroll
                    for (int n = 0; n < 2; ++n) nxt[bj][n] = *(const f32x4*)(x + rown * 1024 + col0 + bj * 128 + n * 4);
                asm volatile("" ::: "memory"); }
#pragma unroll
            for (int bj = 0; bj < 2; ++bj) { const size_t off = row * 1024 + col0 + bj * 128;
                const f32x4 r0 = cur[bj][0] + acc[ai][bj][m][0], r1 = cur[bj][1] + acc[ai][bj][m][1];
                u32x4 w; w.x = cvt_pk_bf16(r0[0], r0[1]); w.y = cvt_pk_bf16(r0[2], r0[3]); w.z = cvt_pk_bf16(r1[0], r1[1]); w.w = cvt_pk_bf16(r1[2], r1[3]);
                *(u32x4*)(x1b + off) = w;
                s += ((r0[0] * r0[0] + r0[1] * r0[1]) + (r0[2] * r0[2] + r0[3] * r0[3])) + ((r1[0] * r1[0] + r1[1] * r1[1]) + (r1[2] * r1[2] + r1[3] * r1[3])); }
            s += __shfl_xor(s, 16); s += __shfl_xor(s, 32);
            if (fq == 0) ssq[row * 16 + u.pn * 4 + wc] = s;
#pragma unroll
            for (int bj = 0; bj < 2; ++bj)
#pragma unroll
                for (int n = 0; n < 2; ++n) cur[bj][n] = nxt[bj][n]; }
    }
};
template <int CTRL> __device__ __forceinline__ float dpp_mov(float x) { return __int_as_float(__builtin_amdgcn_update_dpp(0, __float_as_int(x), CTRL, 0xF, 0xF, false)); }
struct EpiUp {
    static constexpr bool PERM = true;
    bf16_t* U; const float* ssq; const float* cw; const float* cb;
    __device__ __forceinline__ void operator()(const f32x4 (&acc)[2][2][4][2], const pg8::Unit& u, int wr, int wc, int fr, int fq) const {
        const int row0 = u.pm * 256 + wr * 64 + fr, cl = u.pn * 128 + wc * 32 + 8 * fq;
#pragma unroll
        for (int n = 0; n < 2; ++n) {
            const int c4 = cl + 4 * n;
            const f32x4 w0 = *(const f32x4*)(cw + c4), w1 = *(const f32x4*)(cw + DFF + c4), w2 = *(const f32x4*)(cw + 2 * DFF + c4), bs = *(const f32x4*)(cb + c4);
            f32x4 cs4[4], ns4[4];
            f32x4 avp = {0.f, 0.f, 0.f, 0.f};
#pragma unroll
            for (int q = 0; q < 4; ++q) { cs4[q] = ((const f32x4*)(ssq + (size_t)row0 * 16))[q]; ns4[q] = cs4[q]; }
#pragma unroll
            for (int g = 0; g < 8; ++g) { const int ai = g >> 2, m = g & 3; const size_t row = (size_t)(row0 + ai * 128 + m * 16);
                if (g + 1 < 8) { const size_t rown = (size_t)(row0 + ((g + 1) >> 2) * 128 + ((g + 1) & 3) * 16);
#pragma unroll
                    for (int q = 0; q < 4; ++q) ns4[q] = ((const f32x4*)(ssq + rown * 16))[q];
                    asm volatile("" ::: "memory"); }
                const f32x4 sa_ = cs4[0], sb_ = cs4[1], sc_ = cs4[2], sd_ = cs4[3];
                const float ss = ((sa_[0] + sa_[1]) + (sa_[2] + sa_[3])) + ((sb_[0] + sb_[1]) + (sb_[2] + sb_[3])) + ((sc_[0] + sc_[1]) + (sc_[2] + sc_[3])) + ((sd_[0] + sd_[1]) + (sd_[2] + sd_[3]));
                const float rstd = rsqrtf(ss * (1.f / 1024.f) + 1e-6f);
                const f32x4 av = acc[ai][0][m][n] * rstd, bv = acc[ai][1][m][n] * rstd; f32x4 o;
#pragma unroll
                for (int i = 0; i < 4; ++i) {
                    const float o1 = m > 0 ? dpp_mov<0x121>(avp[i]) : 0.f, o2 = m > 0 ? dpp_mov<0x122>(avp[i]) : 0.f;
                    const float p1 = __int_as_float(__builtin_amdgcn_update_dpp(__float_as_int(o1), __float_as_int(av[i]), 0x111, 0xF, 0xF, false));
                    const float p2 = __int_as_float(__builtin_amdgcn_update_dpp(__float_as_int(o2), __float_as_int(av[i]), 0x112, 0xF, 0xF, false));
                    const float v = w0[i] * p2 + w1[i] * p1 + w2[i] * av[i] + bs[i]; o[i] = gelu_erf(v) * bv[i]; }
                bf16_t* ua = U + row * NPROJ + c4; bf16_t* ub = ua + DFF;
                u32x2 pa, pb, po; pa.x = cvt_pk_bf16(av[0], av[1]); pa.y = cvt_pk_bf16(av[2], av[3]); pb.x = cvt_pk_bf16(bv[0], bv[1]); pb.y = cvt_pk_bf16(bv[2], bv[3]);
                po.x = cvt_pk_bf16(o[0], o[1]); po.y = cvt_pk_bf16(o[2], o[3]);
                if (fr >= 2 || m > 0) { *(u32x2*)ub = po; if (fr >= 14 && m == 3) *(u32x2*)ua = pa; }
                else { *(u32x2*)ua = pa; *(u32x2*)ub = pb; }
                avp = av;
#pragma unroll
                for (int q = 0; q < 4; ++q) cs4[q] = ns4[q]; }
        }
    }
};
struct EpiDown {
    static constexpr bool PERM = true;
    float* out; const bf16_t* x1b; bool dry;
    __device__ __forceinline__ void operator()(const f32x4 (&acc)[2][2][4][2], const pg8::Unit& u, int wr, int wc, int fr, int fq) const {
        const int row0 = u.pm * 256 + wr * 64 + fr, col0 = u.pn * 256 + wc * 32 + 8 * fq;
        u32x4 cur[2], nxt[2];
#pragma unroll
        for (int bj = 0; bj < 2; ++bj) { cur[bj] = *(const u32x4*)(x1b + (size_t)row0 * 1024 + col0 + bj * 128); nxt[bj] = cur[bj]; }
#pragma unroll
        for (int g = 0; g < 8; ++g) { const int ai = g >> 2, m = g & 3; const size_t row = (size_t)(row0 + ai * 128 + m * 16);
            if (g + 1 < 8) { const size_t rown = (size_t)(row0 + ((g + 1) >> 2) * 128 + ((g + 1) & 3) * 16);
#pragma unroll
                for (int bj = 0; bj < 2; ++bj) nxt[bj] = *(const u32x4*)(x1b + rown * 1024 + col0 + bj * 128);
                asm volatile("" ::: "memory"); }
#pragma unroll
            for (int bj = 0; bj < 2; ++bj) { const size_t off = row * 1024 + col0 + bj * 128; const u32x4 xb = cur[bj];
                const f32x4 x0 = {bf_lo(xb.x), bf_hi(xb.x), bf_lo(xb.y), bf_hi(xb.y)}, x1 = {bf_lo(xb.z), bf_hi(xb.z), bf_lo(xb.w), bf_hi(xb.w)};
                const f32x4 r0 = x0 + acc[ai][bj][m][0], r1 = x1 + acc[ai][bj][m][1];
                if (!dry) { *(f32x4*)(out + off) = r0; *(f32x4*)(out + off + 4) = r1; } }
#pragma unroll
            for (int bj = 0; bj < 2; ++bj) cur[bj] = nxt[bj]; }
    }
};

__device__ __forceinline__ void tr_item(const float* W, int Ksrc, int Nsrc, int srccol0, const float* rowscale, bf16_t* WT, int ldk, int n0, int k0, float* scr, int lane) {
    float v[32]; const int nn = lane & 31; const bool colok = srccol0 >= 0; const float* Wc = W + (colok ? srccol0 : 0) + nn;
#pragma unroll
    for (int i = 0; i < 32; ++i) { const int k = k0 + 2 * i + (lane >> 5); const bool ok = colok && k < Ksrc; const int kc = ok ? k : 0;
        float t = Wc[(size_t)kc * Nsrc]; if (rowscale) t *= rowscale[kc]; v[i] = ok ? t : 0.f; }
#pragma unroll
    for (int i = 0; i < 32; ++i) scr[(2 * i + (lane >> 5)) * 33 + nn] = v[i];
    asm volatile("s_waitcnt lgkmcnt(0)" ::: "memory");
    const int c = lane & 7;
#pragma unroll
    for (int j = 0; j < 4; ++j) { const int n = (lane >> 3) + 8 * j; const float* s = scr + (8 * c) * 33 + n;
        u32x4 o; o.x = cvt_pk_bf16(s[0 * 33], s[1 * 33]); o.y = cvt_pk_bf16(s[2 * 33], s[3 * 33]); o.z = cvt_pk_bf16(s[4 * 33], s[5 * 33]); o.w = cvt_pk_bf16(s[6 * 33], s[7 * 33]);
        *(u32x4*)(WT + (size_t)(n0 + n) * ldk + k0 + 8 * c) = o; }
    asm volatile("s_waitcnt lgkmcnt(0)" ::: "memory");
}
__device__ __forceinline__ void phase0(const Params& p, unsigned char* lds) {
    const int tid = threadIdx.x, lane = tid & 63, wave = tid >> 6;
    float* scr = (float*)(lds + wave * 16384);
    const int gw = blockIdx.x * 8 + wave, NGW = gridDim.x * 8;
    unsigned char* ws = p.ws;
    constexpr int I_1 = 16 * 176, I_2 = 16 * 176, I_3 = 44 * 32, I_4 = 16 * 32, I_5 = 8 * 32, I_6 = 8 * 32, I_7 = 2 * 16, I_8 = 2 * 16, I_9 = 4 * 16;
    constexpr int NIT = I_1 + I_2 + I_3 + I_4 + I_5 + I_6 + I_7 + I_8 + I_9;
    for (int it = gw; it < NIT; it += NGW) {
        int r = it;
        if (r < I_1) { const int kb = r / 176, nb = r % 176, n0 = nb * 32; const int sc = n0 < 1824 ? n0 : (n0 < 2048 ? -1 : n0 - 224);
            tr_item(p.in[I_WIN], 1024, IN_COLS, sc, nullptr, (bf16_t*)(ws + WS_WIN), 1024, n0, kb * 64, scr, lane); continue; } r -= I_1;
        if (r < I_2) { const int kb = r / 176, nb = r % 176; const int n0 = nb * 32, pn_ = n0 >> 8, w_ = n0 & 255; const int sc = w_ < 128 ? 128 * pn_ + w_ : DFF + 128 * pn_ + (w_ - 128);
            tr_item(p.in[I_WUP], 1024, 5632, sc, p.in[I_N2G], (bf16_t*)(ws + WS_WUP), 1024, n0, kb * 64, scr, lane); continue; } r -= I_2;
        if (r < I_3) { const int kb = r / 32, nb = r % 32; tr_item(p.in[I_WDN], 2816, 1024, nb * 32, nullptr, (bf16_t*)(ws + WS_WDN), 2816, nb * 32, kb * 64, scr, lane); continue; } r -= I_3;
        if (r < I_4) { const int kb = r / 32, nb = r % 32; tr_item(p.in[I_WOUT], 1024, 1024, nb * 32, nullptr, (bf16_t*)(ws + WS_WOUT), 1024, nb * 32, kb * 64, scr, lane); continue; } r -= I_4;
        if (r < I_5) { const int kb = r / 32, nb = r % 32; tr_item(p.in[I_WBA], 512, 1024, nb * 32, nullptr, (bf16_t*)(ws + WS_WBA), 512, nb * 32, kb * 64, scr, lane); continue; } r -= I_5;
        if (r < I_6) { const int kb = r / 32, nb = r % 32; tr_item(p.in[I_WBB], 512, 1024, nb * 32, nullptr, (bf16_t*)(ws + WS_WBB), 512, nb * 32, kb * 64, scr, lane); continue; } r -= I_6;
        if (r < I_7) { const int kb = r / 16, nb = r % 16; tr_item(p.in[I_WDU], 64, 512, nb * 32, nullptr, (bf16_t*)(ws + WS_WD), 128, nb * 32, kb * 64, scr, lane); continue; } r -= I_7;
        if (r < I_8) { const int kb = r / 16, nb = r % 16; tr_item(p.in[I_WAU], 64, 512, nb * 32, nullptr, (bf16_t*)(ws + WS_WA), 128, nb * 32, kb * 64, scr, lane); continue; } r -= I_8;
        { const int kb = r / 16, nb = r % 16; tr_item(p.in[I_WGU], 160, 512, nb * 32, nullptr, (bf16_t*)(ws + WS_WG), 256, nb * 32, kb * 64, scr, lane); }
    }
    const float* x = p.in[I_X]; const float* g1 = p.in[I_N1G]; bf16_t* hb = (bf16_t*)(ws + WS_HB);
    f32x4 gv[4];
#pragma unroll
    for (int j = 0; j < 4; ++j) gv[j] = *(const f32x4*)(g1 + 4 * lane + 256 * j);
    for (int m0 = gw; m0 < T; m0 += 4 * NGW) {
        f32x4 v[4][4];
#pragma unroll
        for (int j = 0; j < 4; ++j) { const f32x4* xr = (const f32x4*)(x + (size_t)(m0 + j * NGW) * DM) + lane;
#pragma unroll
            for (int q = 0; q < 4; ++q) v[j][q] = xr[64 * q]; }
#pragma unroll
        for (int j = 0; j < 4; ++j) { float s = 0.f;
#pragma unroll
            for (int q = 0; q < 4; ++q) s += (v[j][q][0] * v[j][q][0] + v[j][q][1] * v[j][q][1]) + (v[j][q][2] * v[j][q][2] + v[j][q][3] * v[j][q][3]);
            const float rstd = rsqrtf(wave_sum(s) * (1.f / DM) + 1e-6f);
            u32x2* o8 = (u32x2*)(hb + (size_t)(m0 + j * NGW) * DM) + lane;
#pragma unroll
            for (int q = 0; q < 4; ++q) { const f32x4 y = v[j][q] * rstd * gv[q]; u32x2 w; w.x = cvt_pk_bf16(y[0], y[1]); w.y = cvt_pk_bf16(y[2], y[3]); o8[64 * q] = w; } }
    }
}

__device__ __forceinline__ void phase2(const Params& p, unsigned char* lds, int parts) {
    const int tid = threadIdx.x;
    unsigned char* ws = p.ws;
    const bf16_t* ZM = (const bf16_t*)(ws + WS_ZM); const bf16_t* ZR = (const bf16_t*)(ws + WS_ZR);
    bf16_t* Qp = (bf16_t*)((unsigned char*)p.out + OUT_Q); bf16_t* Kp = (bf16_t*)((unsigned char*)p.out + OUT_KP); bf16_t* VT = (bf16_t*)((unsigned char*)p.out + OUT_VT);
    bf16_t* LA = (bf16_t*)((unsigned char*)p.out + OUT_LA);
    float* KMEAN = (float*)(ws + WS_KMEAN);
    const int* pos = (const int*)p.in[I_POS];
    float* kl = (float*)lds;
    unsigned short* vl = (unsigned short*)(lds + 256 * 65 * 4);
    const int tok = tid >> 1, half = tid & 1;
    const float rvh[8] = {0.15915493667125702f, 0.030863763764500618f, 0.005985185503959656f, 0.0011606636689975858f, 0.0002250790857942775f, 4.3647953134495765e-05f, 8.464330676360987e-06f, 1.6414262518082978e-06f};
    const float rvl[8] = {6.4206382432985265e-09f, -6.060805191054897e-10f, 1.7242327010613678e-10f, -4.8028716420622786e-11f, -6.753226016592562e-12f, 1.6772382094298877e-12f, -1.2670839041623722e-13f, -9.854460929453572e-15f};
    u32x4 nraw[2][4]; int npos = 0;
#define P2_LOAD(it_) do { const int h_ = (it_) & 7, blk_ = ((it_) >> 3) & 15, b_ = (it_) >> 7; const size_t t_ = (size_t)b_ * SEQ + blk_ * 256 + tok; npos = pos[t_]; \
        _Pragma("unroll") for (int w3 = 1; w3 < 2; ++w3) _Pragma("unroll") for (int j = 0; j < 4; ++j) nraw[w3][j] = *(const u32x4*)(ZM + t_ * 1536 + w3 * 512 + h_ * 64 + 32 * half + 8 * j); } while (0)
    if ((parts & 1) && (int)blockIdx.x < 1024) P2_LOAD((int)blockIdx.x);
    if (parts & 1)
    for (int item = blockIdx.x; item < 1024; item += gridDim.x) {
        const int h = item & 7, blk = (item >> 3) & 15, b = item >> 7;
        const size_t t = (size_t)b * SEQ + blk * 256 + tok;
        u32x4 raw[2][4]; const int cpos = npos;
#pragma unroll
        for (int w3 = 1; w3 < 2; ++w3)
#pragma unroll
            for (int j = 0; j < 4; ++j) raw[w3][j] = nraw[w3][j];
        if (item + (int)gridDim.x < 1024) P2_LOAD(item + (int)gridDim.x);
        float cs[8], sn[8];
        { const float ps = (float)cpos;
#pragma unroll
          for (int i = 0; i < 8; ++i) { const float hi_ = ps * rvh[i], lo_ = fmaf(ps, rvh[i], -hi_) + ps * rvl[i];
              const float fx = (hi_ - floorf(hi_)) + lo_; sn[i] = __builtin_amdgcn_sinf(fx); cs[i] = __builtin_amdgcn_cosf(fx); } }
#pragma unroll
        for (int which = 1; which < 2; ++which) {
            const float* gg = p.in[which ? I_KNG : I_QNG] + 32 * half;
            float v[32];
#pragma unroll
            for (int j = 0; j < 4; ++j) unpack8(raw[which][j], v + 8 * j);
            float ss = 0.f;
#pragma unroll
            for (int i = 0; i < 32; ++i) ss += v[i] * v[i];
            ss += __shfl_xor(ss, 1);
            const float rstd = rsqrtf(ss * (1.f / 64.f) + 1e-6f);
#pragma unroll
            for (int i = 0; i < 32; ++i) v[i] = v[i] * rstd * gg[i];
            if (half == 0) {
#pragma unroll
                for (int i = 0; i < 8; ++i) { const float x1 = v[i], x2 = v[8 + i]; v[i] = x1 * cs[i] - x2 * sn[i]; v[8 + i] = x2 * cs[i] + x1 * sn[i]; }
            }
            bf16_t* dst = (which ? Kp : Qp) + t * 512 + h * 64 + 32 * half;
#pragma unroll
            for (int j = 0; j < 4; ++j) *(u32x4*)(dst + 8 * j) = pack8(v + 8 * j);
            if (which == 1) {
#pragma unroll
                for (int i = 0; i < 32; ++i) kl[tok * 65 + 32 * half + i] = v[i];
            }
        }
        __syncthreads();
        { float* kp = (float*)(lds + 256 * 65 * 4); const int d_ = tid & 63, part = tid >> 6; float s0_ = 0.f, s1_ = 0.f;
#pragma unroll 8
          for (int r = 0; r < 32; r += 2) { s0_ += kl[(part * 32 + r) * 65 + d_]; s1_ += kl[(part * 32 + r + 1) * 65 + d_]; }
          kp[part * 64 + d_] = s0_ + s1_; }
        __syncthreads();
        if (tid < 64) { const float* kp = (const float*)(lds + 256 * 65 * 4); float s_ = 0.f;
#pragma unroll
            for (int q8 = 0; q8 < 8; ++q8) s_ += kp[q8 * 64 + tid];
            KMEAN[((size_t)(b * 8 + h) * 16 + blk) * 64 + tid] = s_ * (1.f / 256.f); }
    }
    __syncthreads();
    const float* mu = p.in[I_MU];
    const size_t NG = (parts & 2) ? (size_t)(T / 64) * 64 : 0;
    for (size_t idx = (size_t)blockIdx.x * 512 + tid; idx < NG; idx += (size_t)gridDim.x * 512) {
        const size_t t = (idx >> 6) * 64; const int dc = (int)(idx & 63) * 8; int sc = -1, mode = 0;
        if (dc < 64) { sc = 1536 + dc; mode = 1; } else if (dc >= 128 && dc < 192) { sc = 1600 + dc - 128; mode = 0; } else if (dc >= 256 && dc < 416) { sc = 1664 + dc - 256; mode = 2; }
        float v[8];
#pragma unroll
        for (int i = 0; i < 8; ++i) v[i] = 0.f;
        if (sc >= 0) { float a[8], pr[8]; unpack8(*(const u32x4*)(ZR + t * 2048 + sc), a);
            if ((t & (SEQ - 1)) != 0) unpack8(*(const u32x4*)(ZR + (t - 1) * 2048 + sc), pr); else {
#pragma unroll
                for (int i = 0; i < 8; ++i) pr[i] = 0.f; }
#pragma unroll
            for (int i = 0; i < 8; ++i) { const float z = a[i] + mu[sc + i] * (pr[i] - a[i]); v[i] = mode == 1 ? tanhf(z) : (mode == 2 ? sigmoidf_(z) : z); } }
        *(u32x4*)(LA + t * 512 + dc) = pack8(v);
    }
}

__device__ __forceinline__ void phase4(const Params& p) {
    const int tid = threadIdx.x; unsigned char* ws = p.ws;
    const bf16_t* ZR = (const bf16_t*)(ws + WS_ZR); const bf16_t* ALR = (const bf16_t*)(ws + WS_ALR);
    bf16_t* R = (bf16_t*)(ws + WS_R); bf16_t* K = (bf16_t*)(ws + WS_K); bf16_t* V = (bf16_t*)(ws + WS_V); bf16_t* KK = (bf16_t*)((unsigned char*)p.out + OUT_KK);
    float* SBON = (float*)(ws + WS_SBON);
    const float* mu = p.in[I_MU]; const float* k_k = p.in[I_KK]; const float* k_a = p.in[I_KA]; const float* r_k = p.in[I_RK];
    const size_t NG = (size_t)(T / 2) * 64;
    for (size_t idx = (size_t)blockIdx.x * 512 + tid; idx < NG; idx += (size_t)gridDim.x * 512) {
        const size_t t0 = (idx >> 6) * 2; const int c0 = (int)(idx & 63) * 8;
        const bool first = (t0 & (SEQ - 1)) == 0;
        u32x4 raw[3][3], ral[2];
#pragma unroll
        for (int j = 0; j < 3; ++j)
#pragma unroll
            for (int w3 = 0; w3 < 3; ++w3) { if (j > 0 || !first) raw[j][w3] = *(const u32x4*)(ZR + (t0 + j - 1) * 2048 + w3 * 512 + c0); else raw[j][w3] = (u32x4){0u, 0u, 0u, 0u}; }
        const size_t hm0 = hm_idx(t0, c0);
        ral[0] = *(const u32x4*)(ALR + hm0); ral[1] = *(const u32x4*)(ALR + hm0 + 64);
        float muv[3][8], kkw[8], kaw[8], rkw[8];
#pragma unroll
        for (int i = 0; i < 8; ++i) { muv[0][i] = mu[c0 + i]; muv[1][i] = mu[512 + c0 + i]; muv[2][i] = mu[1024 + c0 + i]; kkw[i] = k_k[c0 + i]; kaw[i] = k_a[c0 + i]; rkw[i] = r_k[c0 + i]; }
#pragma unroll
        for (int j = 0; j < 2; ++j) {
            float z[3][8], pr[8], al[8];
#pragma unroll
            for (int w3 = 0; w3 < 3; ++w3) { unpack8(raw[j + 1][w3], z[w3]); unpack8(raw[j][w3], pr);
#pragma unroll
                for (int i = 0; i < 8; ++i) z[w3][i] = z[w3][i] + muv[w3][i] * (pr[i] - z[w3][i]); }
            unpack8(ral[j], al);
            float kk[8], km[8]; float ss = 0.f, sb = 0.f;
#pragma unroll
            for (int i = 0; i < 8; ++i) { kk[i] = z[1][i] * kkw[i]; ss += kk[i] * kk[i]; km[i] = z[1][i] * (1.f + (al[i] - 1.f) * kaw[i]); sb += z[0][i] * km[i] * rkw[i]; }
            ss += __shfl_xor(ss, 1); ss += __shfl_xor(ss, 2); ss += __shfl_xor(ss, 4);
            sb += __shfl_xor(sb, 1); sb += __shfl_xor(sb, 2); sb += __shfl_xor(sb, 4);
            const float inv = 1.f / fmaxf(sqrtf(ss), 1e-12f);
#pragma unroll
            for (int i = 0; i < 8; ++i) kk[i] *= inv;
            const size_t hm = hm0 + 64 * j;
            *(u32x4*)(R + hm) = pack8(z[0]); *(u32x4*)(K + hm) = pack8(km); *(u32x4*)(V + hm) = pack8(z[2]); *(u32x4*)(KK + hm) = pack8(kk);
            if ((idx & 7) == 0) SBON[(t0 + j) * 8 + (c0 >> 6)] = sb;
        }
    }
}

template <int CTRL> __device__ __forceinline__ float dpp_add(float x) {
    const int y = __builtin_amdgcn_update_dpp(0, __float_as_int(x), CTRL, 0xF, 0xF, false);
    return x + __int_as_float(y);
}
__device__ __forceinline__ float row16_sum(float x) {
    x = dpp_add<0xB1>(x);
    x = dpp_add<0x4E>(x);
    x = dpp_add<0x141>(x);
    x = dpp_add<0x140>(x);
    return x;
}
typedef float f32x2 __attribute__((ext_vector_type(2)));
__device__ __forceinline__ float fmul_(float a, float b) { float d; asm("v_mul_f32_e32 %0, %1, %2" : "=v"(d) : "v"(a), "v"(b)); return d; }
__device__ __forceinline__ float fadd_(float a, float b) { float d; asm("v_add_f32_e32 %0, %1, %2" : "=v"(d) : "v"(a), "v"(b)); return d; }
__device__ __forceinline__ float ffma_(float a, float b, float c) { float d; asm("v_fma_f32 %0, %1, %2, %3" : "=v"(d) : "v"(a), "v"(b), "v"(c)); return d; }
__device__ __forceinline__ float row16_sum_asm(float x) {
    float d;
    asm("s_nop 1\n\tv_add_f32_dpp %0, %1, %1 quad_perm:[1,0,3,2] row_mask:0xf bank_mask:0xf\n\t"
        "s_nop 1\n\tv_add_f32_dpp %0, %0, %0 quad_perm:[2,3,0,1] row_mask:0xf bank_mask:0xf\n\t"
        "s_nop 1\n\tv_add_f32_dpp %0, %0, %0 row_half_mirror row_mask:0xf bank_mask:0xf\n\t"
        "s_nop 1\n\tv_add_f32_dpp %0, %0, %0 row_mirror row_mask:0xf bank_mask:0xf" : "=&v"(d) : "v"(x));
    return d;
}
constexpr int SC_STEPS = 32, SC_ROW = 336;
__device__ __forceinline__ void scan_block(const Params& p, unsigned char* lds, int sb) {
    const int tid = threadIdx.x, lane = tid & 63, wave = __builtin_amdgcn_readfirstlane(tid >> 6);
    unsigned char* ws = p.ws;
    const bf16_t* ALR = (const bf16_t*)(ws + WS_ALR); const bf16_t* E = (const bf16_t*)(ws + WS_E);
    bf16_t* Y = (bf16_t*)((unsigned char*)p.out + OUT_VT);
    const int xi_ = sb >> 3, quarter = xi_ & 3, bh = (sb & 7) + 8 * (xi_ >> 2), b = bh >> 3, h = bh & 7;
    float* buf = (float*)lds;
    float* ybuf = (float*)(lds + 2 * SC_STEPS * SC_ROW * 4);
    const size_t rowbase = (size_t)b * SEQ;
    constexpr int NCH = SEQ / SC_STEPS;
    if (wave >= 4) {
        const int lt = tid - 256, st_tok = lt >> 3, st_c = lt & 7;
        const bf16_t* ZR = (const bf16_t*)(ws + WS_ZR); float* SBON = (float*)(ws + WS_SBON);
        const int hc = h * 64 + st_c * 8;
        float mur[8], muk[8], muv[8], kkw[8], kaw[8], rkw[8];
#pragma unroll
        for (int i = 0; i < 8; ++i) { mur[i] = p.in[I_MU][hc + i]; muk[i] = p.in[I_MU][512 + hc + i]; muv[i] = p.in[I_MU][1024 + hc + i]; kkw[i] = p.in[I_KK][hc + i]; kaw[i] = p.in[I_KA][hc + i]; rkw[i] = p.in[I_RK][hc + i]; }
        u32x4 Pr, Pk, Pv, Ppr, Ppk, Ppv, Pa, Pe, Qr, Qk, Qv, Qpr, Qpk, Qpv, Qa, Qe;
#define SC_LOAD(X, ch) do { const int s_ = (ch) * SC_STEPS + st_tok; const bf16_t* zr_ = ZR + (rowbase + s_) * 2048 + hc; \
        X##r = *(const u32x4*)(zr_); X##k = *(const u32x4*)(zr_ + 512); X##v = *(const u32x4*)(zr_ + 1024); \
        if (s_ > 0) { X##pr = *(const u32x4*)(zr_ - 2048); X##pk = *(const u32x4*)(zr_ - 2048 + 512); X##pv = *(const u32x4*)(zr_ - 2048 + 1024); } \
        else { X##pr = (u32x4){0u, 0u, 0u, 0u}; X##pk = X##pr; X##pv = X##pr; } \
        const size_t o_ = (((size_t)bh * SEQ) + s_) * 64 + st_c * 8; X##a = *(const u32x4*)(ALR + o_); X##e = *(const u32x4*)(E + o_); } while (0)
#define SC_STORE(X, ch) do { float* bq = buf + ((ch) & 1) * SC_STEPS * SC_ROW; \
        float fr_[8], fk_[8], fv_[8], fp_[8], fa_[8], fe_[8], fkk_[8], fkm_[8]; \
        unpack8(X##r, fr_); unpack8(X##pr, fp_); _Pragma("unroll") for (int i_ = 0; i_ < 8; ++i_) fr_[i_] = fr_[i_] + mur[i_] * (fp_[i_] - fr_[i_]); \
        unpack8(X##k, fk_); unpack8(X##pk, fp_); _Pragma("unroll") for (int i_ = 0; i_ < 8; ++i_) fk_[i_] = fk_[i_] + muk[i_] * (fp_[i_] - fk_[i_]); \
        unpack8(X##v, fv_); unpack8(X##pv, fp_); _Pragma("unroll") for (int i_ = 0; i_ < 8; ++i_) fv_[i_] = fv_[i_] + muv[i_] * (fp_[i_] - fv_[i_]); \
        unpack8(X##a, fa_); unpack8(X##e, fe_); \
        float ss_ = 0.f, sb_ = 0.f; \
        _Pragma("unroll") for (int i_ = 0; i_ < 8; ++i_) { fkk_[i_] = fk_[i_] * kkw[i_]; ss_ += fkk_[i_] * fkk_[i_]; fkm_[i_] = fk_[i_] * (1.f + (fa_[i_] - 1.f) * kaw[i_]); } \
        ss_ += __shfl_xor(ss_, 1); ss_ += __shfl_xor(ss_, 2); ss_ += __shfl_xor(ss_, 4); \
        const float inv_ = 1.f / fmaxf(sqrtf(ss_), 1e-12f); \
        _Pragma("unroll") for (int i_ = 0; i_ < 8; ++i_) fkk_[i_] *= inv_; \
        if (quarter == 0) {   \
          _Pragma("unroll") for (int i_ = 0; i_ < 8; ++i_) sb_ += fr_[i_] * fkm_[i_] * rkw[i_]; \
          sb_ += __shfl_xor(sb_, 1); sb_ += __shfl_xor(sb_, 2); sb_ += __shfl_xor(sb_, 4); \
          if (st_c == 0) SBON[(rowbase + (size_t)(ch) * SC_STEPS + st_tok) * 8 + h] = sb_; } \
        { float* q = bq + st_tok * SC_ROW + st_c * 8; f32x4 o0, o1; \
          o0 = (f32x4){fr_[0], fr_[1], fr_[2], fr_[3]}; o1 = (f32x4){fr_[4], fr_[5], fr_[6], fr_[7]}; *(f32x4*)(q) = o0; *(f32x4*)(q + 4) = o1; \
          o0 = (f32x4){__expf(-fe_[0]), __expf(-fe_[1]), __expf(-fe_[2]), __expf(-fe_[3])}; o1 = (f32x4){__expf(-fe_[4]), __expf(-fe_[5]), __expf(-fe_[6]), __expf(-fe_[7])}; *(f32x4*)(q + 64) = o0; *(f32x4*)(q + 68) = o1; \
          o0 = (f32x4){fkm_[0], fkm_[1], fkm_[2], fkm_[3]}; o1 = (f32x4){fkm_[4], fkm_[5], fkm_[6], fkm_[7]}; *(f32x4*)(q + 128) = o0; *(f32x4*)(q + 132) = o1; \
          o0 = (f32x4){-fkk_[0], -fkk_[1], -fkk_[2], -fkk_[3]}; o1 = (f32x4){-fkk_[4], -fkk_[5], -fkk_[6], -fkk_[7]}; *(f32x4*)(q + 192) = o0; *(f32x4*)(q + 196) = o1; \
          o0 = (f32x4){fkk_[0] * fa_[0], fkk_[1] * fa_[1], fkk_[2] * fa_[2], fkk_[3] * fa_[3]}; o1 = (f32x4){fkk_[4] * fa_[4], fkk_[5] * fa_[5], fkk_[6] * fa_[6], fkk_[7] * fa_[7]}; *(f32x4*)(q + 256) = o0; *(f32x4*)(q + 260) = o1; } \
        if ((st_c >> 1) == quarter) { float* q = bq + st_tok * SC_ROW + 320 + (st_c & 1) * 8; \
          *(f32x4*)(q) = (f32x4){fv_[0], fv_[1], fv_[2], fv_[3]}; *(f32x4*)(q + 4) = (f32x4){fv_[4], fv_[5], fv_[6], fv_[7]}; } } while (0)
#define SC_FLUSH(ch) do { const float* yq = ybuf + ((ch) & 1) * 512; const int tk = lt >> 3, r2 = (lt & 7) * 2; \
        f32x2 o; o.x = yq[r2 * 32 + tk]; o.y = yq[(r2 + 1) * 32 + tk]; \
        *(unsigned*)(Y + (rowbase + (size_t)(ch) * SC_STEPS + tk) * 512 + h * 64 + quarter * 16 + r2) = cvt_pk_bf16(o.x, o.y); } while (0)
        SC_LOAD(Q, 0); SC_STORE(Q, 0); SC_LOAD(P, 1); SC_LOAD(Q, 2);
        __syncthreads();
        for (int ch = 0; ch < NCH; ch += 2) {
            SC_STORE(P, ch + 1);
            if (ch + 3 < NCH) SC_LOAD(P, ch + 3);
            if (ch >= 1) SC_FLUSH(ch - 1);
            __syncthreads();
            if (ch + 2 < NCH) SC_STORE(Q, ch + 2);
            if (ch + 4 < NCH) SC_LOAD(Q, ch + 4);
            SC_FLUSH(ch);
            __syncthreads();
        }
        SC_FLUSH(NCH - 1);
#undef SC_LOAD
#undef SC_STORE
#undef SC_FLUSH
    } else {
        __syncthreads();
        const int c = lane & 15, rowq = wave * 4 + (lane >> 4);
#define SC_LDG(X, base) do { _Pragma("unroll") for (int u_ = 0; u_ < 2; ++u_) { const float* q_ = (base) + u_ * SC_ROW; \
            X##r[u_] = *(const f32x4*)(q_ + 4 * c); X##w[u_] = *(const f32x4*)(q_ + 64 + 4 * c); X##k[u_] = *(const f32x4*)(q_ + 128 + 4 * c); \
            X##a[u_] = *(const f32x4*)(q_ + 192 + 4 * c); X##b[u_] = *(const f32x4*)(q_ + 256 + 4 * c); X##v[u_] = q_[320 + rowq]; } } while (0)
#define SC_STEP(Xa, Xb, Xw, Xk, Xv, RP, yprev) do { float dA_, dB_, vk0_, vk1_, vk2_, vk3_; \
        asm volatile("v_mul_f32_e32 %0, %2, %6\n\tv_mul_f32_e32 %1, %2, %10\n\t" \
                     "v_fma_f32 %0, %3, %7, %0\n\tv_fma_f32 %1, %3, %11, %1\n\t" \
                     "v_fma_f32 %0, %4, %8, %0\n\tv_fma_f32 %1, %4, %12, %1\n\t" \
                     "v_fma_f32 %0, %5, %9, %0\n\tv_fma_f32 %1, %5, %13, %1" \
                     : "=&v"(dA_), "=&v"(dB_) \
                     : "v"(s0), "v"(s1), "v"(s2), "v"(s3), "v"(Xa[0]), "v"(Xa[1]), "v"(Xa[2]), "v"(Xa[3]), "v"(RP[0]), "v"(RP[1]), "v"(RP[2]), "v"(RP[3])); \
        asm volatile("v_mul_f32_e32 %2, %6, %10\n\t" \
                     "v_add_f32_dpp %0, %0, %0 quad_perm:[1,0,3,2] row_mask:0xf bank_mask:0xf\n\tv_add_f32_dpp %1, %1, %1 quad_perm:[1,0,3,2] row_mask:0xf bank_mask:0xf\n\t" \
                     "v_mul_f32_e32 %3, %7, %10\n\t" \
                     "v_add_f32_dpp %0, %0, %0 quad_perm:[2,3,0,1] row_mask:0xf bank_mask:0xf\n\tv_add_f32_dpp %1, %1, %1 quad_perm:[2,3,0,1] row_mask:0xf bank_mask:0xf\n\t" \
                     "v_mul_f32_e32 %4, %8, %10\n\t" \
                     "v_add_f32_dpp %0, %0, %0 row_half_mirror row_mask:0xf bank_mask:0xf\n\tv_add_f32_dpp %1, %1, %1 row_half_mirror row_mask:0xf bank_mask:0xf\n\t" \
                     "v_mul_f32_e32 %5, %9, %10\n\t" \
                     "v_add_f32_dpp %0, %0, %0 row_mirror row_mask:0xf bank_mask:0xf\n\tv_add_f32_dpp %1, %1, %1 row_mirror row_mask:0xf bank_mask:0xf" \
                     : "+v"(dA_), "+v"(dB_), "=&v"(vk0_), "=&v"(vk1_), "=&v"(vk2_), "=&v"(vk3_) \
                     : "v"(Xk[0]), "v"(Xk[1]), "v"(Xk[2]), "v"(Xk[3]), "v"(Xv)); \
        asm volatile("v_fma_f32 %4, %8, %9, %4\n\tv_fma_f32 %5, %8, %10, %5\n\tv_fma_f32 %6, %8, %11, %6\n\tv_fma_f32 %7, %8, %12, %7\n\t" \
                     "v_fma_f32 %0, %0, %13, %4\n\tv_fma_f32 %1, %1, %14, %5\n\tv_fma_f32 %2, %2, %15, %6\n\tv_fma_f32 %3, %3, %16, %7" \
                     : "+v"(s0), "+v"(s1), "+v"(s2), "+v"(s3), "+v"(vk0_), "+v"(vk1_), "+v"(vk2_), "+v"(vk3_) \
                     : "v"(dA_), "v"(Xb[0]), "v"(Xb[1]), "v"(Xb[2]), "v"(Xb[3]), "v"(Xw[0]), "v"(Xw[1]), "v"(Xw[2]), "v"(Xw[3])); \
        yprev = dB_; } while (0)
#define SC_CMP(X, j0) do { _Pragma("unroll") for (int u_ = 0; u_ < 2; ++u_) { float yp_; \
            SC_STEP(X##a[u_], X##b[u_], X##w[u_], X##k[u_], X##v[u_], rp, yp_); rp = X##r[u_]; \
            { const unsigned long long km_ = 0x0001000100010001ull << (((j0) + u_ + 31) & 15);     \
              asm("v_cndmask_b32_e64 %0, %0, %1, %2" : "+v"(ykeep) : "v"(yp_), "s"(km_)); } \
            if (((j0) + u_) == 16) yb[c] = ykeep; } } while (0)
        float s0 = 0.f, s1 = 0.f, s2 = 0.f, s3 = 0.f;
        f32x4 rp = {0.f, 0.f, 0.f, 0.f}; float ykeep = 0.f;
        f32x4 Ar[2], Aw[2], Ak[2], Aa[2], Ab[2], Br[2], Bw[2], Bk[2], Ba[2], Bb[2]; float Av[2], Bv[2];
        for (int ch = 0; ch < NCH; ++ch) {
            const float* bp = buf + (ch & 1) * SC_STEPS * SC_ROW; float* yb = ybuf + (ch & 1) * 512 + rowq * 32;
            SC_LDG(A, bp);
#pragma unroll 2
            for (int g = 0; g < 16; g += 2) {
                SC_LDG(B, bp + (g + 1) * 2 * SC_ROW);
                __builtin_amdgcn_sched_barrier(0);
                SC_CMP(A, 2 * g);
                __builtin_amdgcn_sched_barrier(0);
                if (g + 2 < 16) SC_LDG(A, bp + (g + 2) * 2 * SC_ROW);
                __builtin_amdgcn_sched_barrier(0);
                SC_CMP(B, 2 * g + 2);
                __builtin_amdgcn_sched_barrier(0);
            }
            { const float y_ = row16_sum_asm(fadd_(ffma_(s1, rp[1], fmul_(s0, rp[0])), ffma_(s3, rp[3], fmul_(s2, rp[2])))); ykeep = (c == 15) ? y_ : ykeep; yb[16 + c] = ykeep; }
            __syncthreads();
        }
#undef SC_LDG
#undef SC_CMP
#undef SC_STEP
    }
    __syncthreads();
}

__device__ __forceinline__ int crow(int r, int hi) { return (r & 3) + 8 * (r >> 2) + 4 * hi; }
constexpr int AT_KROW = 144, AT_VROW = 144, AT_KB = 64 * AT_KROW, AT_VB = 64 * AT_VROW;
constexpr int AT_K0 = 0, AT_V0 = 4 * AT_KB, AT_KM = 4 * AT_KB + 4 * AT_VB;
typedef short tr4_t __attribute__((ext_vector_type(4)));
typedef __attribute__((address_space(3))) tr4_t tr4_lds_t;
typedef __attribute__((address_space(3))) const char* tr_lds_cptr;
__device__ __forceinline__ void attn_unit(const Params& p, unsigned char* lds, int bh, int qb) {
    const int tid = threadIdx.x, lane = tid & 63, wave = __builtin_amdgcn_readfirstlane(tid >> 6), q = lane & 31, hi = lane >> 5;
    const int b = bh >> 3, h = bh & 7;
    const bf16_t* Kp = (const bf16_t*)((const unsigned char*)p.out + OUT_KP);
    const bf16_t* ZMv = (const bf16_t*)(p.ws + WS_ZM); bf16_t* YB = (bf16_t*)p.out;
    const float* KMEAN = (const float*)(p.ws + WS_KMEAN);
    const int ld_r = tid >> 3, ld_c = tid & 7;
    const bf16_t* kbase = Kp + ((size_t)b * SEQ + ld_r) * 512 + h * 64 + ld_c * 8;
    const bf16_t* vbase = ZMv + ((size_t)b * SEQ + ld_r) * 1536 + 1024 + h * 64 + ld_c * 8;
    const int NT = 4 * (qb + 1);
    u32x4 kreg = *(const u32x4*)(kbase), vreg = *(const u32x4*)(vbase), kreg2 = *(const u32x4*)(kbase + (size_t)64 * 512), vreg2 = *(const u32x4*)(vbase + (size_t)64 * 1536);
    float* km = (float*)(lds + AT_KM);
    const float km0 = KMEAN[(size_t)bh * 1024 + tid], km1 = KMEAN[(size_t)bh * 1024 + 512 + tid];
    const size_t qrow = (size_t)b * SEQ + qb * 256 + wave * 32 + q;
    bf16x8 qf[4];
    {
        float qn[32]; u32x4 qraw[4];
#pragma unroll
        for (int kk = 0; kk < 4; ++kk) qraw[kk] = *(const u32x4*)(ZMv + qrow * 1536 + h * 64 + 16 * kk + 8 * hi);
        const int qpos = ((const int*)p.in[I_POS])[qrow];
        km[tid] = km0; km[512 + tid] = km1;
#pragma unroll
        for (int kk = 0; kk < 4; ++kk) unpack8(qraw[kk], qn + 8 * kk);
        float ssq_ = 0.f;
#pragma unroll
        for (int e = 0; e < 32; ++e) ssq_ += qn[e] * qn[e];
        ssq_ += __shfl_xor(ssq_, 32);
        const float rq = rsqrtf(ssq_ * (1.f / 64.f) + 1e-6f);
        const float* qg = p.in[I_QNG];
#pragma unroll
        for (int kk = 0; kk < 4; ++kk)
#pragma unroll
            for (int e = 0; e < 8; ++e) qn[kk * 8 + e] = qn[kk * 8 + e] * rq * qg[16 * kk + 8 * hi + e];
        const float rvh[8] = {0.15915493667125702f, 0.030863763764500618f, 0.005985185503959656f, 0.0011606636689975858f, 0.0002250790857942775f, 4.3647953134495765e-05f, 8.464330676360987e-06f, 1.6414262518082978e-06f};
        const float rvl[8] = {6.4206382432985265e-09f, -6.060805191054897e-10f, 1.7242327010613678e-10f, -4.8028716420622786e-11f, -6.753226016592562e-12f, 1.6772382094298877e-12f, -1.2670839041623722e-13f, -9.854460929453572e-15f};
        const float ps = (float)qpos;
#pragma unroll
        for (int e = 0; e < 8; ++e) { const float hi_ = ps * rvh[e], lo_ = fmaf(ps, rvh[e], -hi_) + ps * rvl[e]; const float fx = (hi_ - floorf(hi_)) + lo_;
            const float sn_ = __builtin_amdgcn_sinf(fx), cs_ = __builtin_amdgcn_cosf(fx); const float other = __shfl_xor(qn[e], 32);
            qn[e] = qn[e] * cs_ + (hi ? other : -other) * sn_; }
#pragma unroll
        for (int kk = 0; kk < 4; ++kk) { const u32x4 w = pack8(qn + 8 * kk); qf[kk] = __builtin_bit_cast(bf16x8, w); }
    }
#define AT_PUT(slot, kr, vr) do { *(u32x4*)(lds + AT_K0 + (slot) * AT_KB + ld_r * AT_KROW + ld_c * 16) = (kr); *(u32x4*)(lds + AT_V0 + (slot) * AT_VB + ld_r * AT_VROW + ld_c * 16) = (vr); } while (0)
    AT_PUT(0, kreg, vreg); AT_PUT(1, kreg2, vreg2);
    __syncthreads();
    unsigned mask = 0u; float mc = 0.f;
    {
        float qv[32];
#pragma unroll
        for (int kk = 0; kk < 4; ++kk)
#pragma unroll
            for (int e = 0; e < 8; ++e) qv[kk * 8 + e] = __uint_as_float(((unsigned)(unsigned short)qf[kk][e]) << 16);
        { float qq = 0.f;
#pragma unroll
          for (int e = 0; e < 32; ++e) qq += qv[e] * qv[e];
          qq += __shfl_xor(qq, 32); mc = sqrtf(qq) * (10.f / 8.f) * 1.4426950408889634f; }
        float g[15];
#pragma unroll
        for (int j = 0; j < 15; ++j) { float s = 0.f;
#pragma unroll
            for (int kk = 0; kk < 4; ++kk)
#pragma unroll
                for (int e = 0; e < 8; ++e) s += qv[kk * 8 + e] * km[j * 64 + 16 * kk + 8 * hi + e];
            s += __shfl_xor(s, 32); g[j] = (j < qb) ? s : -INFINITY; }
#pragma unroll
        for (int pass = 0; pass < 3; ++pass) { float m = g[0]; int idx = 0;
#pragma unroll
            for (int j = 1; j < 15; ++j) if (g[j] > m) { m = g[j]; idx = j; }
            if (m > -INFINITY) mask |= 1u << idx;
#pragma unroll
            for (int j = 0; j < 15; ++j) if (j == idx) g[j] = -INFINITY; }
    }
    const float C = 0.125f * 1.4426950408889634f;
    float l = 0.f;
    f32x16 O0 = {}, O1 = {};
    const int qrel = 32 * wave + q;
    for (int i2 = 0; i2 < NT; i2 += 2) {
        if (i2 + 2 < NT) { const size_t adv = (size_t)(i2 + 2) * 64; kreg = *(const u32x4*)(kbase + adv * 512); vreg = *(const u32x4*)(vbase + adv * 1536);
            kreg2 = *(const u32x4*)(kbase + (adv + 64) * 512); vreg2 = *(const u32x4*)(vbase + (adv + 64) * 1536); }
#pragma unroll 1
      for (int sub = 0; sub < 2; ++sub) { const int i = i2 + sub;
        const int j = i >> 2, kt = i & 3;
        const unsigned char* Kb = lds + AT_K0 + (i & 3) * AT_KB; tr_lds_cptr Vb3 = (tr_lds_cptr)lds + AT_V0 + (i & 3) * AT_VB;
        const bool own = (j == qb);
        const bool act = own ? true : ((mask >> j) & 1u);
        const bool wave_on = own ? (64 * kt <= 32 * wave + 31) : (__ballot(act) != 0ull);
        if (wave_on) {
            f32x16 s0 = {}, s1 = {};
#pragma unroll
            for (int kk = 0; kk < 4; ++kk) {
                const bf16x8 k0 = *(const bf16x8*)(Kb + q * AT_KROW + (16 * kk + 8 * hi) * 2);
                const bf16x8 k1 = *(const bf16x8*)(Kb + (q + 32) * AT_KROW + (16 * kk + 8 * hi) * 2);
                s0 = __builtin_amdgcn_mfma_f32_32x32x16_bf16(k0, qf[kk], s0, 0, 0, 0);
                s1 = __builtin_amdgcn_mfma_f32_32x32x16_bf16(k1, qf[kk], s1, 0, 0, 0);
            }
            if (own) {
#pragma unroll
                for (int r = 0; r < 16; ++r) { const int key = 64 * kt + crow(r, hi); if (key > qrel) s0[r] = -1e30f; if (key + 32 > qrel) s1[r] = -1e30f; }
            } else if (!act) {
#pragma unroll
                for (int r = 0; r < 16; ++r) { s0[r] = -1e30f; s1[r] = -1e30f; }
            }
            float ls = 0.f;
#pragma unroll
            for (int r = 0; r < 16; ++r) { s0[r] = __builtin_amdgcn_exp2f(s0[r] * C - mc); s1[r] = __builtin_amdgcn_exp2f(s1[r] * C - mc); ls += s0[r] + s1[r]; }
            l += ls;
            bf16x8 pf[2][2];
#pragma unroll
            for (int s = 0; s < 2; ++s) {
                u32x4 w0, w1;
                w0.x = cvt_pk_bf16(s0[8 * s + 0], s0[8 * s + 1]); w0.y = cvt_pk_bf16(s0[8 * s + 2], s0[8 * s + 3]); w0.z = cvt_pk_bf16(s0[8 * s + 4], s0[8 * s + 5]); w0.w = cvt_pk_bf16(s0[8 * s + 6], s0[8 * s + 7]);
                w1.x = cvt_pk_bf16(s1[8 * s + 0], s1[8 * s + 1]); w1.y = cvt_pk_bf16(s1[8 * s + 2], s1[8 * s + 3]); w1.z = cvt_pk_bf16(s1[8 * s + 4], s1[8 * s + 5]); w1.w = cvt_pk_bf16(s1[8 * s + 6], s1[8 * s + 7]);
                pf[0][s] = __builtin_bit_cast(bf16x8, w0); pf[1][s] = __builtin_bit_cast(bf16x8, w1);
            }
#pragma unroll
            for (int kh = 0; kh < 2; ++kh)
#pragma unroll
                for (int s = 0; s < 2; ++s) {
                    const int keyq = 32 * kh + 16 * s + 4 * hi + ((lane & 15) >> 2), cb = (16 * ((lane >> 4) & 1) + 4 * (lane & 3)) * 2;
                    const tr4_t a0 = __builtin_amdgcn_ds_read_tr16_b64_v4i16((tr4_lds_t*)(Vb3 + keyq * AT_VROW + cb)), a1 = __builtin_amdgcn_ds_read_tr16_b64_v4i16((tr4_lds_t*)(Vb3 + (keyq + 8) * AT_VROW + cb));
                    const tr4_t c0 = __builtin_amdgcn_ds_read_tr16_b64_v4i16((tr4_lds_t*)(Vb3 + keyq * AT_VROW + cb + 64)), c1 = __builtin_amdgcn_ds_read_tr16_b64_v4i16((tr4_lds_t*)(Vb3 + (keyq + 8) * AT_VROW + cb + 64));
                    const bf16x8 va = {a0[0], a0[1], a0[2], a0[3], a1[0], a1[1], a1[2], a1[3]}, vc = {c0[0], c0[1], c0[2], c0[3], c1[0], c1[1], c1[2], c1[3]};
                    O0 = __builtin_amdgcn_mfma_f32_32x32x16_bf16(va, pf[kh][s], O0, 0, 0, 0);
                    O1 = __builtin_amdgcn_mfma_f32_32x32x16_bf16(vc, pf[kh][s], O1, 0, 0, 0);
                }
        }
      }
        if (i2 + 2 < NT) { AT_PUT((i2 + 2) & 3, kreg, vreg); AT_PUT((i2 + 3) & 3, kreg2, vreg2); }
        __syncthreads();
    }
#undef AT_PUT
    l += __shfl_xor(l, 32);
    const float inv = 1.f / l;
    bf16_t* orow = YB + qrow * 512 + h * 64;
#pragma unroll
    for (int g4 = 0; g4 < 4; ++g4) {
        u32x2 w0, w1;
        w0.x = cvt_pk_bf16(O0[4 * g4 + 0] * inv, O0[4 * g4 + 1] * inv); w0.y = cvt_pk_bf16(O0[4 * g4 + 2] * inv, O0[4 * g4 + 3] * inv);
        w1.x = cvt_pk_bf16(O1[4 * g4 + 0] * inv, O1[4 * g4 + 1] * inv); w1.y = cvt_pk_bf16(O1[4 * g4 + 2] * inv, O1[4 * g4 + 3] * inv);
        *(u32x2*)(orow + 8 * g4 + 4 * hi) = w0; *(u32x2*)(orow + 32 + 8 * g4 + 4 * hi) = w1;
    }
}

__device__ __forceinline__ void phase6(const Params& p) {
    const int tid = threadIdx.x; unsigned char* ws = p.ws;
    const bf16_t* Y = (const bf16_t*)((const unsigned char*)p.out + OUT_VT); const bf16_t* ZR = (const bf16_t*)(ws + WS_ZR); const float* mu = p.in[I_MU]; const bf16_t* G = (const bf16_t*)(ws + WS_G); const float* SBON = (const float*)(ws + WS_SBON);
    bf16_t* YA = (bf16_t*)(ws + WS_YA); const float* ln_g = p.in[I_LNG]; const float* ln_b = p.in[I_LNB];
    const size_t NG = (size_t)T * 64, STR = (size_t)gridDim.x * 512;
    for (size_t idx0 = (size_t)blockIdx.x * 512 + tid; idx0 < NG; idx0 += 4 * STR) {
        f32x4 ya[4][2]; u32x4 rv[4], rpv[4], rg[4]; float sbv[4];
#pragma unroll
        for (int j = 0; j < 4; ++j) { const size_t idx = idx0 + j * STR; const size_t t = idx >> 6; const int c0 = (int)(idx & 63) * 8;
            { const u32x4 yw = *(const u32x4*)(Y + t * 512 + c0); ya[j][0] = (f32x4){bf_lo(yw.x), bf_hi(yw.x), bf_lo(yw.y), bf_hi(yw.y)}; ya[j][1] = (f32x4){bf_lo(yw.z), bf_hi(yw.z), bf_lo(yw.w), bf_hi(yw.w)}; }
            rv[j] = *(const u32x4*)(ZR + t * 2048 + 1024 + c0); rpv[j] = (t & (SEQ - 1)) ? *(const u32x4*)(ZR + (t - 1) * 2048 + 1024 + c0) : (u32x4){0u, 0u, 0u, 0u}; rg[j] = *(const u32x4*)(G + t * 512 + c0); sbv[j] = SBON[t * 8 + (c0 >> 6)]; }
#pragma unroll
        for (int j = 0; j < 4; ++j) { const size_t idx = idx0 + j * STR; const size_t t = idx >> 6; const int c0 = (int)(idx & 63) * 8;
            float y[8] = {ya[j][0][0], ya[j][0][1], ya[j][0][2], ya[j][0][3], ya[j][1][0], ya[j][1][1], ya[j][1][2], ya[j][1][3]};
            float s_ = 0.f;
#pragma unroll
            for (int i = 0; i < 8; ++i) s_ += y[i];
            s_ += __shfl_xor(s_, 1); s_ += __shfl_xor(s_, 2); s_ += __shfl_xor(s_, 4);
            const float mean = s_ * (1.f / 64.f); float q = 0.f;
#pragma unroll
            for (int i = 0; i < 8; ++i) { y[i] -= mean; q += y[i] * y[i]; }
            q += __shfl_xor(q, 1); q += __shfl_xor(q, 2); q += __shfl_xor(q, 4);
            const float rstd = rsqrtf(q * (1.f / 64.f) + 64e-5f);
            float v[8], pv_[8], g[8]; unpack8(rv[j], v); unpack8(rpv[j], pv_); unpack8(rg[j], g);
#pragma unroll
            for (int i = 0; i < 8; ++i) v[i] = v[i] + mu[1024 + c0 + i] * (pv_[i] - v[i]);
#pragma unroll
            for (int i = 0; i < 8; ++i) y[i] = (y[i] * rstd * ln_g[c0 + i] + ln_b[c0 + i] + sbv[j] * v[i]) * g[i];
            *(u32x4*)(YA + t * 512 + c0) = pack8(y); }
    }
}

__device__ __forceinline__ void phase10(const Params& p, bool dry) {
    const int tid = threadIdx.x; bf16_t* U = (bf16_t*)(p.ws + WS_U);
    const float* cw = p.in[I_CW]; const float* cb = p.in[I_CB];
    const size_t NG = (size_t)(T / 64) * 352;
    for (size_t idx = (size_t)blockIdx.x * 512 + tid; idx < NG; idx += (size_t)gridDim.x * 512) {
        const size_t tq = idx / 352; const int c0 = (int)(idx - tq * 352) * 8; const size_t t0 = tq * 64; const int s0 = (int)(t0 & (SEQ - 1));
        u32x4 ra[4], rb[2];
#pragma unroll
        for (int j = 0; j < 4; ++j) { if (j >= 2 || s0 > 0) ra[j] = *(const u32x4*)(U + (t0 + j - 2) * NPROJ + c0); else ra[j] = (u32x4){0u, 0u, 0u, 0u}; }
#pragma unroll
        for (int j = 0; j < 2; ++j) rb[j] = *(const u32x4*)(U + (t0 + j) * NPROJ + DFF + c0);
        float w0[8], w1[8], w2[8], bs[8];
#pragma unroll
        for (int i = 0; i < 8; ++i) { w0[i] = cw[c0 + i]; w1[i] = cw[DFF + c0 + i]; w2[i] = cw[2 * DFF + c0 + i]; bs[i] = cb[c0 + i]; }
        float a2[8], a1[8], a0[8];
        unpack8(ra[0], a2); unpack8(ra[1], a1);
#pragma unroll
        for (int j = 0; j < 2; ++j) {
            float bv[8], o[8]; unpack8(ra[j + 2], a0); unpack8(rb[j], bv);
#pragma unroll
            for (int i = 0; i < 8; ++i) { const float v = w0[i] * a2[i] + w1[i] * a1[i] + w2[i] * a0[i] + bs[i]; o[i] = gelu_erf(v) * bv[i]; a2[i] = a1[i]; a1[i] = a0[i]; }
            if (!dry) *(u32x4*)(U + (t0 + j) * NPROJ + DFF + c0) = pack8(o);
        }
    }
}

#define LAS __attribute__((address_space(3)))
#define XB_TMO      128
#define XB_XCNT(j)  (256  + 64 * (j))
#define XB_XSUB(j)  (1280 + 64 * (j))
#define XB_XGEN(j)  (2304 + 64 * (j))
#define XB_TOP      3328
#define XB_TOPGEN   3392
#define XCD_BAR_WORDS 3456
#define XB_SPIN_CAP (1u << 20)
__device__ __forceinline__ unsigned xb_ld(unsigned* p)              { return __hip_atomic_load(p, __ATOMIC_RELAXED, __HIP_MEMORY_SCOPE_AGENT); }
__device__ __forceinline__ unsigned xb_add(unsigned* p, unsigned v) { return __hip_atomic_fetch_add(p, v, __ATOMIC_RELAXED, __HIP_MEMORY_SCOPE_AGENT); }
__device__ __forceinline__ unsigned xb_xcc_id() { return (unsigned)__builtin_amdgcn_s_getreg((3 << 11) | 20) & 0xFu; }
#define XB_SPIN(cond, bar) do { unsigned _sp = 0; while (cond) { __builtin_amdgcn_s_sleep(1); \
    if ((++_sp & 255u) == 0u) { if (xb_ld(&(bar)[XB_TMO])) break; if (_sp > XB_SPIN_CAP) { atomicAdd(&(bar)[XB_TMO], 1u); break; } } } } while (0)
struct XcdBarrier { unsigned* bar; unsigned x; volatile LAS unsigned* st; };
__device__ __forceinline__ XcdBarrier xcd_barrier_post(unsigned* bar, volatile LAS unsigned* st) {
    XcdBarrier b; b.bar = bar; b.x = xb_xcc_id(); b.st = st;
    if (threadIdx.x == 0) (void)xb_add(&bar[XB_XCNT(b.x)], 1u);
    return b;
}
__device__ __forceinline__ void xcd_barrier_complete(unsigned* bar, unsigned x, unsigned& nloc, unsigned& nx) {
    const unsigned G = gridDim.x * gridDim.y * gridDim.z;
    unsigned sum, cnt, mine, sp = 0u;
    for (;;) {
        sum = 0u; cnt = 0u; mine = 0u;
#pragma unroll
        for (unsigned j = 0; j < 16; ++j) { const unsigned c = xb_ld(&bar[XB_XCNT(j)]); sum += c; cnt += (c > 0u) ? 1u : 0u; mine = (j == x) ? c : mine; }
        if (sum == G) break;
        __builtin_amdgcn_s_sleep(1);
        if ((++sp & 255u) == 0u) { if (xb_ld(&bar[XB_TMO])) break; if (sp > XB_SPIN_CAP) { atomicAdd(&bar[XB_TMO], 1u); break; } }
    }
    nloc = mine > 0u ? mine : 1u; nx = cnt > 0u ? cnt : 1u;
}
__device__ __forceinline__ void xcd_barrier(const XcdBarrier& b) {
    asm volatile("s_waitcnt vmcnt(0)" ::: "memory");
    __syncthreads();
    if (threadIdx.x == 0) {
        unsigned* bar = b.bar;
        __builtin_amdgcn_s_waitcnt(0);
        unsigned nloc = b.st[0], nx = b.st[1];
        if (nloc == 0u) { xcd_barrier_complete(bar, b.x, nloc, nx); b.st[0] = nloc; b.st[1] = nx; }
        const unsigned old = xb_add(&bar[XB_XSUB(b.x)], 1u);
        const unsigned gen = old / nloc;
        if (old + 1u == (gen + 1u) * nloc) {
            __builtin_amdgcn_fence(__ATOMIC_RELEASE, "agent");
            asm volatile("s_waitcnt vmcnt(0)" ::: "memory");
            const unsigned og = xb_add(&bar[XB_TOP], 1u);
            const unsigned tg = og / nx;
            if (og + 1u == (tg + 1u) * nx) xb_add(&bar[XB_TOPGEN], 1u);
            else XB_SPIN(xb_ld(&bar[XB_TOPGEN]) == tg, bar);
            __builtin_amdgcn_fence(__ATOMIC_ACQUIRE, "agent");
            xb_add(&bar[XB_XGEN(b.x)], 1u);
            asm volatile("s_waitcnt vmcnt(0)" ::: "memory");
        } else {
            XB_SPIN(xb_ld(&bar[XB_XGEN(b.x)]) == gen, bar);
            __builtin_amdgcn_fence(__ATOMIC_ACQUIRE, "agent");
            asm volatile("s_waitcnt vmcnt(0)" ::: "memory");
        }
    }
    __syncthreads();
}

#ifndef PROBE_DRY1
#define PROBE_DRY1 0
#endif
#ifndef PROBE_P2PARTS
#define PROBE_P2PARTS 3
#endif
constexpr int NPHASE = 12;
__global__ void __launch_bounds__(512, 2) hybrid_fwd(Params p) {
    extern __shared__ __attribute__((aligned(16))) unsigned char lds[];
    cg::grid_group grid = cg::this_grid();
    PG8_LAS unsigned char* lds3 = (PG8_LAS unsigned char*)lds;
    unsigned char* ws = p.ws;
    const int G = gridDim.x, bx = blockIdx.x;
    const int lo = p.lo, hi = p.hi;
#ifndef PH_MASK
#define PH_MASK 0xFFF
#endif
#define IN(k) (((PH_MASK >> (k)) & 1) && lo <= (k) && (k) < hi)
    if (threadIdx.x < 16) ((volatile LAS unsigned*)(lds3 + LDS_MISC))[16 + threadIdx.x] = 0u;
    __syncthreads();
    const XcdBarrier xbar = xcd_barrier_post((unsigned*)(ws + WS_CTL) + 1024, (volatile LAS unsigned*)(lds3 + LDS_MISC) + 16);
#define RLOOP(k) _Pragma("unroll 1") for (int r_ = 0; r_ < p.rep[k]; ++r_)
#define SEAM(k) do { if (IN(k) && IN((k) + 1)) { if ((k) == 0 && lo < 0) grid.sync(); else xcd_barrier(xbar); } } while (0)
#ifndef REP_EW
#define REP_EW 1
#endif
    if (IN(0)) { RLOOP(0) phase0(p, lds); } SEAM(0);
    if (IN(1)) {
        pg8::Gemm g{(const bf16_t*)(ws + WS_HB), (const bf16_t*)(ws + WS_WIN), T, NPROJ, 1024, 1024, 1024}; pg8::StaticOrder S; S.init(T, NPROJ, G, bx);
        RLOOP(1) { EpiProj E{(bf16_t*)(ws + WS_ZR), (bf16_t*)(ws + WS_ZM), (bf16_t*)(ws + WS_GP), (bf16_t*)((unsigned char*)p.out + OUT_LA), p.in[I_MU], PROBE_DRY1 && (r_ + 1 < p.rep[1])}; pg8::gemm_phase<EpiProj, true>(lds3, g, S, E); }
    } SEAM(1);
    if (IN(2)) { RLOOP(2) phase2(p, lds, r_ == 0 ? 3 : PROBE_P2PARTS); } SEAM(2);
    if (IN(3)) {
        const bf16_t* LA = (const bf16_t*)((const unsigned char*)p.out + OUT_LA);
        RLOOP(3)
#pragma unroll 1
        for (int w = 0; w < 3; ++w) {
            const bf16_t* Bt = (const bf16_t*)(ws + (w == 0 ? WS_WD : (w == 1 ? WS_WA : WS_WG)));
            bf16_t* O = (bf16_t*)(ws + (w == 0 ? WS_E : (w == 1 ? WS_ALR : WS_G)));
            const float* bias = w == 0 ? p.in[I_DB] : p.in[I_AB];
            const int Kw = (w == 2) ? 256 : 128;
            pg8::Gemm g{LA + 128 * w, Bt, T, 512, Kw, 512, Kw}; pg8::StaticOrder S; S.init(T, 512, G, bx);
            EpiLora E{O, bias, w};
            pg8::gemm_phase<EpiLora, true>(lds3, g, S, E);
        }
    } do { if (IN(3) && IN(5)) xcd_barrier(xbar); } while (0);
    if (IN(5)) {
#ifndef REP_SCAN
#define REP_SCAN 1
#endif
        RLOOP(5) scan_block(p, lds, bx);
        volatile unsigned* sh = (volatile unsigned*)(lds + LDS_MISC);
#pragma unroll 1
        for (int rep = 0; rep < p.rep[12]; ++rep) {
        unsigned* qctr = (unsigned*)(ws + WS_CTL) + 64 + 64 * rep;
        unsigned u_next = 0u;
        if (threadIdx.x == 0) u_next = atomicAdd(qctr, 1u);
        for (;;) {
            __syncthreads();
            if (threadIdx.x == 0) sh[0] = u_next;
            __syncthreads();
            const unsigned u = sh[0];
            if (u >= 1024u) break;
            if (threadIdx.x == 0) u_next = atomicAdd(qctr, 1u);
            attn_unit(p, lds, (int)(u & 63u), 15 - (int)(u >> 6));
        }
        }
    } SEAM(5);
    if (IN(6)) { RLOOP(6) phase6(p); } SEAM(6);
#pragma unroll 1
    for (int r_ = 0; r_ < p.rep[13]; ++r_) xcd_barrier(xbar);

    if (IN(7)) {
        const bf16_t* GP = (const bf16_t*)(ws + WS_GP); bf16_t* MG = (bf16_t*)(ws + WS_MG);
#pragma unroll 1
        for (int w = 0; w < 2 * p.rep[7]; ++w) {
            const int second = w & 1;
            pg8::Gemm g{second ? (const bf16_t*)p.out : (const bf16_t*)(ws + WS_YA), (const bf16_t*)(ws + (second ? WS_WBB : WS_WBA)), T, 1024, 512, 512, 512}; pg8::StaticOrder S; S.init(T, 1024, G, bx);
            EpiBranch E{MG, GP, second}; pg8::gemm_phase<EpiBranch, true>(lds3, g, S, E);
        }
    } SEAM(7);
    if (IN(8)) {
        pg8::Gemm g{(const bf16_t*)(ws + WS_MG), (const bf16_t*)(ws + WS_WOUT), T, 1024, 1024, 1024, 1024}; pg8::StaticOrder S; S.init(T, 1024, G, bx);
        EpiOut E{p.in[I_X], p.out, (bf16_t*)(ws + WS_X1B), (float*)(ws + WS_SSQ)};
        RLOOP(8) pg8::gemm_phase<EpiOut, true>(lds3, g, S, E);
    } SEAM(8);
    if (IN(9)) {
        pg8::Gemm g{(const bf16_t*)(ws + WS_X1B), (const bf16_t*)(ws + WS_WUP), T, NPROJ, 1024, 1024, 1024}; pg8::StaticOrder S; S.init(T, NPROJ, G, bx);
        EpiUp E{(bf16_t*)(ws + WS_U), (const float*)(ws + WS_SSQ), p.in[I_CW], p.in[I_CB]};
        RLOOP(9) pg8::gemm_phase<EpiUp, true>(lds3, g, S, E);
    } SEAM(9);
    if (IN(10)) { RLOOP(10) phase10(p, r_ + 1 < p.rep[10]); } SEAM(10);
    if (IN(11)) {
        pg8::Gemm g{(const bf16_t*)(ws + WS_U) + DFF, (const bf16_t*)(ws + WS_WDN), T, 1024, DFF, NPROJ, DFF}; pg8::StaticOrder S; S.init(T, 1024, G, bx);
        RLOOP(11) { EpiDown E{p.out, (const bf16_t*)(ws + WS_X1B), r_ + 1 < p.rep[11]}; pg8::gemm_phase<EpiDown, true>(lds3, g, S, E); }
    }
#undef IN
#undef SEAM
}

extern "C" void kernel_launch(void* const* d_in, const int* in_sizes, int n_in, void* d_out, int out_size, void* d_ws, size_t ws_size, hipStream_t stream) {
    static int grid = 0;
    if (grid == 0) {
        if (n_in != 25 || out_size != T * DM || ws_size < WS_END) { fprintf(stderr, "kernel_launch: unexpected shapes (n_in %d out %d ws %zu)\n", n_in, out_size, ws_size); grid = -1; return; }
        int dev = 0, cus = 0, per_cu = 0;
        hipGetDevice(&dev); hipDeviceGetAttribute(&cus, hipDeviceAttributeMultiprocessorCount, dev);
        if (hipFuncSetAttribute((const void*)hybrid_fwd, hipFuncAttributeMaxDynamicSharedMemorySize, LDS_BYTES) != hipSuccess) { fprintf(stderr, "kernel_launch: hipFuncSetAttribute failed\n"); grid = -1; return; }
        hipOccupancyMaxActiveBlocksPerMultiprocessor(&per_cu, (const void*)hybrid_fwd, 512, LDS_BYTES);
        (void)hipGetLastError();
        if (per_cu < 1) per_cu = 1;
        grid = cus * per_cu; if (grid > 256) grid = 256;
        if (grid != 256) fprintf(stderr, "kernel_launch: grid %d (expected 256)\n", grid);
    }
    if (grid < 0) return;
    (void)hipMemsetAsync((char*)d_ws + WS_CTL, 0, 65536, stream);
    Params p{};
    for (int i = 0; i < 25; ++i) p.in[i] = (const float*)d_in[i];
    p.out = (float*)d_out; p.ws = (unsigned char*)d_ws;
    for (int i = 0; i < 14; ++i) p.rep[i] = 1;
    p.rep[13] = 0;
#ifdef PROBE_SYNCS
    p.rep[13] = PROBE_SYNCS;
#endif
#ifdef PROBE_PHASE
    p.rep[PROBE_PHASE] = 2;
#endif
#ifdef PROBE_PHASE2
    p.rep[PROBE_PHASE2] = 2;
#endif
#if MK_SPLIT
    for (int ph = 0; ph < NPHASE; ++ph) { p.lo = ph; p.hi = ph + 1; void* args[] = {&p};
        hipError_t e = hipLaunchCooperativeKernel((const void*)hybrid_fwd, dim3(grid), dim3(512), args, LDS_BYTES, stream);
        if (e != hipSuccess) { fprintf(stderr, "cooperative launch (phase %d) failed: %s\n", ph, hipGetErrorString(e)); break; } }
#else
    p.lo = 0; p.hi = NPHASE; void* args[] = {&p};
    hipError_t e = hipLaunchCooperativeKernel((const void*)hybrid_fwd, dim3(grid), dim3(512), args, LDS_BYTES, stream);
    if (e != hipSuccess) fprintf(stderr, "cooperative launch failed: %s (grid %d)\n", hipGetErrorString(e), grid);
#endif
}
```
